# Optimizing an MI355X kernel written in HIP

```python
import math
import jax, jax.numpy as jnp
from jax import lax
import numpy as np

D_MODEL = 4096
BATCH = 2
SEQ = 4096
DEPTH = 4

ROPE_THETA = 500000.0
BLOCK = 128
A_HEAD_DIM = 128
A_PATTERNS = ((128, 1), (512, 4), (2048, 16))
A_GROUPS = len(A_PATTERNS)
A_HEADS_PER_GROUP = D_MODEL // 1024
A_HEADS = A_GROUPS * A_HEADS_PER_GROUP
A_WIDTH = A_HEADS * A_HEAD_DIM
A_OUT = A_HEADS_PER_GROUP * A_HEAD_DIM
B_HEAD_DIM = 64
B_Q_HEADS = D_MODEL // 128
B_KV_HEADS = B_Q_HEADS // 8
B_GQA = B_Q_HEADS // B_KV_HEADS
B_WINDOW = 128
B_Q_WIDTH = B_Q_HEADS * B_HEAD_DIM
B_KV_WIDTH = B_KV_HEADS * B_HEAD_DIM
IN_COLS = 3 * A_WIDTH + B_Q_WIDTH + 2 * B_KV_WIDTH + 2 * D_MODEL
SPLITS = tuple(int(s) for s in np.cumsum([A_WIDTH, A_WIDTH, A_WIDTH, B_Q_WIDTH, B_KV_WIDTH, B_KV_WIDTH]))
D_FF = 2 * D_MODEL
CONV_WIDTH = 3
DEEPNORM_ALPHA = (2.0 * DEPTH) ** 0.25
DEEPNORM_BETA = (8.0 * DEPTH) ** -0.25
LN_EPS = 1e-5

kernel_name = "hybrid_dilated_swa_sink_convffn_deepnorm"


def layer_norm(x, g, b):
    xf = x.astype(jnp.float32)
    mu = jnp.mean(xf, axis=-1, keepdims=True)
    var = jnp.mean(jnp.square(xf - mu), axis=-1, keepdims=True)
    y = (xf - mu) * lax.rsqrt(var + LN_EPS)
    return (y * g.astype(jnp.float32) + b.astype(jnp.float32)).astype(x.dtype)


def rope_tables(positions, rot_dim):
    inv_freq = ROPE_THETA ** (-(jnp.arange(0, rot_dim, 2, dtype=jnp.float32) / rot_dim))
    ang = positions.astype(jnp.float32)[..., None] * inv_freq
    return jnp.cos(ang)[:, :, None, :], jnp.sin(ang)[:, :, None, :]


def apply_partial_rope(t, cos, sin):
    half = cos.shape[-1]
    rot = 2 * half
    tf = t[..., :rot].astype(jnp.float32)
    x1, x2 = tf[..., :half], tf[..., half:]
    rotated = jnp.concatenate([x1 * cos - x2 * sin, x2 * cos + x1 * sin], axis=-1)
    return jnp.concatenate([rotated.astype(t.dtype), t[..., rot:]], axis=-1)


def dilate(t, r):
    b, s = t.shape[0], t.shape[1]
    rest = t.shape[2:]
    t = t.reshape((b, s // r, r) + rest)
    t = jnp.moveaxis(t, 2, 1)
    return t.reshape((b * r, s // r) + rest)


def undilate(t, r, b):
    l = t.shape[1]
    rest = t.shape[2:]
    t = t.reshape((b, r, l) + rest)
    t = jnp.moveaxis(t, 1, 2)
    return t.reshape((b, l * r) + rest)


def banded_attention(q, k, v, max_dist, sinks=None):
    n, l, hkv, g, d = q.shape
    lp = -(-l // BLOCK) * BLOCK
    pad = lp - l
    if pad:
        q = jnp.pad(q, ((0, 0), (0, pad), (0, 0), (0, 0), (0, 0)))
        k = jnp.pad(k, ((0, 0), (0, pad), (0, 0), (0, 0)))
        v = jnp.pad(v, ((0, 0), (0, pad), (0, 0), (0, 0)))
    nb = lp // BLOCK
    qb = q.reshape(n, nb, BLOCK, hkv, g, d)
    kb = k.reshape(n, nb, BLOCK, hkv, d)
    vb = v.reshape(n, nb, BLOCK, hkv, d)
    kc = jnp.concatenate([jnp.pad(kb, ((0, 0), (1, 0), (0, 0), (0, 0), (0, 0)))[:, :-1], kb], axis=2)
    vc = jnp.concatenate([jnp.pad(vb, ((0, 0), (1, 0), (0, 0), (0, 0), (0, 0)))[:, :-1], vb], axis=2)
    scale = 1.0 / math.sqrt(d)
    s = jnp.einsum('nbqhgd,nbkhd->nbhgqk', qb, kc).astype(jnp.float32) * scale
    qi = jnp.arange(BLOCK)[:, None] + BLOCK
    kj = jnp.arange(2 * BLOCK)[None, :]
    dist = qi - kj
    key_abs = (jnp.arange(nb) * BLOCK)[:, None] - BLOCK + jnp.arange(2 * BLOCK)[None, :]
    mask = ((dist >= 0) & (dist <= max_dist))[None] & (key_abs >= 0)[:, None, :]
    s = jnp.where(mask[None, :, None, None], s, -jnp.inf)
    m = jnp.max(s, axis=-1, keepdims=True)
    if sinks is not None:
        sink = sinks.astype(jnp.float32).reshape(hkv, g)[None, None, :, :, None, None]
        m = jnp.maximum(m, sink)
        p = jnp.exp(s - m)
        denom = jnp.sum(p, axis=-1, keepdims=True) + jnp.exp(sink - m)
    else:
        p = jnp.exp(s - m)
        denom = jnp.sum(p, axis=-1, keepdims=True)
    out = jnp.einsum('nbhgqk,nbkhd->nbqhgd', (p / denom).astype(v.dtype), vc)
    lse = (m + jnp.log(denom))[..., 0]
    out = out.reshape(n, lp, hkv, g, d)[:, :l]
    lse = jnp.transpose(lse, (0, 1, 4, 2, 3)).reshape(n, lp, hkv, g)[:, :l]
    return out, lse


def mixing_sublayer(x, rope_a, rope_b, w_in, w_proj_a, w_proj_b, w_out, sinks):
    b, s, _ = x.shape
    proj = jnp.einsum('bsd,de->bse', x, w_in)
    qa, ka, va, qb, kb, vb, gates = jnp.split(proj, SPLITS, axis=-1)
    qa = apply_partial_rope(qa.reshape(b, s, A_HEADS, A_HEAD_DIM), *rope_a)
    ka = apply_partial_rope(ka.reshape(b, s, A_HEADS, A_HEAD_DIM), *rope_a)
    va = va.reshape(b, s, A_HEADS, A_HEAD_DIM)
    outs, lses = [], []
    for gi, (window, dil) in enumerate(A_PATTERNS):
        hs = slice(gi * A_HEADS_PER_GROUP, (gi + 1) * A_HEADS_PER_GROUP)
        qg = dilate(qa[:, :, hs], dil)[:, :, :, None, :]
        kg = dilate(ka[:, :, hs], dil)
        vg = dilate(va[:, :, hs], dil)
        o, lse = banded_attention(qg, kg, vg, window // dil)
        outs.append(undilate(o[:, :, :, 0], dil, b))
        lses.append(undilate(lse[..., 0], dil, b))
    wts = jax.nn.softmax(jnp.stack(lses, axis=0), axis=0)
    ya = jnp.sum(wts[..., None] * jnp.stack(outs, axis=0).astype(jnp.float32), axis=0)
    ya = ya.astype(x.dtype).reshape(b, s, A_OUT)
    qb = apply_partial_rope(qb.reshape(b, s, B_Q_HEADS, B_HEAD_DIM), *rope_b)
    kb = apply_partial_rope(kb.reshape(b, s, B_KV_HEADS, B_HEAD_DIM), *rope_b)
    vb = vb.reshape(b, s, B_KV_HEADS, B_HEAD_DIM)
    yb, _ = banded_attention(qb.reshape(b, s, B_KV_HEADS, B_GQA, B_HEAD_DIM), kb, vb,
                             B_WINDOW - 1, sinks=sinks)
    yb = yb.reshape(b, s, B_Q_WIDTH)
    gate_a, gate_b = jnp.split(jax.nn.sigmoid(gates), 2, axis=-1)
    merged = (gate_a * jnp.einsum('bse,ed->bsd', ya, w_proj_a)
              + gate_b * jnp.einsum('bse,ed->bsd', yb, w_proj_b))
    return jnp.einsum('bsd,de->bse', merged, w_out)


def conv_ffn(x, w_up, conv_w, conv_b, w_down):
    u = jnp.einsum('bsd,df->bsf', x, w_up)
    up = jnp.pad(u, ((0, 0), (CONV_WIDTH - 1, 0), (0, 0)))
    s = x.shape[1]
    u = sum(conv_w[i] * up[:, i:i + s] for i in range(CONV_WIDTH)) + conv_b
    g, val = jnp.split(u, 2, axis=-1)
    return jnp.einsum('bsf,fd->bsd', jax.nn.silu(g) * val, w_down)


def setup_inputs(seed: int = 0) -> dict:
    key = jax.random.key(seed)
    ks = jax.random.split(key, 16)
    nrm = lambda k, shape, std: jax.random.normal(k, shape, jnp.float32) * std
    x = jax.random.normal(ks[0], (BATCH, SEQ, D_MODEL), jnp.float32)
    offset = jax.random.randint(ks[1], (BATCH, 1), 0, 1024, dtype=jnp.int32)
    positions = offset + jnp.arange(SEQ, dtype=jnp.int32)[None, :]
    return {
        "x": x,
        "positions": positions,
        "w_in": nrm(ks[2], (DEPTH, D_MODEL, IN_COLS), D_MODEL ** -0.5),
        "w_proj_a": nrm(ks[3], (DEPTH, A_OUT, D_MODEL), DEEPNORM_BETA * A_OUT ** -0.5),
        "w_proj_b": nrm(ks[4], (DEPTH, B_Q_WIDTH, D_MODEL), DEEPNORM_BETA * B_Q_WIDTH ** -0.5),
        "w_out": nrm(ks[5], (DEPTH, D_MODEL, D_MODEL), DEEPNORM_BETA * D_MODEL ** -0.5),
        "sinks": nrm(ks[6], (DEPTH, B_Q_HEADS), 0.5),
        "ln1_g": 1.0 + nrm(ks[7], (DEPTH, D_MODEL), 0.02),
        "ln1_b": nrm(ks[8], (DEPTH, D_MODEL), 0.02),
        "w_up": nrm(ks[9], (DEPTH, D_MODEL, 2 * D_FF), D_MODEL ** -0.5),
        "conv_w": nrm(ks[10], (DEPTH, CONV_WIDTH, 2 * D_FF), CONV_WIDTH ** -0.5),
        "conv_b": nrm(ks[11], (DEPTH, 2 * D_FF), 0.01),
        "w_down": nrm(ks[12], (DEPTH, D_FF, D_MODEL), DEEPNORM_BETA * D_FF ** -0.5),
        "ln2_g": 1.0 + nrm(ks[13], (DEPTH, D_MODEL), 0.02),
        "ln2_b": nrm(ks[14], (DEPTH, D_MODEL), 0.02),
    }


def reference(x, positions, w_in, w_proj_a, w_proj_b, w_out, sinks, ln1_g, ln1_b,
              w_up, conv_w, conv_b, w_down, ln2_g, ln2_b):
    rope_a = rope_tables(positions, A_HEAD_DIM // 4)
    rope_b = rope_tables(positions, B_HEAD_DIM // 4)
    for l in range(DEPTH):
        mix = mixing_sublayer(x, rope_a, rope_b, w_in[l], w_proj_a[l], w_proj_b[l], w_out[l], sinks[l])
        x = layer_norm(DEEPNORM_ALPHA * x + mix, ln1_g[l], ln1_b[l])
        f = conv_ffn(x, w_up[l], conv_w[l], conv_b[l], w_down[l])
        x = layer_norm(DEEPNORM_ALPHA * x + f, ln2_g[l], ln2_b[l])
    return x
```

```cpp
#include <hip/hip_runtime.h>
#include <cstdio>
#include <cstdint>

constexpr int BATCH = 2, SEQ = 4096, DM = 4096, DEPTH = 4;
constexpr int M = BATCH * SEQ;
constexpr int IN_COLS = 15360;
constexpr int KA_OFF = 1536, VA_OFF = 3072, QB_OFF = 4608, KB_OFF = 6656, VB_OFF = 6912, G_OFF = 7168;
constexpr int A_OUT = 512, B_QW = 2048, DFF = 8192, UP_COLS = 16384;
constexpr float LN_EPS = 1e-5f;
constexpr float DN_ALPHA = 1.6817928305074290f;
constexpr float LOG2E = 1.4426950408889634f;
constexpr float QSCALE_A = 0.08838834764831845f * LOG2E;
constexpr float QSCALE_B = 0.125f * LOG2E;
#define MK_PER_PHASE 1
namespace pg8 {
#define PG8_LAS __attribute__((address_space(3)))
typedef unsigned short bf16_t;
typedef short bf16x8 __attribute__((ext_vector_type(8)));
typedef float f32x4 __attribute__((ext_vector_type(4)));
typedef unsigned u32x4 __attribute__((ext_vector_type(4)));
constexpr int BM = 256, BK = 64, HALF = 128, HTB = HALF * BK * 2  , STAGE_BYTES = 8 * HTB, NXCD = 8, WGM = 8;

__host__ __device__ __forceinline__ int lds_byte(int r, int c) { const int st = (r >> 4) * 2 + (c >> 5), rr = r & 15, cc = c & 31, ob = rr * 64 + cc * 2; return st * 1024 + (ob ^ (((ob >> 9) & 1) << 5)); }
__host__ __device__ __forceinline__ void stage_rc(int b, int& R, int& C) { const int st = b / 1024, sb = b % 1024, swz = sb ^ (((sb >> 9) & 1) << 5); R = (st >> 1) * 16 + swz / 64; C = (st & 1) * 32 + (swz % 64) / 2; }
__host__ __device__ __forceinline__ int perm32(int rho) { const int n = rho >> 4, i = rho & 15; return 8 * (i >> 2) + 4 * n + (i & 3); }

struct Unit { int pm, pn; };
struct Gemm { const bf16_t* A; const bf16_t* Bt; int M, N, K; };

struct StaticOrder {
    int nM, nN, nwg, G, c;
    __host__ __device__ void init(int M, int N, int G_, int c_) { nM = M / BM; nN = N / BM; nwg = nM * nN; G = G_; c = c_; }
    __host__ __device__ bool next(int i, Unit& u) const {
        const long L = (long)i * G + c; if (L >= nwg) return false;
        int wgid = (int)L; { const int q = nwg / NXCD, r = nwg % NXCD, xcd = wgid % NXCD, off = wgid / NXCD; wgid = (xcd < r ? xcd * (q + 1) : r * (q + 1) + (xcd - r) * q) + off; }
        const int nig = WGM * nN, gid = wgid / nig, fm = gid * WGM, gsz = (nM - fm) < WGM ? (nM - fm) : WGM;
        u.pm = fm + ((wgid % nig) % gsz); u.pn = (wgid % nig) / gsz; return true;
    }
    __device__ __forceinline__ void a_ready(const Unit&) const {}
    __device__ __forceinline__ void done(const Unit&) const {}
};
typedef float f32x2 __attribute__((ext_vector_type(2)));
typedef __bf16 pg8_bf16x2 __attribute__((ext_vector_type(2)));
__device__ __forceinline__ unsigned cvt_pk_bf16(float lo, float hi) { f32x2 v = {lo, hi}; pg8_bf16x2 b = __builtin_convertvector(v, pg8_bf16x2); return __builtin_bit_cast(unsigned, b); }
#define PG8_GAS __attribute__((address_space(1)))
__device__ __forceinline__ void st8(PG8_GAS bf16_t* p, const f32x4 v0, const f32x4 v1) {
    u32x4 w; w.x = cvt_pk_bf16(v0[0], v0[1]); w.y = cvt_pk_bf16(v0[2], v0[3]); w.z = cvt_pk_bf16(v1[0], v1[1]); w.w = cvt_pk_bf16(v1[2], v1[3]);
    *(PG8_GAS u32x4*)p = w;
}
__device__ __forceinline__ f32x4 bf_lo4(unsigned a, unsigned b) { return (f32x4){__uint_as_float(a << 16), __uint_as_float(a & 0xffff0000u), __uint_as_float(b << 16), __uint_as_float(b & 0xffff0000u)}; }
__device__ __forceinline__ float sigmoidf_fast(float x) { return __builtin_amdgcn_rcpf(1.0f + __builtin_amdgcn_exp2f(-x * LOG2E)); }

struct EpiPlain {
    static constexpr bool PERM = true, AFTER_DRAIN = false;
    PG8_GAS bf16_t* O; int ldc;
    __device__ __forceinline__ void operator()(const f32x4 (&acc)[2][2][4][2], const Unit& u, int wr, int wc, int fr, int fq) const {
        PG8_GAS bf16_t* base = O + (size_t)(u.pm * BM + wr * 64 + fr) * ldc + u.pn * BM + wc * 32 + 8 * fq;
#pragma unroll
        for (int ai = 0; ai < 2; ++ai)
#pragma unroll
            for (int m = 0; m < 4; ++m) { PG8_GAS bf16_t* rowp = base + (size_t)(ai * HALF + m * 16) * ldc;
#pragma unroll
                for (int bj = 0; bj < 2; ++bj) st8(rowp + bj * HALF, acc[ai][bj][m][0], acc[ai][bj][m][1]); }
    }
};

struct EpiIn {
    static constexpr bool PERM = true, AFTER_DRAIN = false;
    PG8_GAS bf16_t* O; PG8_GAS const float* ropeA; PG8_GAS const float* ropeB;
    __device__ __forceinline__ void operator()(const f32x4 (&acc)[2][2][4][2], const Unit& u, int wr, int wc, int fr, int fq) const {
        const int row0 = u.pm * BM + wr * 64 + fr, pn = u.pn;
        PG8_GAS bf16_t* base = O + (size_t)row0 * IN_COLS + pn * BM + wc * 32 + 8 * fq;
        if (pn >= 28) {
#pragma unroll
            for (int ai = 0; ai < 2; ++ai)
#pragma unroll
                for (int m = 0; m < 4; ++m) { PG8_GAS bf16_t* rowp = base + (size_t)(ai * HALF + m * 16) * IN_COLS;
#pragma unroll
                    for (int bj = 0; bj < 2; ++bj) { f32x4 v0 = acc[ai][bj][m][0], v1 = acc[ai][bj][m][1];
#pragma unroll
                        for (int j = 0; j < 4; ++j) { v0[j] = sigmoidf_fast(v0[j]); v1[j] = sigmoidf_fast(v1[j]); }
                        st8(rowp + bj * HALF, v0, v1); } }
        } else if (pn < 12) {
            const float sc = pn < 6 ? QSCALE_A : 1.0f;
#pragma unroll
            for (int ai = 0; ai < 2; ++ai)
#pragma unroll
                for (int m = 0; m < 4; ++m) { const int r = row0 + ai * HALF + m * 16; PG8_GAS bf16_t* rowp = base + (size_t)(ai * HALF + m * 16) * IN_COLS;
                    f32x4 c = (f32x4){1.f, 1.f, 1.f, 1.f}, s = (f32x4){0.f, 0.f, 0.f, 0.f};
                    if (wc == 0) { c = *(PG8_GAS const f32x4*)(ropeA + (size_t)r * 32 + 4 * fq); s = *(PG8_GAS const f32x4*)(ropeA + (size_t)r * 32 + 16 + 4 * fq); }
#pragma unroll
                    for (int bj = 0; bj < 2; ++bj) { const f32x4 v0 = acc[ai][bj][m][0], v1 = acc[ai][bj][m][1];
                        const f32x4 n0 = (v0 * c - v1 * s) * sc, n1 = (v1 * c + v0 * s) * sc;
                        st8(rowp + bj * HALF, n0, n1); } }
        } else if (pn >= 18 && pn < 27) {
            const float sc = pn < 26 ? QSCALE_B : 1.0f;
            const bool rotl = ((wc & 1) == 0) && (fq < 2);
#pragma unroll
            for (int ai = 0; ai < 2; ++ai)
#pragma unroll
                for (int m = 0; m < 4; ++m) { const int r = row0 + ai * HALF + m * 16; PG8_GAS bf16_t* rowp = base + (size_t)(ai * HALF + m * 16) * IN_COLS;
                    f32x4 c = *(PG8_GAS const f32x4*)(ropeB + (size_t)r * 16 + 4 * (fq & 1)), s = *(PG8_GAS const f32x4*)(ropeB + (size_t)r * 16 + 8 + 4 * (fq & 1));
                    if (!rotl) { c = (f32x4){1.f, 1.f, 1.f, 1.f}; s = (f32x4){0.f, 0.f, 0.f, 0.f}; }
#pragma unroll
                    for (int bj = 0; bj < 2; ++bj) { const f32x4 v0 = acc[ai][bj][m][0], v1 = acc[ai][bj][m][1];
                        const f32x4 n0 = (v0 * c - v1 * s) * sc, n1 = (v1 * c + v0 * s) * sc;
                        st8(rowp + bj * HALF, n0, n1); } }
        } else {
#pragma unroll
            for (int ai = 0; ai < 2; ++ai)
#pragma unroll
                for (int m = 0; m < 4; ++m) { PG8_GAS bf16_t* rowp = base + (size_t)(ai * HALF + m * 16) * IN_COLS;
#pragma unroll
                    for (int bj = 0; bj < 2; ++bj) st8(rowp + bj * HALF, acc[ai][bj][m][0], acc[ai][bj][m][1]); }
        }
    }
};

template <bool ADD> struct EpiGate {
    static constexpr bool PERM = true, AFTER_DRAIN = false;
    PG8_GAS bf16_t* MG; PG8_GAS const bf16_t* gate;
    __device__ __forceinline__ void operator()(const f32x4 (&acc)[2][2][4][2], const Unit& u, int wr, int wc, int fr, int fq) const {
        const int row0 = u.pm * BM + wr * 64 + fr, col0 = u.pn * BM + wc * 32 + 8 * fq;
#pragma unroll
        for (int ai = 0; ai < 2; ++ai)
#pragma unroll
            for (int m = 0; m < 4; ++m) { const size_t r = (size_t)(row0 + ai * HALF + m * 16);
#pragma unroll
                for (int bj = 0; bj < 2; ++bj) { const int c = col0 + bj * HALF;
                    const u32x4 g = *(PG8_GAS const u32x4*)(gate + r * IN_COLS + c);
                    f32x4 v0 = acc[ai][bj][m][0] * bf_lo4(g.x, g.y), v1 = acc[ai][bj][m][1] * bf_lo4(g.z, g.w);
                    if (ADD) { const u32x4 o = *(PG8_GAS const u32x4*)(MG + r * DM + c); v0 = v0 + bf_lo4(o.x, o.y); v1 = v1 + bf_lo4(o.z, o.w); }
                    st8(MG + r * DM + c, v0, v1); } }
    }
};

struct EpiRes {
    static constexpr bool PERM = false, AFTER_DRAIN = false;
    PG8_GAS const float* base; PG8_GAS float* H;
    __device__ __forceinline__ void operator()(const f32x4 (&acc)[2][2][4][2], const Unit& u, int wr, int wc, int fr, int fq) const {
        const int row0 = u.pm * BM + wr * 64 + fr, col0 = u.pn * BM + wc * 32 + 4 * fq;
#pragma unroll
        for (int ai = 0; ai < 2; ++ai)
#pragma unroll
            for (int m = 0; m < 4; ++m) { const size_t off = (size_t)(row0 + ai * HALF + m * 16) * DM + col0;
#pragma unroll
                for (int bj = 0; bj < 2; ++bj)
#pragma unroll
                    for (int n = 0; n < 2; ++n) { const f32x4 b = *(PG8_GAS const f32x4*)(base + off + bj * HALF + n * 16);
                        *(PG8_GAS f32x4*)(H + off + bj * HALF + n * 16) = b * DN_ALPHA + acc[ai][bj][m][n]; } }
    }
};

template <class Epi, class Sched, bool ALIGN_EPI = false, bool SP2 = false>
__device__ __forceinline__ void gemm_phase(PG8_LAS unsigned char* lds, const Gemm g, const Sched& S, const Epi& E) {
    int tid_ = threadIdx.x; asm volatile("" : "+v"(tid_));
    const int tid = tid_, wid = __builtin_amdgcn_readfirstlane(tid >> 6), lane = tid & 63, wr = wid >> 2, wc = wid & 3, fr = lane & 15, fq = lane >> 4;
    const int K = g.K, nt = K / BK;
    unsigned voffA[2], voffB[2];
#pragma unroll
    for (int i = 0; i < 2; ++i) { int R, C; stage_rc(tid * 16 + i * 8192, R, C); const int Rb = Epi::PERM ? ((R & ~31) + perm32(R & 31)) : R;
        voffA[i] = (unsigned)(R * K + C) * 2u; voffB[i] = (unsigned)(Rb * K + C) * 2u; }
    const size_t kstep = (size_t)(BK * 2);
    const size_t hstep = (size_t)HALF * K * 2;
    const size_t tstep = 2 * hstep;
    const unsigned ldsw = (unsigned)wid * 1024u;
    const int aoff = lds_byte(wr * 64 + fr, fq * 8), boff = lds_byte(wc * 32 + fr, fq * 8);
#define PG8_SA(b, h) (((b) * 2 + (h)) * HTB)
#define PG8_SB(b, h) ((4 + (b) * 2 + (h)) * HTB)
#define PG8_STAGE(bufoff, gbase, voff) do { _Pragma("unroll") for (int _i = 0; _i < 2; ++_i) \
        __builtin_amdgcn_global_load_lds((const unsigned*)((const char*)(gbase) + (voff)[_i]), (PG8_LAS unsigned*)(lds + (bufoff) + ldsw + _i * 8192), 16, 0, 0); } while (0)
#define PG8_LDA(dst, b, h) do { _Pragma("unroll") for (int m = 0; m < 4; ++m) _Pragma("unroll") for (int k = 0; k < 2; ++k) dst[m][k] = *(const PG8_LAS bf16x8*)(lds + PG8_SA(b, h) + aoff + m * 2048 + k * 1024); } while (0)
#define PG8_LDB(dst, b, h) do { _Pragma("unroll") for (int n = 0; n < 2; ++n) _Pragma("unroll") for (int k = 0; k < 2; ++k) dst[n][k] = *(const PG8_LAS bf16x8*)(lds + PG8_SB(b, h) + boff + n * 2048 + k * 1024); } while (0)
#define PG8_MMA(ai, bj, At, Bt) do { __builtin_amdgcn_s_setprio(1); _Pragma("unroll") for (int m = 0; m < 4; ++m) _Pragma("unroll") for (int n = 0; n < 2; ++n) _Pragma("unroll") for (int k = 0; k < 2; ++k) \
        acc[ai][bj][m][n] = __builtin_amdgcn_mfma_f32_16x16x32_bf16(Bt[n][k], At[m][k], acc[ai][bj][m][n], 0, 0, 0); __builtin_amdgcn_s_setprio(0); } while (0)
#define PG8_WAIT_V(n) asm volatile("s_waitcnt vmcnt(" #n ")" ::: "memory")
#define PG8_WAIT_L(n) asm volatile("s_waitcnt lgkmcnt(" #n ")" ::: "memory")
#define PG8_BAR __builtin_amdgcn_s_barrier()
#define PG8_SCHED __builtin_amdgcn_sched_barrier(0)
    Unit cur, nxt; int ui = 0;
    if (!S.next(0, cur)) return;
    f32x4 acc[2][2][4][2];
#pragma unroll
    for (int a = 0; a < 2; ++a)
#pragma unroll
        for (int b = 0; b < 2; ++b)
#pragma unroll
            for (int m = 0; m < 4; ++m)
#pragma unroll
                for (int n = 0; n < 2; ++n) acc[a][b][m][n] = (f32x4){0.f, 0.f, 0.f, 0.f};
    bf16x8 At[4][2], B0[2][2], B1[2][2];
    const char* cA = (const char*)g.A + (size_t)cur.pm * tstep; const char* cB = (const char*)g.Bt + (size_t)cur.pn * tstep;
    S.a_ready(cur);
    if constexpr (SP2) {
        PG8_STAGE(PG8_SB(0, 0), cB, voffB); PG8_STAGE(PG8_SB(0, 1), cB + hstep, voffB); PG8_STAGE(PG8_SA(0, 0), cA, voffA); PG8_STAGE(PG8_SA(0, 1), cA + hstep, voffA);
        if (wr == 1) PG8_BAR;
        PG8_WAIT_V(2); PG8_BAR;
        PG8_STAGE(PG8_SB(1, 0), cB + kstep, voffB); PG8_STAGE(PG8_SA(1, 0), cA + kstep, voffA); PG8_STAGE(PG8_SB(1, 1), cB + hstep + kstep, voffB);
        PG8_WAIT_V(6); PG8_BAR;
    } else {
        PG8_STAGE(PG8_SB(0, 0), cB, voffB); PG8_STAGE(PG8_SA(0, 0), cA, voffA); PG8_STAGE(PG8_SB(0, 1), cB + hstep, voffB); PG8_STAGE(PG8_SA(0, 1), cA + hstep, voffA);
        if (wr == 1) PG8_BAR;
        PG8_WAIT_V(4); PG8_BAR;
        PG8_STAGE(PG8_SB(1, 0), cB + kstep, voffB); PG8_STAGE(PG8_SA(1, 0), cA + kstep, voffA); PG8_STAGE(PG8_SB(1, 1), cB + hstep + kstep, voffB);
        PG8_WAIT_V(6); PG8_BAR;
    }
    for (;;) {
        const bool has_next = S.next(ui + 1, nxt);
        const char* nA = has_next ? (const char*)g.A + (size_t)nxt.pm * tstep : cA; const char* nB = has_next ? (const char*)g.Bt + (size_t)nxt.pn * tstep : cB;
        for (int t = 0; t < nt; t += 2) {
            const bool last = (t == nt - 2);
            const char* a1 = cA + (size_t)(t + 1) * kstep;
            const char* a2 = last ? nA : cA + (size_t)(t + 2) * kstep; const char* b2 = last ? nB : cB + (size_t)(t + 2) * kstep;
            const char* a3 = a2 + kstep; const char* b3 = b2 + kstep;
            if (last && has_next) S.a_ready(nxt);
            if constexpr (SP2) {
            PG8_LDB(B0, 0, 0); PG8_LDB(B1, 0, 1); PG8_SCHED; PG8_LDA(At, 0, 0); PG8_STAGE(PG8_SA(1, 1), a1 + hstep, voffA);
            PG8_WAIT_V(8); PG8_WAIT_L(0); PG8_BAR; PG8_MMA(0, 0, At, B0); PG8_MMA(0, 1, At, B1); PG8_BAR; PG8_SCHED;
            PG8_LDA(At, 0, 1); PG8_STAGE(PG8_SB(0, 0), b2, voffB); PG8_STAGE(PG8_SB(0, 1), b2 + hstep, voffB); PG8_STAGE(PG8_SA(0, 0), a2, voffA);
            PG8_WAIT_V(8); PG8_WAIT_L(0); PG8_BAR; PG8_MMA(1, 0, At, B0); PG8_MMA(1, 1, At, B1); PG8_BAR; PG8_SCHED;
            PG8_LDB(B0, 1, 0); PG8_LDB(B1, 1, 1); PG8_SCHED; PG8_LDA(At, 1, 0); PG8_STAGE(PG8_SA(0, 1), a2 + hstep, voffA);
            PG8_WAIT_V(8); PG8_WAIT_L(0); PG8_BAR; PG8_MMA(0, 0, At, B0); PG8_MMA(0, 1, At, B1); PG8_BAR; PG8_SCHED;
            PG8_LDA(At, 1, 1); PG8_STAGE(PG8_SB(1, 0), b3, voffB); PG8_STAGE(PG8_SB(1, 1), b3 + hstep, voffB); PG8_STAGE(PG8_SA(1, 0), a3, voffA);
            PG8_WAIT_V(8); PG8_WAIT_L(0); PG8_BAR; PG8_MMA(1, 0, At, B0); PG8_MMA(1, 1, At, B1); PG8_BAR; PG8_SCHED;
            } else {
            PG8_LDB(B0, 0, 0); PG8_SCHED; PG8_LDA(At, 0, 0); PG8_STAGE(PG8_SA(1, 1), a1 + hstep, voffA);
            PG8_WAIT_L(8); PG8_BAR; PG8_WAIT_L(0); PG8_MMA(0, 0, At, B0); PG8_BAR; PG8_SCHED;
            PG8_LDB(B1, 0, 1); PG8_STAGE(PG8_SB(0, 0), b2, voffB);
            PG8_BAR; PG8_WAIT_L(0); PG8_MMA(0, 1, At, B1); PG8_BAR;
            PG8_LDA(At, 0, 1); PG8_STAGE(PG8_SA(0, 0), a2, voffA);
            PG8_BAR; PG8_WAIT_L(0); PG8_MMA(1, 0, At, B0); PG8_BAR; PG8_SCHED;
            PG8_STAGE(PG8_SB(0, 1), b2 + hstep, voffB);
            PG8_WAIT_V(6); PG8_BAR; PG8_MMA(1, 1, At, B1); PG8_BAR;
            PG8_LDB(B0, 1, 0); PG8_SCHED; PG8_LDA(At, 1, 0); PG8_STAGE(PG8_SA(0, 1), a2 + hstep, voffA);
            PG8_WAIT_L(8); PG8_BAR; PG8_WAIT_L(0); PG8_MMA(0, 0, At, B0); PG8_BAR; PG8_SCHED;
            PG8_LDB(B1, 1, 1); PG8_STAGE(PG8_SB(1, 0), b3, voffB);
            PG8_BAR; PG8_WAIT_L(0); PG8_MMA(0, 1, At, B1); PG8_BAR;
            PG8_LDA(At, 1, 1); PG8_STAGE(PG8_SA(1, 0), a3, voffA);
            PG8_BAR; PG8_WAIT_L(0); PG8_MMA(1, 0, At, B0); PG8_BAR; PG8_SCHED;
            PG8_STAGE(PG8_SB(1, 1), b3 + hstep, voffB);
            PG8_WAIT_V(6); PG8_BAR; PG8_MMA(1, 1, At, B1); PG8_BAR;
            }
        }
        if constexpr (ALIGN_EPI) { if (wr == 0) PG8_BAR; }
        if constexpr (!Epi::AFTER_DRAIN) { E(acc, cur, wr, wc, fr, fq); S.done(cur); }
        if (!has_next) break;
#pragma unroll
        for (int a = 0; a < 2; ++a)
#pragma unroll
            for (int b = 0; b < 2; ++b)
#pragma unroll
                for (int m = 0; m < 4; ++m)
#pragma unroll
                    for (int n = 0; n < 2; ++n) acc[a][b][m][n] = (f32x4){0.f, 0.f, 0.f, 0.f};
        cur = nxt; cA = nA; cB = nB; ++ui;
        if constexpr (ALIGN_EPI) { if (wr == 1) PG8_BAR; }
    }
    PG8_WAIT_V(0);
    if constexpr (!ALIGN_EPI) { if (wr == 0) PG8_BAR; }
    PG8_BAR;
    if constexpr (Epi::AFTER_DRAIN) { E.fused(acc, cur, wr, wc, fr, fq, lds, wid, lane); S.done(cur); }
#undef PG8_SA
#undef PG8_SB
#undef PG8_STAGE
#undef PG8_LDA
#undef PG8_LDB
#undef PG8_MMA
#undef PG8_WAIT_V
#undef PG8_WAIT_L
#undef PG8_BAR
#undef PG8_SCHED
}
}
__device__ __forceinline__ float sigmoidf_dev(float x) { return __builtin_amdgcn_rcpf(1.0f + __builtin_amdgcn_exp2f(-x * LOG2E)); }

constexpr int NWAVES = 8;
#ifndef MK_PER_PHASE
#define MK_PER_PHASE 0
#endif
constexpr int PH_PER_LAYER = 10;
constexpr int N_PHASES = 1 + DEPTH * PH_PER_LAYER;

constexpr size_t MiB = 1u << 20;
constexpr size_t WS_CTL = 0, CTL_ZERO_BYTES = 1 * MiB;
constexpr size_t WS_ROPEA = 1 * MiB;
constexpr size_t WS_ROPEB = 2 * MiB;
constexpr size_t WS_LSE = 3 * MiB;
constexpr size_t WS_W = 4 * MiB;
constexpr size_t LW_IN = 0, LW_PA = 120 * MiB, LW_PB = 124 * MiB, LW_OUT = 140 * MiB, LW_UP = 172 * MiB, LW_DN = 300 * MiB, LW_BYTES = 364 * MiB;
constexpr size_t WS_XB = WS_W + DEPTH * LW_BYTES;
constexpr size_t WS_XF = WS_XB + 64 * MiB;
constexpr size_t WS_HF = WS_XF + 128 * MiB;
constexpr size_t WS_PROJ = WS_HF + 128 * MiB;
constexpr size_t WS_OG = WS_PROJ + 240 * MiB;
constexpr size_t WS_YA = WS_OG + 48 * MiB;
constexpr size_t WS_YB = WS_YA + 8 * MiB;
constexpr size_t WS_MG = WS_YB + 32 * MiB;
constexpr size_t WS_U = WS_MG + 64 * MiB;
constexpr size_t WS_HA = WS_U + 256 * MiB;
constexpr size_t WS_END = WS_HA + 128 * MiB;
static_assert((size_t)IN_COLS * DM * 2 == 120 * MiB && (size_t)M * IN_COLS * 2 == 240 * MiB && (size_t)3 * M * 512 * 4 == 48 * MiB, "ws map");
constexpr int CW_TMO = 0, CW_CODE = 1;
constexpr int CW_BAR = 4096;

constexpr int RING_OFF = 0, RING_BYTES = 131072;
constexpr int KSA = 272, KSB = 144;
constexpr int SCRATCH_BYTES = 2 * 256 * KSA;
constexpr int LDSCTL_OFF = SCRATCH_BYTES, MISC_OFF = LDSCTL_OFF + 320;
constexpr int LDS_BYTES = 147456;
static_assert(MISC_OFF + 128 <= LDS_BYTES && 8 * 64 * 65 * 4 <= SCRATCH_BYTES && RING_BYTES <= SCRATCH_BYTES, "LDS map");

#define GAS __attribute__((address_space(1)))
#define LAS __attribute__((address_space(3)))
typedef unsigned short bf16;
typedef unsigned v4u __attribute__((ext_vector_type(4)));
typedef float f32x4 __attribute__((ext_vector_type(4)));
typedef short bf16x8 __attribute__((ext_vector_type(8)));
typedef GAS unsigned gu32;
typedef GAS unsigned long long gu64;
#define RLX_AGENT __ATOMIC_RELAXED, __HIP_MEMORY_SCOPE_AGENT
#define LDS_WAIT() asm volatile("s_waitcnt lgkmcnt(0)" ::: "memory")
#define VM_WAIT() asm volatile("s_waitcnt vmcnt(0)" ::: "memory")
__device__ __forceinline__ unsigned long long rt() { return __builtin_amdgcn_s_memrealtime(); }
__device__ __forceinline__ unsigned f2bf(float f) { unsigned u = __builtin_bit_cast(unsigned, f); return (u + 0x7fffu + ((u >> 16) & 1u)) >> 16; }
__device__ __forceinline__ unsigned pk2(float lo, float hi) { return f2bf(lo) | (f2bf(hi) << 16); }

#define XB_TMO      128
#define XB_XCNT(j)  (256  + 64 * (j))
#define XB_XSUB(j)  (1280 + 64 * (j))
#define XB_XGEN(j)  (2304 + 64 * (j))
#define XB_TOP      3328
#define XB_TOPGEN   3392
#define XCD_BAR_WORDS 3456
#define XB_SPIN_CAP (1u << 18)

__device__ __forceinline__ unsigned xb_ld(unsigned* p)              { return __hip_atomic_load((GAS unsigned*)p, __ATOMIC_RELAXED, __HIP_MEMORY_SCOPE_AGENT); }
__device__ __forceinline__ unsigned xb_add(unsigned* p, unsigned v) { return __hip_atomic_fetch_add((GAS unsigned*)p, v, __ATOMIC_RELAXED, __HIP_MEMORY_SCOPE_AGENT); }
__device__ __forceinline__ unsigned xb_xcc_id() { return (unsigned)__builtin_amdgcn_s_getreg((3 << 11) | 20) & 0xFu; }
#define XB_SPIN(cond, bar) do { unsigned _sp = 0; while (cond) { __builtin_amdgcn_s_sleep(1); \
    if ((++_sp & 255u) == 0u) { if (xb_ld(&(bar)[XB_TMO])) break; if (_sp > XB_SPIN_CAP) { (void)xb_add(&(bar)[XB_TMO], 1u); break; } } } } while (0)

struct XcdBarrier {
    unsigned* bar; unsigned x;
    volatile LAS unsigned* st;
};

__device__ __forceinline__ XcdBarrier xcd_barrier_post(unsigned* bar, volatile LAS unsigned* st) {
    XcdBarrier b; b.bar = bar; b.x = xb_xcc_id(); b.st = st;
    if (threadIdx.x == 0) (void)xb_add(&bar[XB_XCNT(b.x)], 1u);
    return b;
}
__device__ __forceinline__ void xcd_barrier_complete(unsigned* bar, unsigned x, unsigned& nloc, unsigned& nx) {
    const unsigned G = gridDim.x * gridDim.y * gridDim.z;
    unsigned sum, cnt, mine, sp = 0u;
    for (;;) {
        sum = 0u; cnt = 0u; mine = 0u;
#pragma unroll
        for (unsigned j = 0; j < 16; ++j) { const unsigned c = xb_ld(&bar[XB_XCNT(j)]); sum += c; cnt += (c > 0u) ? 1u : 0u; mine = (j == x) ? c : mine; }
        if (sum == G) break;
        __builtin_amdgcn_s_sleep(1);
        if ((++sp & 255u) == 0u) { if (xb_ld(&bar[XB_TMO])) break; if (sp > XB_SPIN_CAP) { (void)xb_add(&bar[XB_TMO], 1u); break; } }
    }
    nloc = mine > 0u ? mine : 1u; nx = cnt > 0u ? cnt : 1u;
}

__device__ __forceinline__ void xcd_barrier(const XcdBarrier& b) {
    asm volatile("s_waitcnt vmcnt(0)" ::: "memory");
    __syncthreads();
    if (threadIdx.x == 0) {
        unsigned* bar = b.bar; unsigned bx = b.x; asm volatile("" : "+s"(bar), "+s"(bx));
        __builtin_amdgcn_s_waitcnt(0);
        unsigned nloc = b.st[0], nx = b.st[1];
        if (nloc == 0u) { xcd_barrier_complete(bar, bx, nloc, nx); b.st[0] = nloc; b.st[1] = nx; }
        const unsigned old = xb_add(&bar[XB_XSUB(bx)], 1u);
        const unsigned gen = old / nloc;
        if (old + 1u == (gen + 1u) * nloc) {
            __builtin_amdgcn_fence(__ATOMIC_RELEASE, "agent");
            asm volatile("s_waitcnt vmcnt(0)" ::: "memory");
            const unsigned og = xb_add(&bar[XB_TOP], 1u);
            const unsigned tg = og / nx;
            if (og + 1u == (tg + 1u) * nx) xb_add(&bar[XB_TOPGEN], 1u);
            else XB_SPIN(xb_ld(&bar[XB_TOPGEN]) == tg, bar);
            __builtin_amdgcn_fence(__ATOMIC_ACQUIRE, "agent");
            xb_add(&bar[XB_XGEN(bx)], 1u);
            asm volatile("s_waitcnt vmcnt(0)" ::: "memory");
        } else {
            XB_SPIN(xb_ld(&bar[XB_XGEN(bx)]) == gen, bar);
            __builtin_amdgcn_fence(__ATOMIC_ACQUIRE, "agent");
            asm volatile("s_waitcnt vmcnt(0)" ::: "memory");
        }
    }
    __syncthreads();
}

typedef short v4i16_t __attribute__((ext_vector_type(4)));
typedef GAS const float gcf; typedef GAS float gf; typedef GAS bf16 gbf; typedef GAS const bf16 gcbf;
typedef float f32x2v __attribute__((ext_vector_type(2)));
typedef __bf16 bf16x2v __attribute__((ext_vector_type(2)));
__device__ __forceinline__ unsigned cvtpk(float lo, float hi) { f32x2v v = {lo, hi}; bf16x2v b = __builtin_convertvector(v, bf16x2v); return __builtin_bit_cast(unsigned, b); }
__device__ __forceinline__ float bflo(unsigned w) { return __uint_as_float(w << 16); }
__device__ __forceinline__ float bfhi(unsigned w) { return __uint_as_float(w & 0xffff0000u); }

struct Frame {
    LAS unsigned char* lds;
    volatile LAS unsigned* MISC;
    gu32* ctl;
    int tid, lane, wave;
    int vcu, G, bid;
};

__device__ __forceinline__ float wave_sum(float v) {
#pragma unroll
    for (int o = 1; o < 64; o <<= 1) v += __shfl_xor(v, o);
    return v;
}

__device__ __forceinline__ int win_dst_col(int c) {
    if (c < VA_OFF) { const int d = c & 127; if (d < 32) { const int nd = d < 16 ? 8 * (d >> 2) + (d & 3) : 8 * ((d - 16) >> 2) + 4 + (d & 3); return c - d + nd; } return c; }
    if (c >= QB_OFF && c < VB_OFF) { const int d = c & 63; if (d < 16) { const int nd = d < 8 ? 8 * (d >> 2) + (d & 3) : 8 * ((d - 8) >> 2) + 4 + (d & 3); return c - d + nd; } return c; }
    return c;
}
template <bool PERM_IN>
__device__ __forceinline__ void p0_transpose_item(gcf* W, int K, int N, gbf* WT, LAS float* scr, int item, int lane) {
    const int nblk = N >> 6, kb = item / nblk, nb = item - kb * nblk, k0 = 64 * kb, n0 = 64 * nb;
    const GAS f32x4* src = (const GAS f32x4*)(W + (size_t)(k0 + (lane >> 4)) * N + n0 + 4 * (lane & 15));
    f32x4 v[16];
#pragma unroll
    for (int i = 0; i < 16; ++i) v[i] = src[(size_t)i * N];
#pragma unroll
    for (int i = 0; i < 16; ++i) { LAS float* d = scr + (4 * i + (lane >> 4)) * 65 + 4 * (lane & 15); d[0] = v[i][0]; d[1] = v[i][1]; d[2] = v[i][2]; d[3] = v[i][3]; }
    LDS_WAIT(); asm volatile("" ::: "memory");
    const int c = lane & 7;
#pragma unroll
    for (int j = 0; j < 8; ++j) { const int n = (lane >> 3) + 8 * j; const LAS float* s = scr + (8 * c) * 65 + n;
        v4u o; o.x = cvtpk(s[0 * 65], s[1 * 65]); o.y = cvtpk(s[2 * 65], s[3 * 65]); o.z = cvtpk(s[4 * 65], s[5 * 65]); o.w = cvtpk(s[6 * 65], s[7 * 65]);
        const int row = PERM_IN ? win_dst_col(n0 + n) : n0 + n;
        *(GAS v4u*)(WT + (size_t)row * K + k0 + 8 * c) = o; }
    LDS_WAIT(); asm volatile("" ::: "memory");
}
__device__ __forceinline__ void sincos_d(double a, float& c, float& s) {
    const double q = __builtin_rint(a * 0.63661977236758134308);
    const double r = (a - q * 1.5707963267948966192) - q * 6.123233995736766036e-17;
    const double r2 = r * r;
    const double sn = r * (1.0 + r2 * (-1.0 / 6 + r2 * (1.0 / 120 + r2 * (-1.0 / 5040 + r2 * (1.0 / 362880 + r2 * (-1.0 / 39916800 + r2 * (1.0 / 6227020800.0)))))));
    const double cs = 1.0 + r2 * (-0.5 + r2 * (1.0 / 24 + r2 * (-1.0 / 720 + r2 * (1.0 / 40320 + r2 * (-1.0 / 3628800 + r2 * (1.0 / 479001600 + r2 * (-1.0 / 87178291200.0)))))));
    const int qi = (int)q & 3;
    const double sv = (qi == 0) ? sn : (qi == 1) ? cs : (qi == 2) ? -sn : -cs;
    const double cv = (qi == 0) ? cs : (qi == 1) ? -sn : (qi == 2) ? -cs : sn;
    c = (float)cv; s = (float)sv;
}
enum { PT_X, PT_POS, PT_WIN, PT_WPA, PT_WPB, PT_WOUT, PT_SINKS, PT_LN1G, PT_LN1B, PT_WUP, PT_CW, PT_CB, PT_WDN, PT_LN2G, PT_LN2B, PT_OUT, PT_WS, PT_N };
struct Ptrs { const void* p[PT_N]; };
__device__ __forceinline__ GAS unsigned char* ldptr(const Frame& F, int i) {
    volatile LAS unsigned long long* t = (volatile LAS unsigned long long*)(F.lds + LDSCTL_OFF); const unsigned long long v = t[i];
    const unsigned lo = __builtin_amdgcn_readfirstlane((unsigned)v), hi = __builtin_amdgcn_readfirstlane((unsigned)(v >> 32));
    return (GAS unsigned char*)(((unsigned long long)hi << 32) | lo);
}
struct PPtrs { gcf *x, *w_in, *w_pa, *w_pb, *w_out, *w_up, *w_dn; GAS const int* pos; GAS unsigned char* ws; };
__device__ __forceinline__ void p0_prologue(Frame& F) {
    PPtrs P; P.x = (gcf*)ldptr(F, PT_X); P.w_in = (gcf*)ldptr(F, PT_WIN); P.w_pa = (gcf*)ldptr(F, PT_WPA); P.w_pb = (gcf*)ldptr(F, PT_WPB); P.w_out = (gcf*)ldptr(F, PT_WOUT);
    P.w_up = (gcf*)ldptr(F, PT_WUP); P.w_dn = (gcf*)ldptr(F, PT_WDN); P.pos = (GAS const int*)ldptr(F, PT_POS); P.ws = ldptr(F, PT_WS);
    LAS float* scr = (LAS float*)(F.lds + F.wave * (64 * 65 * 4));
    const int gw = F.vcu * NWAVES + F.wave, NGW = F.G * NWAVES;
    constexpr int I_IN = (DM / 64) * (IN_COLS / 64), I_PA = (A_OUT / 64) * (DM / 64), I_PB = (B_QW / 64) * (DM / 64), I_OUT = (DM / 64) * (DM / 64), I_UP = (DM / 64) * (UP_COLS / 64), I_DN = (DFF / 64) * (DM / 64);
    constexpr int I_LAYER = I_IN + I_PA + I_PB + I_OUT + I_UP + I_DN;
    for (int it = gw; it < DEPTH * I_LAYER; it += NGW) {
        const int l = it / I_LAYER; int r = it - l * I_LAYER;
        GAS unsigned char* wl = P.ws + WS_W + (size_t)l * LW_BYTES;
        if (r < I_IN) { p0_transpose_item<true>(P.w_in + (size_t)l * DM * IN_COLS, DM, IN_COLS, (gbf*)(wl + LW_IN), scr, r, F.lane); continue; } r -= I_IN;
        if (r < I_PA) { p0_transpose_item<false>(P.w_pa + (size_t)l * A_OUT * DM, A_OUT, DM, (gbf*)(wl + LW_PA), scr, r, F.lane); continue; } r -= I_PA;
        if (r < I_PB) { p0_transpose_item<false>(P.w_pb + (size_t)l * B_QW * DM, B_QW, DM, (gbf*)(wl + LW_PB), scr, r, F.lane); continue; } r -= I_PB;
        if (r < I_OUT) { p0_transpose_item<false>(P.w_out + (size_t)l * DM * DM, DM, DM, (gbf*)(wl + LW_OUT), scr, r, F.lane); continue; } r -= I_OUT;
        if (r < I_UP) { p0_transpose_item<false>(P.w_up + (size_t)l * DM * UP_COLS, DM, UP_COLS, (gbf*)(wl + LW_UP), scr, r, F.lane); continue; } r -= I_UP;
        p0_transpose_item<false>(P.w_dn + (size_t)l * DFF * DM, DFF, DM, (gbf*)(wl + LW_DN), scr, r, F.lane);
    }
    { const int gt = F.vcu * (NWAVES * 64) + F.tid, NT = F.G * NWAVES * 64; gbf* XB = (gbf*)(P.ws + WS_XB);
      for (int i = gt; i < M * DM / 8; i += NT) { const GAS f32x4* s = (const GAS f32x4*)(P.x + (size_t)i * 8); const f32x4 a = s[0], b = s[1];
          v4u o; o.x = cvtpk(a[0], a[1]); o.y = cvtpk(a[2], a[3]); o.z = cvtpk(b[0], b[1]); o.w = cvtpk(b[2], b[3]); *(GAS v4u*)(XB + (size_t)i * 8) = o; }
      gf* ra = (gf*)(P.ws + WS_ROPEA); gf* rb = (gf*)(P.ws + WS_ROPEB);
      constexpr double INVF[16] = {1.0, 0.44036660267178046, 0.19392274474868576, 0.08539710028576561, 0.03760603093086393, 0.016560440080994446, 0.007292664737217109, 0.003211445994752591,
                                   0.001414213562373095, 0.000622772421914596, 0.0002742481756762073, 0.00012076973741146504, 5.318295896944988e-05, 2.341999896140934e-05, 1.031338537721246e-05, 4.5416704806078695e-06};
      for (int m = gt; m < M; m += NT) { const double pos = (double)P.pos[m];
#pragma unroll
          for (int j = 0; j < 16; ++j) { float c, s; sincos_d(pos * INVF[j], c, s); ra[(size_t)m * 32 + j] = c; ra[(size_t)m * 32 + 16 + j] = s;
              if ((j & 1) == 0) { rb[(size_t)m * 16 + (j >> 1)] = c; rb[(size_t)m * 16 + 8 + (j >> 1)] = s; } } }
    }
}

__device__ __forceinline__ void ln_phase(Frame& F, gcf* H, gcf* g, gcf* b, gf* XF, gbf* XB) {
    const int gw = F.vcu * NWAVES + F.wave, NGW = F.G * NWAVES;
    const GAS f32x4* gp = (const GAS f32x4*)g + F.lane; const GAS f32x4* bp = (const GAS f32x4*)b + F.lane;
    for (int m = gw; m < M; m += NGW) {
        const GAS f32x4* hr = (const GAS f32x4*)(H + (size_t)m * DM) + F.lane;
        f32x4 v[16]; float s = 0.f;
#pragma unroll
        for (int j = 0; j < 16; ++j) { v[j] = hr[64 * j]; s += (v[j][0] + v[j][1]) + (v[j][2] + v[j][3]); }
        const float mean = wave_sum(s) * (1.f / DM); float s2 = 0.f;
#pragma unroll
        for (int j = 0; j < 16; ++j) { v[j] = v[j] - mean; s2 += (v[j][0] * v[j][0] + v[j][1] * v[j][1]) + (v[j][2] * v[j][2] + v[j][3] * v[j][3]); }
        const float rstd = 1.f / sqrtf(wave_sum(s2) * (1.f / DM) + LN_EPS);
        GAS f32x4* of = (GAS f32x4*)(XF + (size_t)m * DM) + F.lane;
        GAS unsigned long long* ob = (GAS unsigned long long*)(XB + (size_t)m * DM) + F.lane;
#pragma unroll
        for (int j = 0; j < 16; ++j) { const f32x4 y = v[j] * rstd * gp[64 * j] + bp[64 * j]; of[64 * j] = y;
            ob[64 * j] = (unsigned long long)cvtpk(y[0], y[1]) | ((unsigned long long)cvtpk(y[2], y[3]) << 32); }
    }
}

__device__ __forceinline__ void conv_phase(Frame& F, gcbf* U, gcf* cw, gcf* cb, gbf* HA) {
    const int gt = F.vcu * (NWAVES * 64) + F.tid, NT = F.G * NWAVES * 64;
    for (int item = gt; item < (DFF / 8) * (M / 64); item += NT) {
        const int c0 = 8 * (item & (DFF / 8 - 1)), t0 = 64 * (item >> 10);
        f32x4 wg[3][2], wv[3][2], bg[2], bv[2];
#pragma unroll
        for (int h = 0; h < 2; ++h) {
#pragma unroll
            for (int i = 0; i < 3; ++i) { wg[i][h] = *(const GAS f32x4*)(cw + (size_t)i * UP_COLS + c0 + 4 * h); wv[i][h] = *(const GAS f32x4*)(cw + (size_t)i * UP_COLS + DFF + c0 + 4 * h); }
            bg[h] = *(const GAS f32x4*)(cb + c0 + 4 * h); bv[h] = *(const GAS f32x4*)(cb + DFF + c0 + 4 * h); }
        f32x4 g1[2], g2[2], v1[2], v2[2];
        const bool first = (t0 & (SEQ - 1)) == 0;
        { const int ta = first ? t0 : t0 - 1, tb = first ? t0 : t0 - 2;
          const v4u a = *(const GAS v4u*)(U + (size_t)ta * UP_COLS + c0), av = *(const GAS v4u*)(U + (size_t)ta * UP_COLS + DFF + c0);
          const v4u b = *(const GAS v4u*)(U + (size_t)tb * UP_COLS + c0), bw = *(const GAS v4u*)(U + (size_t)tb * UP_COLS + DFF + c0);
          const float z = first ? 0.f : 1.f;
          g1[0] = (f32x4){bflo(a.x), bfhi(a.x), bflo(a.y), bfhi(a.y)} * z; g1[1] = (f32x4){bflo(a.z), bfhi(a.z), bflo(a.w), bfhi(a.w)} * z;
          v1[0] = (f32x4){bflo(av.x), bfhi(av.x), bflo(av.y), bfhi(av.y)} * z; v1[1] = (f32x4){bflo(av.z), bfhi(av.z), bflo(av.w), bfhi(av.w)} * z;
          g2[0] = (f32x4){bflo(b.x), bfhi(b.x), bflo(b.y), bfhi(b.y)} * z; g2[1] = (f32x4){bflo(b.z), bfhi(b.z), bflo(b.w), bfhi(b.w)} * z;
          v2[0] = (f32x4){bflo(bw.x), bfhi(bw.x), bflo(bw.y), bfhi(bw.y)} * z; v2[1] = (f32x4){bflo(bw.z), bfhi(bw.z), bflo(bw.w), bfhi(bw.w)} * z; }
#pragma unroll 4
        for (int t = t0; t < t0 + 64; ++t) {
            const v4u a = *(const GAS v4u*)(U + (size_t)t * UP_COLS + c0), av = *(const GAS v4u*)(U + (size_t)t * UP_COLS + DFF + c0);
            f32x4 gc[2], vc[2], hh[2];
            gc[0] = (f32x4){bflo(a.x), bfhi(a.x), bflo(a.y), bfhi(a.y)}; gc[1] = (f32x4){bflo(a.z), bfhi(a.z), bflo(a.w), bfhi(a.w)};
            vc[0] = (f32x4){bflo(av.x), bfhi(av.x), bflo(av.y), bfhi(av.y)}; vc[1] = (f32x4){bflo(av.z), bfhi(av.z), bflo(av.w), bfhi(av.w)};
#pragma unroll
            for (int h = 0; h < 2; ++h) {
                const f32x4 ug = wg[0][h] * g2[h] + wg[1][h] * g1[h] + wg[2][h] * gc[h] + bg[h];
                const f32x4 uv = wv[0][h] * v2[h] + wv[1][h] * v1[h] + wv[2][h] * vc[h] + bv[h];
#pragma unroll
                for (int j = 0; j < 4; ++j) hh[h][j] = ug[j] * sigmoidf_dev(ug[j]) * uv[j];
                g2[h] = g1[h]; g1[h] = gc[h]; v2[h] = v1[h]; v1[h] = vc[h]; }
            v4u o; o.x = cvtpk(hh[0][0], hh[0][1]); o.y = cvtpk(hh[0][2], hh[0][3]); o.z = cvtpk(hh[1][0], hh[1][1]); o.w = cvtpk(hh[1][2], hh[1][3]);
            *(GAS v4u*)(HA + (size_t)t * DFF + c0) = o;
        }
    }
}

__device__ __forceinline__ v4i16_t vtr(const LAS unsigned char* p) { return __builtin_amdgcn_ds_read_tr16_b64_v4i16((LAS v4i16_t*)p); }
template <int HD, int KS, int MAXD>
__device__ __forceinline__ void attn_wave(const LAS unsigned char* Kl, const LAS unsigned char* Vl, const bf16x8 (&qf)[HD / 32], int w, int lane, bool first_blk, float sink2, bool has_sink,
                                          f32x4 (&o)[HD / 16], float& mx_out, float& l_out) {
    int lane_o = lane; asm volatile("" : "+v"(lane_o));
    const int fr = lane_o & 15, fq = lane_o >> 4, sb = 32 * (w >> 1);
    f32x4 S[10];
#pragma unroll
    for (int ks = 0; ks < 5; ++ks)
#pragma unroll
        for (int t = 0; t < 2; ++t) { const int T = 2 * ks + t; S[T] = (f32x4){0.f, 0.f, 0.f, 0.f};
            const LAS unsigned char* kp = Kl + (sb + 32 * ks + 8 * (fr >> 2) + 4 * t + (fr & 3)) * KS + 16 * fq;
#pragma unroll
            for (int kk = 0; kk < HD / 32; ++kk) { const bf16x8 a = *(const LAS bf16x8*)(kp + 64 * kk); S[T] = __builtin_amdgcn_mfma_f32_16x16x32_bf16(a, qf[kk], S[T], 0, 0, 0); } }
    const int iq = 128 + 16 * w + fr; float mx = -INFINITY;
#pragma unroll
    for (int ks = 0; ks < 5; ++ks)
#pragma unroll
        for (int t = 0; t < 2; ++t)
#pragma unroll
            for (int r = 0; r < 4; ++r) { const int j = sb + 32 * ks + 8 * fq + 4 * t + r, d = iq - j; const bool ok = (d >= 0) && (d <= MAXD) && (!first_blk || j >= 128);
                const float s = ok ? S[2 * ks + t][r] : -INFINITY; S[2 * ks + t][r] = s; mx = fmaxf(mx, s); }
    mx = fmaxf(mx, __shfl_xor(mx, 16)); mx = fmaxf(mx, __shfl_xor(mx, 32));
    if (has_sink) mx = fmaxf(mx, sink2);
    float l = 0.f;
#pragma unroll
    for (int T = 0; T < 10; ++T)
#pragma unroll
        for (int r = 0; r < 4; ++r) { const float p = __builtin_amdgcn_exp2f(S[T][r] - mx); S[T][r] = p; l += p; }
    l += __shfl_xor(l, 16); l += __shfl_xor(l, 32);
    if (has_sink) l += __builtin_amdgcn_exp2f(sink2 - mx);
    bf16x8 pf[5];
#pragma unroll
    for (int ks = 0; ks < 5; ++ks) { v4u pw; pw.x = cvtpk(S[2 * ks][0], S[2 * ks][1]); pw.y = cvtpk(S[2 * ks][2], S[2 * ks][3]); pw.z = cvtpk(S[2 * ks + 1][0], S[2 * ks + 1][1]); pw.w = cvtpk(S[2 * ks + 1][2], S[2 * ks + 1][3]);
        pf[ks] = __builtin_bit_cast(bf16x8, pw); }
    const LAS unsigned char* vp = Vl + (sb + 8 * fq + ((lane_o & 15) >> 2)) * KS + 8 * (lane_o & 3);
#pragma unroll
    for (int dt = 0; dt < HD / 16; ++dt) { o[dt] = (f32x4){0.f, 0.f, 0.f, 0.f};
#pragma unroll
        for (int ks = 0; ks < 5; ++ks) { const v4i16_t lo = vtr(vp + (32 * ks) * KS + 32 * dt), hi = vtr(vp + (32 * ks + 4) * KS + 32 * dt);
            const bf16x8 vf = (bf16x8){lo[0], lo[1], lo[2], lo[3], hi[0], hi[1], hi[2], hi[3]};
            o[dt] = __builtin_amdgcn_mfma_f32_16x16x32_bf16(vf, pf[ks], o[dt], 0, 0, 0); } }
    mx_out = mx; l_out = l;
}

__device__ __forceinline__ void attnA_phase(Frame& F, gcbf* PROJ, gf* OG, gf* LSE) {
    LAS unsigned char* Kl = F.lds; LAS unsigned char* Vl = F.lds + 256 * KSA;
    const int lane = F.lane, w = F.wave, fr = lane & 15, fq = lane >> 4;
    for (int u = F.bid; u < 768; u += F.G) {
        const int b = u / 384, h = (u >> 5) % 12, cq = u & 31, grp = h >> 2, slot = h & 3;
        const int lr = 2 * grp;
        const int c = cq >> (5 - lr), qb = cq & ((32 >> lr) - 1);
        gcbf* kbase = PROJ + KA_OFF + h * 128; gcbf* vbase = PROJ + VA_OFF + h * 128;
        v4u kv[8], vv[8];
#pragma unroll
        for (int i = 0; i < 8; ++i) { const int rho = 32 * i + (F.tid >> 4), ch = F.tid & 15, p = 128 * (qb - 1) + rho, pc = p < 0 ? 0 : p;
            const size_t m = (size_t)b * SEQ + ((size_t)pc << lr) + c;
            kv[i] = *(const GAS v4u*)(kbase + m * IN_COLS + 8 * ch); vv[i] = *(const GAS v4u*)(vbase + m * IN_COLS + 8 * ch); }
        const int pq = 128 * qb + 16 * w + fr; const size_t mq = (size_t)b * SEQ + ((size_t)pq << lr) + c;
        bf16x8 qf[4];
#pragma unroll
        for (int kk = 0; kk < 4; ++kk) qf[kk] = *(const GAS bf16x8*)(PROJ + mq * IN_COLS + h * 128 + 32 * kk + 8 * fq);
#pragma unroll
        for (int i = 0; i < 8; ++i) { const int rho = 32 * i + (F.tid >> 4), ch = F.tid & 15; const bool z = (128 * (qb - 1) + rho) < 0;
            if (z) { kv[i] = (v4u){0u, 0u, 0u, 0u}; vv[i] = (v4u){0u, 0u, 0u, 0u}; }
            *(LAS v4u*)(Kl + rho * KSA + 16 * ch) = kv[i]; *(LAS v4u*)(Vl + rho * KSA + 16 * ch) = vv[i]; }
        __syncthreads();
        f32x4 o[8]; float mx, l;
        attn_wave<128, KSA, 128>(Kl, Vl, qf, w, lane, qb == 0, 0.f, false, o, mx, l);
        const float inv = 1.0f / l;
        gf* op = OG + ((size_t)grp * M + mq) * 512 + slot * 128 + 4 * fq;
#pragma unroll
        for (int dt = 0; dt < 8; ++dt) *(GAS f32x4*)(op + 16 * dt) = o[dt] * inv;
        if (fq == 0) LSE[((size_t)grp * M + mq) * 4 + slot] = mx + __builtin_amdgcn_logf(l);
        __syncthreads();
    }
}
__device__ __forceinline__ void attnB_phase(Frame& F, gcbf* PROJ, gcf* sinks, gbf* YB) {
    LAS unsigned char* Kl = F.lds; LAS unsigned char* Vl = F.lds + 256 * KSB;
    const int lane = F.lane, w = F.wave, fr = lane & 15, fq = lane >> 4;
    for (int u = F.bid; u < 256; u += F.G) {
        const int b = u >> 7, kvh = (u >> 5) & 3, qb = u & 31;
        gcbf* kbase = PROJ + KB_OFF + kvh * 64; gcbf* vbase = PROJ + VB_OFF + kvh * 64;
        v4u kv[4], vv[4];
#pragma unroll
        for (int i = 0; i < 4; ++i) { const int idx = 512 * i + F.tid, rho = idx >> 3, ch = idx & 7, t = 128 * (qb - 1) + rho, tc = t < 0 ? 0 : t;
            const size_t m = (size_t)b * SEQ + tc;
            kv[i] = *(const GAS v4u*)(kbase + m * IN_COLS + 8 * ch); vv[i] = *(const GAS v4u*)(vbase + m * IN_COLS + 8 * ch); }
#pragma unroll
        for (int i = 0; i < 4; ++i) { const int idx = 512 * i + F.tid, rho = idx >> 3, ch = idx & 7; const bool z = (128 * (qb - 1) + rho) < 0;
            if (z) { kv[i] = (v4u){0u, 0u, 0u, 0u}; vv[i] = (v4u){0u, 0u, 0u, 0u}; }
            *(LAS v4u*)(Kl + rho * KSB + 16 * ch) = kv[i]; *(LAS v4u*)(Vl + rho * KSB + 16 * ch) = vv[i]; }
        __syncthreads();
        const size_t mq = (size_t)b * SEQ + 128 * qb + 16 * w + fr;
#pragma unroll 1
        for (int g = 0; g < 8; ++g) { const int hq = kvh * 8 + g;
            bf16x8 qf[2];
#pragma unroll
            for (int kk = 0; kk < 2; ++kk) qf[kk] = *(const GAS bf16x8*)(PROJ + mq * IN_COLS + QB_OFF + hq * 64 + 32 * kk + 8 * fq);
            f32x4 o[4]; float mx, l;
            attn_wave<64, KSB, 127>(Kl, Vl, qf, w, lane, qb == 0, sinks[hq] * LOG2E, true, o, mx, l);
            const float inv = 1.0f / l;
            gbf* op = YB + mq * B_QW + hq * 64 + 4 * fq;
#pragma unroll
            for (int dt = 0; dt < 4; ++dt) { const f32x4 y = o[dt] * inv; *(GAS unsigned long long*)(op + 16 * dt) = (unsigned long long)cvtpk(y[0], y[1]) | ((unsigned long long)cvtpk(y[2], y[3]) << 32); } }
        __syncthreads();
    }
}
__device__ __forceinline__ void combine_phase(Frame& F, gcf* OG, gcf* LSE, gbf* YA) {
    const int gt = F.vcu * (NWAVES * 64) + F.tid, NT = F.G * NWAVES * 64;
    for (int item = gt; item < M * 128; item += NT) {
        const int m = item >> 7, j = (item >> 5) & 3, d4 = item & 31;
        const float l0 = LSE[((size_t)0 * M + m) * 4 + j], l1 = LSE[((size_t)1 * M + m) * 4 + j], l2 = LSE[((size_t)2 * M + m) * 4 + j];
        const float mx = fmaxf(l0, fmaxf(l1, l2));
        const float e0 = __builtin_amdgcn_exp2f(l0 - mx), e1 = __builtin_amdgcn_exp2f(l1 - mx), e2 = __builtin_amdgcn_exp2f(l2 - mx), inv = 1.0f / (e0 + e1 + e2);
        const size_t off = (size_t)m * 512 + j * 128 + 4 * d4;
        const f32x4 a = *(const GAS f32x4*)(OG + off), bq = *(const GAS f32x4*)(OG + (size_t)M * 512 + off), cq = *(const GAS f32x4*)(OG + (size_t)2 * M * 512 + off);
        const f32x4 y = (a * e0 + bq * e1 + cq * e2) * inv;
        *(GAS unsigned long long*)(YA + off) = (unsigned long long)cvtpk(y[0], y[1]) | ((unsigned long long)cvtpk(y[2], y[3]) << 32);
    }
}

struct Args { Ptrs p; int ph_lo, ph_hi; };
__global__ void __launch_bounds__(NWAVES * 64, 2) fwd_kernel(Args args) {
    extern __shared__ __attribute__((aligned(16))) unsigned char lds[];
    Frame F;
    F.lds = (LAS unsigned char*)lds;
    F.MISC = (volatile LAS unsigned*)(F.lds + MISC_OFF);
    F.tid = threadIdx.x; F.lane = F.tid & 63; F.wave = __builtin_amdgcn_readfirstlane(F.tid >> 6);
    F.bid = blockIdx.x; F.G = gridDim.x; { const int bx = blockIdx.x; F.vcu = (F.G % 8 == 0) ? (bx % 8) * (F.G / 8) + bx / 8 : bx; }
    for (int u = F.tid; u < (LDS_BYTES - LDSCTL_OFF) / 4; u += NWAVES * 64) ((LAS unsigned*)(F.lds + LDSCTL_OFF))[u] = 0u;
    __syncthreads();
    if (F.tid == 0) {
#pragma unroll
        for (int i = 0; i < PT_N; ++i) ((LAS unsigned long long*)(F.lds + LDSCTL_OFF))[i] = (unsigned long long)args.p.p[i]; }
    __syncthreads();
    F.ctl = (gu32*)(ldptr(F, PT_WS) + WS_CTL);
    XcdBarrier bar; bar.bar = (unsigned*)(F.ctl + CW_BAR); bar.x = 0; bar.st = nullptr;
    if (!MK_PER_PHASE) bar = xcd_barrier_post((unsigned*)(F.ctl + CW_BAR), F.MISC + 8);
#define GRID_BAR() do { if (MK_PER_PHASE) { if (F.tid == 0) __hip_atomic_store(F.ctl + CW_TMO, 0xBADBA0u, RLX_AGENT); } else { xcd_barrier(bar); } } while (0)
    const int lo = args.ph_lo, hi = args.ph_hi;
#define IN(k) (lo <= (k) && (k) < hi)
#define SEAM(k) do { if (IN((k) + 1)) GRID_BAR(); } while (0)
#define WSP(T, off) ((GAS T*)(ldptr(F, PT_WS) + (off)))
#define INP(T, i) ((GAS const T*)ldptr(F, (i)))
#define PHASE_IDS() int bid = blockIdx.x; asm volatile("" : "+s"(bid)); Frame Fp = F; asm volatile("" : "+v"(Fp.tid)); Fp.lane = Fp.tid & 63; Fp.wave = __builtin_amdgcn_readfirstlane(Fp.tid >> 6); asm volatile("" : "+s"(Fp.vcu)); Fp.bid = bid

    if (IN(0)) { PHASE_IDS(); p0_prologue(Fp); SEAM(0); }

    for (int l = 0; l < DEPTH; ++l) {
        const int g0 = 1 + l * PH_PER_LAYER;
        const size_t wl = WS_W + (size_t)l * LW_BYTES;

        if (IN(g0 + 0)) { PHASE_IDS();
            pg8::Gemm g{(const bf16*)WSP(bf16, WS_XB), (const bf16*)WSP(bf16, wl + LW_IN), M, IN_COLS, DM}; pg8::StaticOrder S; S.init(M, IN_COLS, F.G, bid);
            pg8::EpiIn E{WSP(bf16, WS_PROJ), WSP(float, WS_ROPEA), WSP(float, WS_ROPEB)};
            pg8::gemm_phase<pg8::EpiIn, pg8::StaticOrder, true, true>(F.lds + RING_OFF, g, S, E);
            SEAM(g0 + 0);
        }
        if (IN(g0 + 1)) { PHASE_IDS(); attnA_phase(Fp, WSP(bf16, WS_PROJ), WSP(float, WS_OG), WSP(float, WS_LSE)); SEAM(g0 + 1); }
        if (IN(g0 + 2)) { PHASE_IDS(); attnB_phase(Fp, WSP(bf16, WS_PROJ), INP(float, PT_SINKS) + l * 32, WSP(bf16, WS_YB)); combine_phase(Fp, WSP(float, WS_OG), WSP(float, WS_LSE), WSP(bf16, WS_YA)); SEAM(g0 + 2); }
        if (IN(g0 + 3)) { PHASE_IDS();
            { pg8::Gemm g{(const bf16*)WSP(bf16, WS_YA), (const bf16*)WSP(bf16, wl + LW_PA), M, DM, A_OUT}; pg8::StaticOrder S; S.init(M, DM, F.G, bid);
              pg8::EpiGate<false> E{WSP(bf16, WS_MG), WSP(bf16, WS_PROJ) + G_OFF};
              pg8::gemm_phase<pg8::EpiGate<false>, pg8::StaticOrder, true, true>(F.lds + RING_OFF, g, S, E); }
            { pg8::Gemm g{(const bf16*)WSP(bf16, WS_YB), (const bf16*)WSP(bf16, wl + LW_PB), M, DM, B_QW}; pg8::StaticOrder S; S.init(M, DM, F.G, bid);
              pg8::EpiGate<true> E{WSP(bf16, WS_MG), WSP(bf16, WS_PROJ) + G_OFF + DM};
              pg8::gemm_phase<pg8::EpiGate<true>, pg8::StaticOrder, true, true>(F.lds + RING_OFF, g, S, E); }
            SEAM(g0 + 3);
        }
        if (IN(g0 + 4)) { PHASE_IDS();
            pg8::Gemm g{(const bf16*)WSP(bf16, WS_MG), (const bf16*)WSP(bf16, wl + LW_OUT), M, DM, DM}; pg8::StaticOrder S; S.init(M, DM, F.G, bid);
            pg8::EpiRes E{(l == 0) ? INP(float, PT_X) : WSP(float, WS_XF), WSP(float, WS_HF)};
            pg8::gemm_phase<pg8::EpiRes, pg8::StaticOrder, true, true>(F.lds + RING_OFF, g, S, E);
            SEAM(g0 + 4);
        }
        if (IN(g0 + 5)) { PHASE_IDS(); ln_phase(Fp, WSP(float, WS_HF), INP(float, PT_LN1G) + l * DM, INP(float, PT_LN1B) + l * DM, WSP(float, WS_XF), WSP(bf16, WS_XB)); SEAM(g0 + 5); }
        if (IN(g0 + 6)) { PHASE_IDS();
            pg8::Gemm g{(const bf16*)WSP(bf16, WS_XB), (const bf16*)WSP(bf16, wl + LW_UP), M, UP_COLS, DM}; pg8::StaticOrder S; S.init(M, UP_COLS, F.G, bid);
            pg8::EpiPlain E{WSP(bf16, WS_U), UP_COLS};
            pg8::gemm_phase<pg8::EpiPlain, pg8::StaticOrder, true, true>(F.lds + RING_OFF, g, S, E);
            SEAM(g0 + 6);
        }
        if (IN(g0 + 7)) { PHASE_IDS(); conv_phase(Fp, WSP(bf16, WS_U), INP(float, PT_CW) + (size_t)l * 3 * UP_COLS, INP(float, PT_CB) + (size_t)l * UP_COLS, WSP(bf16, WS_HA)); SEAM(g0 + 7); }
        if (IN(g0 + 8)) { PHASE_IDS();
            pg8::Gemm g{(const bf16*)WSP(bf16, WS_HA), (const bf16*)WSP(bf16, wl + LW_DN), M, DM, DFF}; pg8::StaticOrder S; S.init(M, DM, F.G, bid);
            pg8::EpiRes E{WSP(float, WS_XF), WSP(float, WS_HF)};
            pg8::gemm_phase<pg8::EpiRes, pg8::StaticOrder, true, true>(F.lds + RING_OFF, g, S, E);
            SEAM(g0 + 8);
        }
        if (IN(g0 + 9)) { PHASE_IDS(); ln_phase(Fp, WSP(float, WS_HF), INP(float, PT_LN2G) + l * DM, INP(float, PT_LN2B) + l * DM, (l == DEPTH - 1) ? (GAS float*)ldptr(F, PT_OUT) : WSP(float, WS_XF), WSP(bf16, WS_XB)); if (l + 1 < DEPTH) SEAM(g0 + 9); }
    }
#undef IN
#undef SEAM
#undef GRID_BAR
#undef WSP
#undef INP
#undef PHASE_IDS
}

extern "C" void kernel_launch(void* const* d_in, const int* in_sizes, int n_in, void* d_out, int out_size, void* d_ws, size_t ws_size, hipStream_t stream) {
    static int grid = 0;
    if (grid == 0) {
        if (n_in != 15 || in_sizes[0] != M * DM || out_size != M * DM || ws_size < WS_END) { fprintf(stderr, "kernel_launch: shape/workspace mismatch (n_in %d, in0 %d, out %d, ws %zu, need %zu); nothing launched\n", n_in, n_in > 0 ? in_sizes[0] : -1, out_size, ws_size, (size_t)WS_END); grid = -1; return; }
        int dev = 0, cus = 0, per_cu = 0;
        if (hipGetDevice(&dev) != hipSuccess || hipDeviceGetAttribute(&cus, hipDeviceAttributeMultiprocessorCount, dev) != hipSuccess) { fprintf(stderr, "kernel_launch: hipGetDevice / hipDeviceGetAttribute failed; nothing launched\n"); grid = -1; return; }
        if (hipFuncSetAttribute((const void*)fwd_kernel, hipFuncAttributeMaxDynamicSharedMemorySize, LDS_BYTES) != hipSuccess) { fprintf(stderr, "kernel_launch: hipFuncSetAttribute failed; nothing launched\n"); grid = -1; return; }
        if (hipOccupancyMaxActiveBlocksPerMultiprocessor(&per_cu, (const void*)fwd_kernel, NWAVES * 64, LDS_BYTES) != hipSuccess || per_cu < 1)
            fprintf(stderr, "kernel_launch: note: the occupancy query reports %d workgroups per CU\n", per_cu);
        (void)hipGetLastError();
        grid = cus;
    }
    if (grid < 0) return;
    if (hipMemsetAsync((char*)d_ws + WS_CTL, 0, CTL_ZERO_BYTES, stream) != hipSuccess) { fprintf(stderr, "kernel_launch: hipMemsetAsync of the control words failed; nothing launched\n"); return; }
    Args a{};
    a.p.p[PT_X] = d_in[0]; a.p.p[PT_POS] = d_in[1]; a.p.p[PT_WIN] = d_in[2]; a.p.p[PT_WPA] = d_in[3]; a.p.p[PT_WPB] = d_in[4]; a.p.p[PT_WOUT] = d_in[5]; a.p.p[PT_SINKS] = d_in[6];
    a.p.p[PT_LN1G] = d_in[7]; a.p.p[PT_LN1B] = d_in[8]; a.p.p[PT_WUP] = d_in[9]; a.p.p[PT_CW] = d_in[10]; a.p.p[PT_CB] = d_in[11]; a.p.p[PT_WDN] = d_in[12]; a.p.p[PT_LN2G] = d_in[13]; a.p.p[PT_LN2B] = d_in[14];
    a.p.p[PT_OUT] = d_out; a.p.p[PT_WS] = d_ws;
#if MK_PER_PHASE
    for (int ph = 0; ph < N_PHASES; ++ph) { a.ph_lo = ph; a.ph_hi = ph + 1; hipLaunchKernelGGL(fwd_kernel, dim3(grid), dim3(NWAVES * 64), LDS_BYTES, stream, a); }
#else
    a.ph_lo = 0; a.ph_hi = N_PHASES;
    hipLaunchKernelGGL(fwd_kernel, dim3(grid), dim3(NWAVES * 64), LDS_BYTES, stream, a);
#endif
    const hipError_t le = hipPeekAtLastError();
    if (le != hipSuccess) fprintf(stderr, "kernel_launch: launch failed: %s (grid %d x %d threads, %d B LDS)\n", hipGetErrorName(le), grid, NWAVES * 64, LDS_BYTES);
}
```

```cpp
#include <hip/hip_runtime.h>
#include <cstdio>
#include <cstdint>

constexpr int BATCH = 2, SEQ = 4096, DM = 4096, DEPTH = 4;
constexpr int M = BATCH * SEQ;
constexpr int IN_COLS = 15360;
constexpr int KA_OFF = 1536, VA_OFF = 3072, QB_OFF = 4608, KB_OFF = 6656, VB_OFF = 6912, G_OFF = 7168;
constexpr int A_OUT = 512, B_QW = 2048, DFF = 8192, UP_COLS = 16384;
constexpr int YW = A_OUT + B_QW;
constexpr float LN_EPS = 1e-5f;
constexpr float DN_ALPHA = 1.6817928305074290f;
constexpr float LOG2E = 1.4426950408889634f;
constexpr float QSCALE_A = 0.08838834764831845f * LOG2E;
constexpr float QSCALE_B = 0.125f * LOG2E;
constexpr int F8_X = 123  , F8_WIN = 117  , F8_Y = 122  , F8_WPA = 117  , F8_WPB = 117  , F8_MG = 118  , F8_WOUT = 116  ;
constexpr float F8S_X = 16.f, F8S_WIN = 1024.f, F8S_Y = 32.f, F8S_WPA = 1024.f, F8S_WPB = 1024.f, F8S_MG = 512.f, F8S_WOUT = 2048.f;
constexpr int QW = 7168;
constexpr float F8S_Q = 32.f, F8S_K = 16.f, F8S_V = 16.f;
constexpr float F8S_G = 256.f;
#define MK_PER_PHASE 0
#define DBL_MASK 0
namespace pg8 {
#define PG8_LAS __attribute__((address_space(3)))
typedef unsigned short bf16_t;
typedef short bf16x8 __attribute__((ext_vector_type(8)));
typedef float f32x4 __attribute__((ext_vector_type(4)));
typedef unsigned u32x4 __attribute__((ext_vector_type(4)));
constexpr int BM = 256, BK = 64, HALF = 128, HTB = HALF * BK * 2  , STAGE_BYTES = 8 * HTB, NXCD = 8, WGM = 8;

__host__ __device__ __forceinline__ int lds_byte(int r, int c) { const int st = (r >> 4) * 2 + (c >> 5), rr = r & 15, cc = c & 31, ob = rr * 64 + cc * 2; return st * 1024 + (ob ^ (((ob >> 9) & 1) << 5)); }
__host__ __device__ __forceinline__ void stage_rc(int b, int& R, int& C) { const int st = b / 1024, sb = b % 1024, swz = sb ^ (((sb >> 9) & 1) << 5); R = (st >> 1) * 16 + swz / 64; C = (st & 1) * 32 + (swz % 64) / 2; }
__host__ __device__ __forceinline__ int perm32(int rho) { const int n = rho >> 4, i = rho & 15; return 8 * (i >> 2) + 4 * n + (i & 3); }

struct Unit { int pm, pn; };
struct Gemm { const bf16_t* A; const bf16_t* Bt; int M, N, K; };

struct StaticOrder {
    int nM, nN, nwg, G, c, i0, nr;
    __host__ __device__ void init(int M, int N, int G_, int c_) { nM = M / BM; nN = N / BM; nwg = nM * nN; G = G_; c = c_; i0 = 0; nr = 1 << 20; }
    __host__ __device__ bool next(int i, Unit& u) const {
        if (i >= nr) return false;
        const long L = (long)(i + i0) * G + c; if (L >= nwg) return false;
        int wgid = (int)L; { const int q = nwg / NXCD, r = nwg % NXCD, xcd = wgid % NXCD, off = wgid / NXCD; wgid = (xcd < r ? xcd * (q + 1) : r * (q + 1) + (xcd - r) * q) + off; }
        const int nig = WGM * nN, gid = wgid / nig, fm = gid * WGM, gsz = (nM - fm) < WGM ? (nM - fm) : WGM;
        u.pm = fm + ((wgid % nig) % gsz); u.pn = (wgid % nig) / gsz; return true;
    }
    __device__ __forceinline__ void a_ready(const Unit&) const {}
    __device__ __forceinline__ void done(const Unit&) const {}
};
typedef float f32x2 __attribute__((ext_vector_type(2)));
typedef __bf16 pg8_bf16x2 __attribute__((ext_vector_type(2)));
__device__ __forceinline__ unsigned cvt_pk_bf16(float lo, float hi) { f32x2 v = {lo, hi}; pg8_bf16x2 b = __builtin_convertvector(v, pg8_bf16x2); return __builtin_bit_cast(unsigned, b); }
__device__ __forceinline__ unsigned pk4_fp8(float a, float b, float c, float d) {
    a = __builtin_fminf(__builtin_fmaxf(a, -448.f), 448.f); b = __builtin_fminf(__builtin_fmaxf(b, -448.f), 448.f); c = __builtin_fminf(__builtin_fmaxf(c, -448.f), 448.f); d = __builtin_fminf(__builtin_fmaxf(d, -448.f), 448.f);
    int w = 0; w = __builtin_amdgcn_cvt_pk_fp8_f32(a, b, w, false); w = __builtin_amdgcn_cvt_pk_fp8_f32(c, d, w, true); return (unsigned)w; }
__device__ __forceinline__ float lx(float v, int mask, int lane) { return __int_as_float(__builtin_amdgcn_ds_bpermute((lane ^ mask) << 2, __float_as_int(v))); }
__device__ __forceinline__ float lup16(float v, int lane) { return __int_as_float(__builtin_amdgcn_ds_bpermute(((lane & 15) ? lane - 1 : lane) << 2, __float_as_int(v))); }
typedef float f32x4_c __attribute__((ext_vector_type(4)));
__device__ __forceinline__ void unpk8_fp8(unsigned lo, unsigned hi, f32x4_c& a, f32x4_c& b) {
    const f32x2 a0 = __builtin_amdgcn_cvt_pk_f32_fp8((int)lo, false), a1 = __builtin_amdgcn_cvt_pk_f32_fp8((int)lo, true), b0 = __builtin_amdgcn_cvt_pk_f32_fp8((int)hi, false), b1 = __builtin_amdgcn_cvt_pk_f32_fp8((int)hi, true);
    a = (f32x4_c){a0[0], a0[1], a1[0], a1[1]}; b = (f32x4_c){b0[0], b0[1], b1[0], b1[1]}; }
#define PG8_GAS __attribute__((address_space(1)))
__device__ __forceinline__ void st8(PG8_GAS bf16_t* p, const f32x4 v0, const f32x4 v1) {
    u32x4 w; w.x = cvt_pk_bf16(v0[0], v0[1]); w.y = cvt_pk_bf16(v0[2], v0[3]); w.z = cvt_pk_bf16(v1[0], v1[1]); w.w = cvt_pk_bf16(v1[2], v1[3]);
    *(PG8_GAS u32x4*)p = w;
}
__device__ __forceinline__ f32x4 bf_lo4(unsigned a, unsigned b) { return (f32x4){__uint_as_float(a << 16), __uint_as_float(a & 0xffff0000u), __uint_as_float(b << 16), __uint_as_float(b & 0xffff0000u)}; }
__device__ __forceinline__ float sigmoidf_fast(float x) { return __builtin_amdgcn_rcpf(1.0f + __builtin_amdgcn_exp2f(-x * LOG2E)); }

typedef float f32x2s __attribute__((ext_vector_type(2)));
constexpr int ST_OFF = 131072;
struct LnCols { f32x4 a0, a1, b0, b1; };
__device__ __forceinline__ LnCols ln_cols(PG8_GAS const float* c1, PG8_GAS const float* c2, int col) {
    LnCols c; c.a0 = *(PG8_GAS const f32x4*)(c1 + col); c.a1 = *(PG8_GAS const f32x4*)(c1 + col + 4); c.b0 = *(PG8_GAS const f32x4*)(c2 + col); c.b1 = *(PG8_GAS const f32x4*)(c2 + col + 4); return c; }
__device__ __forceinline__ f32x4 fma4(const f32x4 a, const f32x4 b, const f32x4 c) { return __builtin_elementwise_fma(a, b, c); }
__device__ __forceinline__ void ln_fix8(f32x4& v0, f32x4& v1, const f32x2s st, const LnCols& c) { const f32x4 nm = (f32x4){-st.x, -st.x, -st.x, -st.x}, rs = (f32x4){st.y, st.y, st.y, st.y};
    v0 = fma4(fma4(c.a0, nm, v0), rs, c.b0); v1 = fma4(fma4(c.a1, nm, v1), rs, c.b1); }

constexpr int HALO_OFF = ST_OFF + 2048;
constexpr int GB_OFF = ST_OFF + 4096;
__device__ __forceinline__ float silu_mul(float g, float v) { return g * __builtin_amdgcn_rcpf(1.0f + __builtin_amdgcn_exp2f(-g * LOG2E)) * v; }
struct EpiConv {
    static constexpr bool PERM = true, AFTER_DRAIN = false; static constexpr int MID_T = -1;
    PG8_GAS bf16_t* HA; PG8_GAS const float* c1; PG8_GAS const float* c2; PG8_GAS const float* cw; PG8_GAS const float* cb; PG8_GAS float* SBL; PG8_GAS float* SBF; PG8_LAS unsigned char* lds;
    __device__ __forceinline__ void operator()(const f32x4 (&acc_)[2][2][4][2], const Unit& u, int wr, int wc, int fr, int fq) const {
        f32x4 (&acc)[2][2][4][2] = const_cast<f32x4 (&)[2][2][4][2]>(acc_);
        const int col0 = u.pn * BM + wc * 32 + 8 * fq, ch0 = u.pn * HALF + wc * 32 + 8 * fq, tok0 = 8 * (16 * wr + fr);
        const PG8_LAS f32x2s* ST = (const PG8_LAS f32x2s*)(lds + ST_OFF);
        PG8_LAS f32x4* HL = (PG8_LAS f32x4*)(lds + HALO_OFF) + (wc * 4 + fq) * 8;
        { const LnCols lg = ln_cols(c1, c2, col0), lv = ln_cols(c1, c2, col0 + HALF);
#pragma unroll
          for (int ai = 0; ai < 2; ++ai)
#pragma unroll
            for (int m = 0; m < 4; ++m) { const f32x2s st = ST[tok0 + 4 * ai + m]; ln_fix8(acc[ai][0][m][0], acc[ai][0][m][1], st, lg); ln_fix8(acc[ai][1][m][0], acc[ai][1][m][1], st, lv); } }
#define UG(s_, n_) acc[(s_) >> 2][0][(s_) & 3][n_]
#define UV(s_, n_) acc[(s_) >> 2][1][(s_) & 3][n_]
        asm volatile("" ::: "memory");
        if (wr == 0 && fr == 15) {
#pragma unroll
            for (int n = 0; n < 2; ++n) { HL[0 + 2 * n] = UG(6, n); HL[1 + 2 * n] = UG(7, n); HL[4 + 2 * n] = UV(6, n); HL[5 + 2 * n] = UV(7, n); } }
        if (wr == 1 && fr == 15) { PG8_GAS float* q = SBL + (size_t)u.pm * 2 * UP_COLS + ch0;
#pragma unroll
            for (int n = 0; n < 2; ++n) { *(PG8_GAS f32x4*)(q + 4 * n) = UG(6, n); *(PG8_GAS f32x4*)(q + UP_COLS + 4 * n) = UG(7, n); *(PG8_GAS f32x4*)(q + DFF + 4 * n) = UV(6, n); *(PG8_GAS f32x4*)(q + UP_COLS + DFF + 4 * n) = UV(7, n); } }
        if (wr == 0 && fr == 0) { PG8_GAS float* q = SBF + (size_t)u.pm * 2 * UP_COLS + ch0;
#pragma unroll
            for (int n = 0; n < 2; ++n) { *(PG8_GAS f32x4*)(q + 4 * n) = UG(0, n); *(PG8_GAS f32x4*)(q + UP_COLS + 4 * n) = UG(1, n); *(PG8_GAS f32x4*)(q + DFF + 4 * n) = UV(0, n); *(PG8_GAS f32x4*)(q + UP_COLS + DFF + 4 * n) = UV(1, n); } }
        asm volatile("s_waitcnt lgkmcnt(0)" ::: "memory"); __builtin_amdgcn_s_barrier(); asm volatile("" ::: "memory");
        PG8_GAS bf16_t* op = HA + (size_t)(u.pm * BM + tok0) * DFF + ch0; const int ln_ = fq * 16 + fr;
#pragma unroll
        for (int n = 0; n < 2; ++n) {
            f32x4 wg[3], wv[3];
#pragma unroll
            for (int i = 0; i < 3; ++i) { wg[i] = *(PG8_GAS const f32x4*)(cw + (size_t)i * UP_COLS + ch0 + 4 * n); wv[i] = *(PG8_GAS const f32x4*)(cw + (size_t)i * UP_COLS + DFF + ch0 + 4 * n); }
            const f32x4 bg = *(PG8_GAS const f32x4*)(cb + ch0 + 4 * n), bv = *(PG8_GAS const f32x4*)(cb + DFF + ch0 + 4 * n);
            f32x4 g1, g2, v1, v2;
#pragma unroll
            for (int j = 0; j < 4; ++j) { g1[j] = lup16(UG(7, n)[j], ln_); g2[j] = lup16(UG(6, n)[j], ln_); v1[j] = lup16(UV(7, n)[j], ln_); v2[j] = lup16(UV(6, n)[j], ln_); }
            if (fr == 0) { if (wr == 1) { g2 = HL[0 + 2 * n]; g1 = HL[1 + 2 * n]; v2 = HL[4 + 2 * n]; v1 = HL[5 + 2 * n]; }
                           else { g1 = (f32x4){0.f, 0.f, 0.f, 0.f}; g2 = g1; v1 = g1; v2 = g1; } }
            unsigned hp[8][2];
#pragma unroll
            for (int sI = 0; sI < 8; ++sI) {
                const f32x4 gm2 = sI >= 2 ? UG(sI >= 2 ? sI - 2 : 0, n) : (sI == 1 ? g1 : g2), gm1 = sI >= 1 ? UG(sI >= 1 ? sI - 1 : 0, n) : g1;
                const f32x4 vm2 = sI >= 2 ? UV(sI >= 2 ? sI - 2 : 0, n) : (sI == 1 ? v1 : v2), vm1 = sI >= 1 ? UV(sI >= 1 ? sI - 1 : 0, n) : v1;
                const f32x4 og = fma4(wg[2], UG(sI, n), fma4(wg[1], gm1, fma4(wg[0], gm2, bg))), ov = fma4(wv[2], UV(sI, n), fma4(wv[1], vm1, fma4(wv[0], vm2, bv)));
                hp[sI][0] = cvt_pk_bf16(silu_mul(og[0], ov[0]), silu_mul(og[1], ov[1])); hp[sI][1] = cvt_pk_bf16(silu_mul(og[2], ov[2]), silu_mul(og[3], ov[3])); }
#pragma unroll
            for (int sI = 0; sI < 8; ++sI) { typedef unsigned u32x2_ __attribute__((ext_vector_type(2))); u32x2_ w; w.x = hp[sI][0]; w.y = hp[sI][1]; *(PG8_GAS u32x2_*)(op + (size_t)sI * DFF + 4 * n) = w; }
        }
#undef UG
#undef UV
    }
};

struct EpiIn {
    static constexpr bool PERM = true, AFTER_DRAIN = false; static constexpr int MID_T = -1;
    PG8_GAS unsigned char* O; PG8_GAS const float* ropeA; PG8_GAS const float* ropeB;
    PG8_GAS const float* c1; PG8_GAS const float* c2; PG8_LAS const unsigned char* lds; int ln;
    PG8_GAS unsigned char* G8;
    static __device__ __forceinline__ void st8q(PG8_GAS unsigned char* p, const f32x4 a, const f32x4 b) { typedef unsigned u32x2_ __attribute__((ext_vector_type(2))); u32x2_ w; w.x = pk4_fp8(a[0], a[1], a[2], a[3]); w.y = pk4_fp8(b[0], b[1], b[2], b[3]); *(PG8_GAS u32x2_*)p = w; }
    __device__ __forceinline__ void operator()(const f32x4 (&acc_)[2][2][4][2], const Unit& u, int wr, int wc, int fr, int fq) const {
        const int row0 = u.pm * BM + wr * 64 + fr, pn = u.pn;
        PG8_GAS unsigned char* base = O + (size_t)row0 * QW + pn * BM + wc * 32 + 8 * fq;
        f32x4 (&acc)[2][2][4][2] = const_cast<f32x4 (&)[2][2][4][2]>(acc_);
        if (ln) { const PG8_LAS f32x2s* ST = (const PG8_LAS f32x2s*)(lds + ST_OFF); const int col0 = pn * BM + wc * 32 + 8 * fq;
          LnCols lc0 = ln_cols(c1, c2, col0), lc1 = ln_cols(c1, c2, col0 + HALF);
          const float ks = pn >= 28 ? -LOG2E : 1.0f;
          lc0.b0 *= ks; lc0.b1 *= ks; lc1.b0 *= ks; lc1.b1 *= ks;
#pragma unroll
          for (int ai = 0; ai < 2; ++ai)
#pragma unroll
            for (int m = 0; m < 4; ++m) { f32x2s st = ST[ai * HALF + wr * 64 + m * 16 + fr]; st.y *= ks; ln_fix8(acc[ai][0][m][0], acc[ai][0][m][1], st, lc0); ln_fix8(acc[ai][1][m][0], acc[ai][1][m][1], st, lc1); } }
        if (pn >= 28) {
            PG8_GAS unsigned char* gb8 = G8 + (size_t)row0 * (2 * DM) + (pn - 28) * BM + wc * 32 + 8 * fq;
#pragma unroll
            for (int ai = 0; ai < 2; ++ai)
#pragma unroll
                for (int m = 0; m < 4; ++m) { PG8_GAS unsigned char* rowp = gb8 + (size_t)(ai * HALF + m * 16) * (2 * DM);
#pragma unroll
                    for (int bj = 0; bj < 2; ++bj) { f32x4 v0 = acc[ai][bj][m][0], v1 = acc[ai][bj][m][1];
                        if (!ln) { v0 *= -LOG2E; v1 *= -LOG2E; }
#pragma unroll
                        for (int j = 0; j < 4; ++j) { v0[j] = __builtin_amdgcn_exp2f(v0[j]); v1[j] = __builtin_amdgcn_exp2f(v1[j]); }
                        typedef unsigned u32x2_ __attribute__((ext_vector_type(2))); u32x2_ w; w.x = pk4_fp8(v0[0], v0[1], v0[2], v0[3]); w.y = pk4_fp8(v1[0], v1[1], v1[2], v1[3]);
                        *(PG8_GAS u32x2_*)(rowp + bj * HALF) = w; } }
        } else if (pn < 12) {
            const float sc = pn < 6 ? QSCALE_A * F8S_Q : F8S_K;
#pragma unroll
            for (int ai = 0; ai < 2; ++ai) {
                f32x4 cc[4], ss[4];
#pragma unroll
                for (int m = 0; m < 4; ++m) { const int r = row0 + ai * HALF + m * 16; cc[m] = (f32x4){1.f, 1.f, 1.f, 1.f}; ss[m] = (f32x4){0.f, 0.f, 0.f, 0.f};
                    if (wc == 0) { cc[m] = *(PG8_GAS const f32x4*)(ropeA + (size_t)r * 32 + 4 * fq); ss[m] = *(PG8_GAS const f32x4*)(ropeA + (size_t)r * 32 + 16 + 4 * fq); } }
#pragma unroll
                for (int m = 0; m < 4; ++m) { PG8_GAS unsigned char* rowp = base + (size_t)(ai * HALF + m * 16) * QW; const f32x4 c = cc[m], s = ss[m];
#pragma unroll
                    for (int bj = 0; bj < 2; ++bj) { const f32x4 v0 = acc[ai][bj][m][0], v1 = acc[ai][bj][m][1];
                        const f32x4 n0 = (v0 * c - v1 * s) * sc, n1 = (v1 * c + v0 * s) * sc;
                        st8q(rowp + bj * HALF, n0, n1); } } }
        } else if (pn >= 18 && pn < 27) {
            const float sc = pn < 26 ? QSCALE_B * F8S_Q : F8S_K;
            const bool rotl = ((wc & 1) == 0) && (fq < 2);
#pragma unroll
            for (int ai = 0; ai < 2; ++ai) {
                f32x4 cc[4], ss[4];
#pragma unroll
                for (int m = 0; m < 4; ++m) { const int r = row0 + ai * HALF + m * 16;
                    cc[m] = *(PG8_GAS const f32x4*)(ropeB + (size_t)r * 16 + 4 * (fq & 1)); ss[m] = *(PG8_GAS const f32x4*)(ropeB + (size_t)r * 16 + 8 + 4 * (fq & 1));
                    if (!rotl) { cc[m] = (f32x4){1.f, 1.f, 1.f, 1.f}; ss[m] = (f32x4){0.f, 0.f, 0.f, 0.f}; } }
#pragma unroll
                for (int m = 0; m < 4; ++m) { PG8_GAS unsigned char* rowp = base + (size_t)(ai * HALF + m * 16) * QW; const f32x4 c = cc[m], s = ss[m];
#pragma unroll
                    for (int bj = 0; bj < 2; ++bj) { const f32x4 v0 = acc[ai][bj][m][0], v1 = acc[ai][bj][m][1];
                        const f32x4 n0 = (v0 * c - v1 * s) * sc, n1 = (v1 * c + v0 * s) * sc;
                        st8q(rowp + bj * HALF, n0, n1); } } }
        } else {
#pragma unroll
            for (int ai = 0; ai < 2; ++ai)
#pragma unroll
                for (int m = 0; m < 4; ++m) { PG8_GAS unsigned char* rowp = base + (size_t)(ai * HALF + m * 16) * QW;
#pragma unroll
                    for (int bj = 0; bj < 2; ++bj) st8q(rowp + bj * HALF, acc[ai][bj][m][0] * F8S_V, acc[ai][bj][m][1] * F8S_V); }
        }
    }
};

struct EpiGate {
    static constexpr bool PERM = true, AFTER_DRAIN = false; static constexpr int MID_T = 2;
    PG8_GAS unsigned char* MG8; PG8_GAS const unsigned char* G8;
    typedef unsigned u32x2_ __attribute__((ext_vector_type(2)));
    __device__ __forceinline__ void mid(f32x4 (&acc)[2][2][4][2], const Unit& u, int wr, int wc, int fr, int fq) const {
        const int row0 = u.pm * BM + wr * 64 + fr, col0 = u.pn * BM + wc * 32 + 8 * fq;
#pragma unroll
        for (int ai = 0; ai < 2; ++ai) {
            u32x2_ ga[4][2], gb[4][2];
#pragma unroll
            for (int m = 0; m < 4; ++m) { const size_t r = (size_t)(row0 + ai * HALF + m * 16) * (2 * DM);
#pragma unroll
                for (int bj = 0; bj < 2; ++bj) { const int c = col0 + bj * HALF; ga[m][bj] = *(PG8_GAS const u32x2_*)(G8 + r + c); gb[m][bj] = *(PG8_GAS const u32x2_*)(G8 + r + DM + c); } }
#pragma unroll
            for (int m = 0; m < 4; ++m)
#pragma unroll
                for (int bj = 0; bj < 2; ++bj) { f32x4 a0, a1, b0, b1; unpk8_fp8(ga[m][bj].x, ga[m][bj].y, a0, a1); unpk8_fp8(gb[m][bj].x, gb[m][bj].y, b0, b1);
#pragma unroll
                    for (int j = 0; j < 4; ++j) { acc[ai][bj][m][0][j] *= (1.0f + b0[j]) * __builtin_amdgcn_rcpf(1.0f + a0[j]); acc[ai][bj][m][1][j] *= (1.0f + b1[j]) * __builtin_amdgcn_rcpf(1.0f + a1[j]); } } }
    }
    __device__ __forceinline__ void operator()(const f32x4 (&acc)[2][2][4][2], const Unit& u, int wr, int wc, int fr, int fq) const {
        const int row0 = u.pm * BM + wr * 64 + fr, col0 = u.pn * BM + wc * 32 + 8 * fq;
#pragma unroll
        for (int ai = 0; ai < 2; ++ai) {
            u32x2_ gb[4][2];
#pragma unroll
            for (int m = 0; m < 4; ++m) { const size_t r = (size_t)(row0 + ai * HALF + m * 16) * (2 * DM);
#pragma unroll
                for (int bj = 0; bj < 2; ++bj) gb[m][bj] = *(PG8_GAS const u32x2_*)(G8 + r + DM + col0 + bj * HALF); }
#pragma unroll
            for (int m = 0; m < 4; ++m) { const size_t r = (size_t)(row0 + ai * HALF + m * 16);
#pragma unroll
                for (int bj = 0; bj < 2; ++bj) { const int c = col0 + bj * HALF; f32x4 b0, b1; unpk8_fp8(gb[m][bj].x, gb[m][bj].y, b0, b1);
                    f32x4 v0, v1;
#pragma unroll
                    for (int j = 0; j < 4; ++j) { v0[j] = acc[ai][bj][m][0][j] * __builtin_amdgcn_rcpf((1.0f + b0[j]) * (1.0f / F8S_MG)); v1[j] = acc[ai][bj][m][1][j] * __builtin_amdgcn_rcpf((1.0f + b1[j]) * (1.0f / F8S_MG)); }
                    u32x2_ w; w.x = pk4_fp8(v0[0], v0[1], v0[2], v0[3]); w.y = pk4_fp8(v1[0], v1[1], v1[2], v1[3]);
                    *(PG8_GAS u32x2_*)(MG8 + r * DM + c) = w; } } }
    }
};

typedef _Float16 f16x2_ __attribute__((ext_vector_type(2)));
__device__ __forceinline__ unsigned pk_f16(float lo, float hi) { f32x2 v = {lo, hi}; f16x2_ h = __builtin_convertvector(v, f16x2_); return __builtin_bit_cast(unsigned, h); }
__device__ __forceinline__ void unpk8_f16(const u32x4 w, f32x4& a, f32x4& b) {
    const unsigned wx = w.x, wy = w.y, wz = w.z, ww = w.w;
    const f16x2_ h0 = __builtin_bit_cast(f16x2_, wx), h1 = __builtin_bit_cast(f16x2_, wy), h2 = __builtin_bit_cast(f16x2_, wz), h3 = __builtin_bit_cast(f16x2_, ww);
    a = (f32x4){(float)h0[0], (float)h0[1], (float)h1[0], (float)h1[1]}; b = (f32x4){(float)h2[0], (float)h2[1], (float)h3[0], (float)h3[1]}; }
template <int OPK, bool XIN  > struct EpiResLn {
    static constexpr bool PERM = true, AFTER_DRAIN = false; static constexpr int MID_T = -1;
    PG8_GAS const float* xin; PG8_GAS unsigned short* H; PG8_GAS const float* g; PG8_GAS const float* b; PG8_GAS bf16_t* OB; PG8_GAS unsigned char* O8; PG8_GAS float* STP; PG8_LAS const unsigned char* lds; int lnres;
    __device__ __forceinline__ void operator()(const f32x4 (&acc)[2][2][4][2], const Unit& u, int wr, int wc, int fr, int fq) const {
        const int row0 = u.pm * BM + wr * 64 + fr, col0 = u.pn * BM + wc * 32 + 8 * fq;
        const PG8_LAS f32x2s* ST = (const PG8_LAS f32x2s*)(lds + ST_OFF);
        PG8_LAS float* GB = (PG8_LAS float*)(const_cast<PG8_LAS unsigned char*>(lds) + GB_OFF) + (wr * 4 + wc) * 128;
        if (lnres) { const int l5 = (fq * 16 + fr) & 31, hf = (fq * 16 + fr) >> 5, cc = u.pn * BM + hf * HALF + wc * 32 + l5; GB[hf * 32 + l5] = g[cc]; GB[64 + hf * 32 + l5] = b[cc]; }
        asm volatile("s_waitcnt lgkmcnt(0)" ::: "memory");
#define ERL_G(bj, n) (*(const PG8_LAS f32x4*)(GB + (bj) * 32 + 8 * fq + 4 * (n)))
#define ERL_B(bj, n) (*(const PG8_LAS f32x4*)(GB + 64 + (bj) * 32 + 8 * fq + 4 * (n)))
#define ERL_ROW(ai, m, X0, X1) do { const int row = row0 + (ai) * HALF + (m) * 16; const size_t off = (size_t)row * DM + col0; \
            f32x2s st = ST[(ai) * HALF + wr * 64 + (m) * 16 + fr]; if (!lnres) st = (f32x2s){0.f, 1.f}; \
            float sm = 0.f, sq = 0.f; \
            _Pragma("unroll") for (int bj = 0; bj < 2; ++bj) { f32x4 h[2]; \
                _Pragma("unroll") for (int n = 0; n < 2; ++n) { f32x4 x = n ? X1(bj) : X0(bj); if (lnres) x = (x - st.x) * st.y * ERL_G(bj, n) + ERL_B(bj, n); \
                    h[n] = x * DN_ALPHA + acc[ai][bj][m][n]; \
                    sm += (h[n][0] + h[n][1]) + (h[n][2] + h[n][3]); sq += (h[n][0] * h[n][0] + h[n][1] * h[n][1]) + (h[n][2] * h[n][2] + h[n][3] * h[n][3]); } \
                u32x4 hw; hw.x = pk_f16(h[0][0], h[0][1]); hw.y = pk_f16(h[0][2], h[0][3]); hw.z = pk_f16(h[1][0], h[1][1]); hw.w = pk_f16(h[1][2], h[1][3]); \
                *(PG8_GAS u32x4*)(H + off + bj * HALF) = hw; \
                if (OPK == 0) st8(OB + off + bj * HALF, h[0], h[1]); \
                else { typedef unsigned u32x2_ __attribute__((ext_vector_type(2))); u32x2_ w; w.x = pk4_fp8(h[0][0] * F8S_X, h[0][1] * F8S_X, h[0][2] * F8S_X, h[0][3] * F8S_X); w.y = pk4_fp8(h[1][0] * F8S_X, h[1][1] * F8S_X, h[1][2] * F8S_X, h[1][3] * F8S_X); \
                    *(PG8_GAS u32x2_*)(O8 + off + bj * HALF) = w; } } \
            { const int ln_ = fq * 16 + fr; sm += lx(sm, 16, ln_); sq += lx(sq, 16, ln_); sm += lx(sm, 32, ln_); sq += lx(sq, 32, ln_); } \
            if (fq == 0) *(PG8_GAS f32x2s*)(STP + ((size_t)row * 64 + u.pn * 4 + wc) * 2) = (f32x2s){sm, sq}; } while (0)
        if (!XIN || lnres) {
#pragma unroll
            for (int ai = 0; ai < 2; ++ai) {
                u32x4 xw[4][2];
#pragma unroll
                for (int m = 0; m < 4; ++m)
#pragma unroll
                    for (int bj = 0; bj < 2; ++bj) xw[m][bj] = *(PG8_GAS const u32x4*)(H + (size_t)(row0 + ai * HALF + m * 16) * DM + col0 + bj * HALF);
#pragma unroll
                for (int m = 0; m < 4; ++m) { f32x4 xa[2], xb[2];
#pragma unroll
                    for (int bj = 0; bj < 2; ++bj) unpk8_f16(xw[m][bj], xa[bj], xb[bj]);
#define ERL_XA(bj) xa[bj]
#define ERL_XB(bj) xb[bj]
                    ERL_ROW(ai, m, ERL_XA, ERL_XB); __builtin_amdgcn_sched_barrier(0); } }
        } else if constexpr (XIN) {
#pragma unroll
            for (int ai = 0; ai < 2; ++ai)
#pragma unroll
                for (int m = 0; m < 4; ++m) {
                    f32x4 xv[2][2];
#pragma unroll
                    for (int bj = 0; bj < 2; ++bj) { const size_t off = (size_t)(row0 + ai * HALF + m * 16) * DM + col0 + bj * HALF; xv[bj][0] = *(PG8_GAS const f32x4*)(xin + off); xv[bj][1] = *(PG8_GAS const f32x4*)(xin + off + 4); }
#define ERL_YA(bj) xv[bj][0]
#define ERL_YB(bj) xv[bj][1]
                    ERL_ROW(ai, m, ERL_YA, ERL_YB); __builtin_amdgcn_sched_barrier(0); }
        }
#undef ERL_ROW
#undef ERL_G
#undef ERL_B
#undef ERL_XA
#undef ERL_XB
#undef ERL_YA
#undef ERL_YB
    }
};

template <class Epi, class Sched, bool ALIGN_EPI = false, bool SP2 = false, int F8SA = 0, int F8SB = 0, bool ROWPERM = false>
__device__ __forceinline__ void gemm_phase(PG8_LAS unsigned char* lds, const Gemm g, const Sched& S, const Epi& E) {
    int tid_ = threadIdx.x; asm volatile("" : "+v"(tid_));
    const int tid = tid_, wid = __builtin_amdgcn_readfirstlane(tid >> 6), lane = tid & 63, wr = wid >> 2, wc = wid & 3, fr = lane & 15, fq = lane >> 4;
    int K_ = g.K; asm volatile("" : "+s"(K_));
    const int K = K_, nt = K / BK;
    unsigned voffA[2], voffB[2];
#pragma unroll
    for (int i = 0; i < 2; ++i) { int R, C; stage_rc(tid * 16 + i * 8192, R, C); const int Rb = Epi::PERM ? ((R & ~31) + perm32(R & 31)) : R;
        const int Ra = ROWPERM ? 8 * (16 * (R >> 6) + (R & 15)) + ((R >> 4) & 3) : R;
        voffA[i] = (unsigned)(Ra * K + C) * 2u; voffB[i] = (unsigned)(Rb * BK + C) * 2u; }
    const size_t kstep = (size_t)(BK * 2);
    const size_t hstep = (size_t)HALF * K * 2;
    const size_t hstepA = ROWPERM ? (size_t)4 * K * 2 : hstep;
    const size_t tstep = 2 * hstep;
    const size_t kstepB = (size_t)BM * BK * 2, hstepB = (size_t)HALF * BK * 2;
    const unsigned ldsw = (unsigned)wid * 1024u;
    const int aoff = lds_byte(wr * 64 + fr, fq * 8), boff = lds_byte(wc * 32 + fr, fq * 8);
#define PG8_SA(b, h) (((b) * 2 + (h)) * HTB)
#define PG8_SB(b, h) ((4 + (b) * 2 + (h)) * HTB)
#define PG8_STAGE(bufoff, gbase, voff) do { _Pragma("unroll") for (int _i = 0; _i < 2; ++_i) \
        __builtin_amdgcn_global_load_lds((const unsigned*)((const char*)(gbase) + (voff)[_i]), (PG8_LAS unsigned*)(lds + (bufoff) + ldsw + _i * 8192), 16, 0, 0); } while (0)
#define PG8_LDA(dst, b, h) do { _Pragma("unroll") for (int m = 0; m < 4; ++m) _Pragma("unroll") for (int k = 0; k < 2; ++k) dst[m][k] = *(const PG8_LAS bf16x8*)(lds + PG8_SA(b, h) + aoff + m * 2048 + k * 1024); } while (0)
#define PG8_LDB(dst, b, h) do { _Pragma("unroll") for (int n = 0; n < 2; ++n) _Pragma("unroll") for (int k = 0; k < 2; ++k) dst[n][k] = *(const PG8_LAS bf16x8*)(lds + PG8_SB(b, h) + boff + n * 2048 + k * 1024); } while (0)
#define PG8_MMA(ai, bj, At, Bt) do { __builtin_amdgcn_s_setprio(1); _Pragma("unroll") for (int m = 0; m < 4; ++m) _Pragma("unroll") for (int n = 0; n < 2; ++n) { \
        if constexpr (F8SA != 0) { typedef int i32x4_ __attribute__((ext_vector_type(4))); typedef int i32x8_ __attribute__((ext_vector_type(8))); \
            const i32x8_ b8 = __builtin_shufflevector(__builtin_bit_cast(i32x4_, Bt[n][0]), __builtin_bit_cast(i32x4_, Bt[n][1]), 0, 1, 2, 3, 4, 5, 6, 7), a8 = __builtin_shufflevector(__builtin_bit_cast(i32x4_, At[m][0]), __builtin_bit_cast(i32x4_, At[m][1]), 0, 1, 2, 3, 4, 5, 6, 7); \
            asm volatile("v_mfma_scale_f32_16x16x128_f8f6f4 %0, %1, %2, %0, %3, %4 op_sel_hi:[0,0,0]" : "+v"(acc[ai][bj][m][n]) : "v"(b8), "v"(a8), "v"(f8_sb), "v"(f8_sa)); } \
        else { _Pragma("unroll") for (int k = 0; k < 2; ++k) acc[ai][bj][m][n] = __builtin_amdgcn_mfma_f32_16x16x32_bf16(Bt[n][k], At[m][k], acc[ai][bj][m][n], 0, 0, 0); } } \
        __builtin_amdgcn_s_setprio(0); } while (0)
#define PG8_WAIT_V(n) asm volatile("s_waitcnt vmcnt(" #n ")" ::: "memory")
#define PG8_WAIT_L(n) asm volatile("s_waitcnt lgkmcnt(" #n ")" ::: "memory")
#define PG8_BAR __builtin_amdgcn_s_barrier()
#define PG8_SCHED __builtin_amdgcn_sched_barrier(0)
    int f8_sa = F8SA, f8_sb = F8SB; asm volatile("" : "+v"(f8_sa), "+v"(f8_sb));
    Unit cur, nxt; int ui = 0;
    if (!S.next(0, cur)) return;
    f32x4 acc[2][2][4][2];
#pragma unroll
    for (int a = 0; a < 2; ++a)
#pragma unroll
        for (int b = 0; b < 2; ++b)
#pragma unroll
            for (int m = 0; m < 4; ++m)
#pragma unroll
                for (int n = 0; n < 2; ++n) acc[a][b][m][n] = (f32x4){0.f, 0.f, 0.f, 0.f};
    bf16x8 At[4][2], B0[2][2], B1[2][2];
    const char* cA = (const char*)g.A + (size_t)cur.pm * tstep; const char* cB = (const char*)g.Bt + (size_t)cur.pn * tstep;
    S.a_ready(cur);
    if constexpr (SP2) {
        PG8_STAGE(PG8_SB(0, 0), cB, voffB); PG8_STAGE(PG8_SB(0, 1), cB + hstepB, voffB); PG8_STAGE(PG8_SA(0, 0), cA, voffA); PG8_STAGE(PG8_SA(0, 1), cA + hstepA, voffA);
        if (wr == 1) PG8_BAR;
        PG8_WAIT_V(2); PG8_BAR;
        PG8_STAGE(PG8_SB(1, 0), cB + kstepB, voffB); PG8_STAGE(PG8_SA(1, 0), cA + kstep, voffA); PG8_STAGE(PG8_SB(1, 1), cB + hstepB + kstepB, voffB);
        PG8_WAIT_V(6); PG8_BAR;
    } else {
        PG8_STAGE(PG8_SB(0, 0), cB, voffB); PG8_STAGE(PG8_SA(0, 0), cA, voffA); PG8_STAGE(PG8_SB(0, 1), cB + hstepB, voffB); PG8_STAGE(PG8_SA(0, 1), cA + hstepA, voffA);
        if (wr == 1) PG8_BAR;
        PG8_WAIT_V(4); PG8_BAR;
        PG8_STAGE(PG8_SB(1, 0), cB + kstepB, voffB); PG8_STAGE(PG8_SA(1, 0), cA + kstep, voffA); PG8_STAGE(PG8_SB(1, 1), cB + hstepB + kstepB, voffB);
        PG8_WAIT_V(6); PG8_BAR;
    }
    for (;;) {
        const bool has_next = S.next(ui + 1, nxt);
        const char* nA = has_next ? (const char*)g.A + (size_t)nxt.pm * tstep : cA; const char* nB = has_next ? (const char*)g.Bt + (size_t)nxt.pn * tstep : cB;
        for (int t = 0; t < nt; t += 2) {
            const bool last = (t == nt - 2);
            const char* a1 = cA + (size_t)(t + 1) * kstep;
            const char* a2 = last ? nA : cA + (size_t)(t + 2) * kstep; const char* b2 = last ? nB : cB + (size_t)(t + 2) * kstepB;
            const char* a3 = a2 + kstep; const char* b3 = b2 + kstepB;
            if (last && has_next) S.a_ready(nxt);
            if constexpr (SP2) {
            PG8_LDB(B0, 0, 0); PG8_LDB(B1, 0, 1); PG8_SCHED; PG8_LDA(At, 0, 0); PG8_STAGE(PG8_SA(1, 1), a1 + hstepA, voffA);
            PG8_WAIT_V(8); PG8_WAIT_L(0); PG8_BAR; PG8_MMA(0, 0, At, B0); PG8_MMA(0, 1, At, B1); PG8_BAR; PG8_SCHED;
            PG8_LDA(At, 0, 1); PG8_STAGE(PG8_SB(0, 0), b2, voffB); PG8_STAGE(PG8_SB(0, 1), b2 + hstepB, voffB); PG8_STAGE(PG8_SA(0, 0), a2, voffA);
            PG8_WAIT_V(8); PG8_WAIT_L(0); PG8_BAR; PG8_MMA(1, 0, At, B0); PG8_MMA(1, 1, At, B1); PG8_BAR; PG8_SCHED;
            PG8_LDB(B0, 1, 0); PG8_LDB(B1, 1, 1); PG8_SCHED; PG8_LDA(At, 1, 0); PG8_STAGE(PG8_SA(0, 1), a2 + hstepA, voffA);
            PG8_WAIT_V(8); PG8_WAIT_L(0); PG8_BAR; PG8_MMA(0, 0, At, B0); PG8_MMA(0, 1, At, B1); PG8_BAR; PG8_SCHED;
            PG8_LDA(At, 1, 1); PG8_STAGE(PG8_SB(1, 0), b3, voffB); PG8_STAGE(PG8_SB(1, 1), b3 + hstepB, voffB); PG8_STAGE(PG8_SA(1, 0), a3, voffA);
            PG8_WAIT_V(8); PG8_WAIT_L(0); PG8_BAR; PG8_MMA(1, 0, At, B0); PG8_MMA(1, 1, At, B1); PG8_BAR; PG8_SCHED;
            } else {
            PG8_LDB(B0, 0, 0); PG8_SCHED; PG8_LDA(At, 0, 0); PG8_STAGE(PG8_SA(1, 1), a1 + hstepA, voffA);
            PG8_WAIT_L(8); PG8_BAR; PG8_WAIT_L(0); PG8_MMA(0, 0, At, B0); PG8_BAR; PG8_SCHED;
            PG8_LDB(B1, 0, 1); PG8_STAGE(PG8_SB(0, 0), b2, voffB);
            PG8_BAR; PG8_WAIT_L(0); PG8_MMA(0, 1, At, B1); PG8_BAR;
            PG8_LDA(At, 0, 1); PG8_STAGE(PG8_SA(0, 0), a2, voffA);
            PG8_BAR; PG8_WAIT_L(0); PG8_MMA(1, 0, At, B0); PG8_BAR; PG8_SCHED;
            PG8_STAGE(PG8_SB(0, 1), b2 + hstepB, voffB);
            PG8_WAIT_V(6); PG8_BAR; PG8_MMA(1, 1, At, B1); PG8_BAR;
            PG8_LDB(B0, 1, 0); PG8_SCHED; PG8_LDA(At, 1, 0); PG8_STAGE(PG8_SA(0, 1), a2 + hstepA, voffA);
            PG8_WAIT_L(8); PG8_BAR; PG8_WAIT_L(0); PG8_MMA(0, 0, At, B0); PG8_BAR; PG8_SCHED;
            PG8_LDB(B1, 1, 1); PG8_STAGE(PG8_SB(1, 0), b3, voffB);
            PG8_BAR; PG8_WAIT_L(0); PG8_MMA(0, 1, At, B1); PG8_BAR;
            PG8_LDA(At, 1, 1); PG8_STAGE(PG8_SA(1, 0), a3, voffA);
            PG8_BAR; PG8_WAIT_L(0); PG8_MMA(1, 0, At, B0); PG8_BAR; PG8_SCHED;
            PG8_STAGE(PG8_SB(1, 1), b3 + hstepB, voffB);
            PG8_WAIT_V(6); PG8_BAR; PG8_MMA(1, 1, At, B1); PG8_BAR;
            }
            if constexpr (Epi::MID_T >= 0) { if (t == Epi::MID_T) {
                if constexpr (F8SA != 0) asm volatile("s_nop 15\n\ts_nop 15" ::: "memory");
                int fr_m = fr, fq_m = fq; asm volatile("" : "+v"(fr_m), "+v"(fq_m)); E.mid(acc, cur, wr, wc, fr_m, fq_m);
                asm volatile("s_nop 7" ::: "memory"); } }
        }
        if constexpr (F8SA != 0) asm volatile("s_nop 15\n\ts_nop 15" ::: "memory");
        if constexpr (ALIGN_EPI) { if (wr == 0) PG8_BAR; }
        if constexpr (!Epi::AFTER_DRAIN) { int fr_e = fr, fq_e = fq; asm volatile("" : "+v"(fr_e), "+v"(fq_e));   E(acc, cur, wr, wc, fr_e, fq_e); S.done(cur); }
        if (!has_next) break;
#pragma unroll
        for (int a = 0; a < 2; ++a)
#pragma unroll
            for (int b = 0; b < 2; ++b)
#pragma unroll
                for (int m = 0; m < 4; ++m)
#pragma unroll
                    for (int n = 0; n < 2; ++n) acc[a][b][m][n] = (f32x4){0.f, 0.f, 0.f, 0.f};
        cur = nxt; cA = nA; cB = nB; ++ui;
        if constexpr (ALIGN_EPI) { if (wr == 1) PG8_BAR; }
    }
    PG8_WAIT_V(0);
    if constexpr (!ALIGN_EPI) { if (wr == 0) PG8_BAR; }
    PG8_BAR;
    if constexpr (Epi::AFTER_DRAIN) { E.fused(acc, cur, wr, wc, fr, fq, lds, wid, lane); S.done(cur); }
#undef PG8_SA
#undef PG8_SB
#undef PG8_STAGE
#undef PG8_LDA
#undef PG8_LDB
#undef PG8_MMA
#undef PG8_WAIT_V
#undef PG8_WAIT_L
#undef PG8_BAR
#undef PG8_SCHED
}
}
__device__ __forceinline__ float sigmoidf_dev(float x) { return __builtin_amdgcn_rcpf(1.0f + __builtin_amdgcn_exp2f(-x * LOG2E)); }

constexpr int NWAVES = 8;
#ifndef MK_PER_PHASE
#define MK_PER_PHASE 0
#endif
constexpr int PH_PER_LAYER = 10;
constexpr int N_PHASES = 2 + DEPTH * PH_PER_LAYER;

constexpr size_t MiB = 1u << 20;
constexpr size_t WS_CTL = 0, CTL_ZERO_BYTES = 2 * MiB;
constexpr size_t WS_CVEC = 1 * MiB;
constexpr int CV_C1IN = 0, CV_C2IN = 4 * IN_COLS, CV_C1UP = 8 * IN_COLS, CV_C2UP = 8 * IN_COLS + 4 * UP_COLS;
static_assert((size_t)(8 * IN_COLS + 8 * UP_COLS) * 4 <= MiB, "fold vectors fit their MiB");
constexpr size_t WS_ROPEA = 2 * MiB;
constexpr size_t WS_ROPEB = 3 * MiB;
constexpr size_t WS_LSE = 4 * MiB;
constexpr size_t WS_STP1 = 5 * MiB, WS_STP2 = 9 * MiB;
constexpr size_t WS_SBL = 13 * MiB, WS_SBF = 17 * MiB;
constexpr size_t WS_W = 24 * MiB;
constexpr size_t LW_IN = 0, LW_PA = 120 * MiB, LW_PB = 124 * MiB, LW_OUT = 140 * MiB, LW_UP = 172 * MiB, LW_DN = 300 * MiB, LW_BYTES = 364 * MiB;
constexpr size_t WS_XB = WS_W + DEPTH * LW_BYTES;
constexpr size_t WS_XF = WS_XB + 64 * MiB;
constexpr size_t WS_HF = WS_XF + 128 * MiB;
constexpr size_t WS_PROJ = WS_HF + 128 * MiB;
constexpr size_t WS_OG = WS_PROJ + 240 * MiB;
constexpr size_t WS_YA = WS_OG + 48 * MiB;
constexpr size_t WS_YB = WS_YA + 8 * MiB;
constexpr size_t WS_MG = WS_YB + 32 * MiB;
constexpr size_t WS_U = WS_MG + 64 * MiB;
constexpr size_t WS_HA = WS_U + 256 * MiB;
constexpr size_t WS_G8 = WS_HA + 128 * MiB;
constexpr size_t WS_MT = WS_HA + 128 * MiB;
constexpr size_t WS_END = WS_MT + 64 * MiB;
static_assert((size_t)IN_COLS * DM * 2 == 120 * MiB && (size_t)M * IN_COLS * 2 == 240 * MiB && (size_t)3 * M * 512 * 4 == 48 * MiB, "ws map");
constexpr int CW_TMO = 0, CW_CODE = 1;
constexpr int IN_FULL_ROUNDS = (M / 256) * (IN_COLS / 256) / 256;
constexpr int IN_TAIL = (M / 256) * (IN_COLS / 256) - IN_FULL_ROUNDS * 256;
constexpr int CW_BAR = 4096;

constexpr int RING_OFF = 0, RING_BYTES = 131072;
constexpr int KSA = 272, KSB = 144;
constexpr int SCRATCH_BYTES = 2 * 256 * KSA;
constexpr int LDSCTL_OFF = SCRATCH_BYTES, MISC_OFF = LDSCTL_OFF + 320;
constexpr int LDS_BYTES = 147456;
static_assert(MISC_OFF + 128 <= LDS_BYTES && 8 * 128 * 33 * 4 <= SCRATCH_BYTES && RING_BYTES <= SCRATCH_BYTES, "LDS map");

#define GAS __attribute__((address_space(1)))
#define LAS __attribute__((address_space(3)))
typedef unsigned short bf16;
typedef unsigned v4u __attribute__((ext_vector_type(4)));
typedef float f32x4 __attribute__((ext_vector_type(4)));
typedef short bf16x8 __attribute__((ext_vector_type(8)));
typedef GAS unsigned gu32;
typedef GAS unsigned long long gu64;
#define RLX_AGENT __ATOMIC_RELAXED, __HIP_MEMORY_SCOPE_AGENT
#define LDS_WAIT() asm volatile("s_waitcnt lgkmcnt(0)" ::: "memory")
#define VM_WAIT() asm volatile("s_waitcnt vmcnt(0)" ::: "memory")
__device__ __forceinline__ unsigned long long rt() { return __builtin_amdgcn_s_memrealtime(); }
__device__ __forceinline__ unsigned f2bf(float f) { unsigned u = __builtin_bit_cast(unsigned, f); return (u + 0x7fffu + ((u >> 16) & 1u)) >> 16; }
__device__ __forceinline__ unsigned pk2(float lo, float hi) { return f2bf(lo) | (f2bf(hi) << 16); }

#define XB_TMO      128
#define XB_XCNT(j)  (256  + 64 * (j))
#define XB_XSUB(j)  (1280 + 64 * (j))
#define XB_XGEN(j)  (2304 + 64 * (j))
#define XB_TOP      3328
#define XB_TOPGEN   3392
#define XCD_BAR_WORDS 3456
#define XB_SPIN_CAP (1u << 18)

__device__ __forceinline__ unsigned xb_ld(unsigned* p)              { return __hip_atomic_load((GAS unsigned*)p, __ATOMIC_RELAXED, __HIP_MEMORY_SCOPE_AGENT); }
__device__ __forceinline__ unsigned xb_add(unsigned* p, unsigned v) { return __hip_atomic_fetch_add((GAS unsigned*)p, v, __ATOMIC_RELAXED, __HIP_MEMORY_SCOPE_AGENT); }
__device__ __forceinline__ unsigned xb_xcc_id() { return (unsigned)__builtin_amdgcn_s_getreg((3 << 11) | 20) & 0xFu; }
#define XB_SPIN(cond, bar) do { unsigned _sp = 0; while (cond) { __builtin_amdgcn_s_sleep(1); \
    if ((++_sp & 255u) == 0u) { if (xb_ld(&(bar)[XB_TMO])) break; if (_sp > XB_SPIN_CAP) { (void)xb_add(&(bar)[XB_TMO], 1u); break; } } } } while (0)

struct XcdBarrier {
    unsigned* bar; unsigned x;
    volatile LAS unsigned* st;
};

__device__ __forceinline__ XcdBarrier xcd_barrier_post(unsigned* bar, volatile LAS unsigned* st) {
    XcdBarrier b; b.bar = bar; b.x = xb_xcc_id(); b.st = st;
    if (threadIdx.x == 0) (void)xb_add(&bar[XB_XCNT(b.x)], 1u);
    return b;
}
__device__ __forceinline__ void xcd_barrier_complete(unsigned* bar, unsigned x, unsigned& nloc, unsigned& nx) {
    const unsigned G = gridDim.x * gridDim.y * gridDim.z;
    unsigned sum, cnt, mine, sp = 0u;
    for (;;) {
        sum = 0u; cnt = 0u; mine = 0u;
#pragma unroll
        for (unsigned j = 0; j < 16; ++j) { const unsigned c = xb_ld(&bar[XB_XCNT(j)]); sum += c; cnt += (c > 0u) ? 1u : 0u; mine = (j == x) ? c : mine; }
        if (sum == G) break;
        __builtin_amdgcn_s_sleep(1);
        if ((++sp & 255u) == 0u) { if (xb_ld(&bar[XB_TMO])) break; if (sp > XB_SPIN_CAP) { (void)xb_add(&bar[XB_TMO], 1u); break; } }
    }
    nloc = mine > 0u ? mine : 1u; nx = cnt > 0u ? cnt : 1u;
}

__device__ __forceinline__ void xcd_barrier(const XcdBarrier& b) {
    asm volatile("s_waitcnt vmcnt(0)" ::: "memory");
    __syncthreads();
    if (threadIdx.x == 0) {
        unsigned* bar = b.bar; unsigned bx = b.x; asm volatile("" : "+s"(bar), "+s"(bx));
        __builtin_amdgcn_s_waitcnt(0);
        unsigned nloc = b.st[0], nx = b.st[1];
        if (nloc == 0u) { xcd_barrier_complete(bar, bx, nloc, nx); b.st[0] = nloc; b.st[1] = nx; }
        const unsigned old = xb_add(&bar[XB_XSUB(bx)], 1u);
        const unsigned gen = old / nloc;
        if (old + 1u == (gen + 1u) * nloc) {
            __builtin_amdgcn_fence(__ATOMIC_RELEASE, "agent");
            asm volatile("s_waitcnt vmcnt(0)" ::: "memory");
            const unsigned og = xb_add(&bar[XB_TOP], 1u);
            const unsigned tg = og / nx;
            if (og + 1u == (tg + 1u) * nx) xb_add(&bar[XB_TOPGEN], 1u);
            else XB_SPIN(xb_ld(&bar[XB_TOPGEN]) == tg, bar);
            __builtin_amdgcn_fence(__ATOMIC_ACQUIRE, "agent");
            xb_add(&bar[XB_XGEN(bx)], 1u);
            asm volatile("s_waitcnt vmcnt(0)" ::: "memory");
        } else {
            XB_SPIN(xb_ld(&bar[XB_XGEN(bx)]) == gen, bar);
            __builtin_amdgcn_fence(__ATOMIC_ACQUIRE, "agent");
            asm volatile("s_waitcnt vmcnt(0)" ::: "memory");
        }
    }
    __syncthreads();
}

typedef short v4i16_t __attribute__((ext_vector_type(4)));
using pg8::pk4_fp8;
typedef GAS const float gcf; typedef GAS float gf; typedef GAS bf16 gbf; typedef GAS const bf16 gcbf;
typedef float f32x2v __attribute__((ext_vector_type(2)));
typedef __bf16 bf16x2v __attribute__((ext_vector_type(2)));
__device__ __forceinline__ unsigned cvtpk(float lo, float hi) { f32x2v v = {lo, hi}; bf16x2v b = __builtin_convertvector(v, bf16x2v); return __builtin_bit_cast(unsigned, b); }
__device__ __forceinline__ float bflo(unsigned w) { return __uint_as_float(w << 16); }
__device__ __forceinline__ float bfhi(unsigned w) { return __uint_as_float(w & 0xffff0000u); }

struct Frame {
    LAS unsigned char* lds;
    volatile LAS unsigned* MISC;
    gu32* ctl;
    int tid, lane, wave;
    int vcu, G, bid;
};

__device__ __forceinline__ float wave_sum(float v) {
#pragma unroll
    for (int o = 1; o < 64; o <<= 1) v += __shfl_xor(v, o);
    return v;
}

__device__ __forceinline__ int win_dst_col(int c) {
    if (c < VA_OFF) { const int d = c & 127; if (d < 32) { const int nd = d < 16 ? 8 * (d >> 2) + (d & 3) : 8 * ((d - 16) >> 2) + 4 + (d & 3); return c - d + nd; } return c; }
    if (c >= QB_OFF && c < VB_OFF) { const int d = c & 63; if (d < 16) { const int nd = d < 8 ? 8 * (d >> 2) + (d & 3) : 8 * ((d - 8) >> 2) + 4 + (d & 3); return c - d + nd; } return c; }
    return c;
}
__device__ __forceinline__ void atomic_addf(gf* p, float v) { (void)__hip_atomic_fetch_add(p, v, __ATOMIC_RELAXED, __HIP_MEMORY_SCOPE_AGENT); }
__device__ __forceinline__ int up_dst_row(int c) { const int hf = c >= DFF ? 1 : 0, cc = c - hf * DFF; return 256 * (cc >> 7) + 128 * hf + (cc & 127); }
__device__ __forceinline__ size_t wpack_off(int n, int kb, int ldb) { return ((size_t)((n >> 8) * (ldb >> 7) + (kb >> 7)) * 256 + (n & 255)) * 128 + (kb & 127); }
template <bool FOLD, bool UPPERM>
__device__ __forceinline__ void p0_transpose_item(gcf* W, int K, int N, gbf* WT, gcf* g, gcf* b, gf* c1, gf* c2, LAS float* scr, int item, int lane) {
    const int nblk = N >> 6, kbg = item / nblk, nb = item - kbg * nblk, n0 = 64 * nb;
    f32x4 s1 = (f32x4){0.f, 0.f, 0.f, 0.f}, s2 = s1;
#pragma unroll 1
    for (int kk = 0; kk < 4; ++kk) { const int k0 = 64 * (4 * kbg + kk);
        const GAS f32x4* src = (const GAS f32x4*)(W + (size_t)(k0 + (lane >> 4)) * N + n0 + 4 * (lane & 15));
        f32x4 v[16];
#pragma unroll
        for (int i = 0; i < 16; ++i) v[i] = __builtin_nontemporal_load(src + (size_t)i * N);
        if (FOLD) {
#pragma unroll
            for (int i = 0; i < 16; ++i) { const int k = k0 + 4 * i + (lane >> 4); const float gk = g[k], bk = b[k]; s2 = s2 + v[i] * bk; v[i] = v[i] * gk; s1 = s1 + v[i]; } }
#pragma unroll
        for (int i = 0; i < 16; ++i) { LAS float* d = scr + (4 * i + (lane >> 4)) * 65 + 4 * (lane & 15); d[0] = v[i][0]; d[1] = v[i][1]; d[2] = v[i][2]; d[3] = v[i][3]; }
        LDS_WAIT(); asm volatile("" ::: "memory");
        const int c = lane & 7;
#pragma unroll
        for (int j = 0; j < 8; ++j) { const int n = (lane >> 3) + 8 * j; const LAS float* q = scr + (8 * c) * 65 + n;
            v4u o; o.x = cvtpk(q[0 * 65], q[1 * 65]); o.y = cvtpk(q[2 * 65], q[3 * 65]); o.z = cvtpk(q[4 * 65], q[5 * 65]); o.w = cvtpk(q[6 * 65], q[7 * 65]);
            *(GAS v4u*)((GAS unsigned char*)WT + wpack_off(UPPERM ? up_dst_row(n0 + n) : n0 + n, 2 * (k0 + 8 * c), 2 * K)) = o; }
        LDS_WAIT(); asm volatile("" ::: "memory");
    }
    if (FOLD) {
#pragma unroll
        for (int j = 0; j < 4; ++j) { s1[j] += __shfl_xor(s1[j], 16); s1[j] += __shfl_xor(s1[j], 32); s2[j] += __shfl_xor(s2[j], 16); s2[j] += __shfl_xor(s2[j], 32); }
        float t1 = 0.f, t2 = 0.f;
#pragma unroll
        for (int j = 0; j < 4; ++j) { const float a1 = __shfl(s1[j], lane >> 2), a2 = __shfl(s2[j], lane >> 2); if ((lane & 3) == j) { t1 = a1; t2 = a2; } }
        const int dc = UPPERM ? up_dst_row(n0 + lane) : n0 + lane; atomic_addf(c1 + dc, t1); atomic_addf(c2 + dc, t2); }
}
template <bool PERM_IN, bool FOLD>
__device__ __forceinline__ void p0_transpose_item8(gcf* W, int K, int N, GAS unsigned char* WT, int ldw  , int kofs  , float scale, gcf* g, gcf* b, gf* c1, gf* c2, LAS float* scr, int item, int lane) {
    const int nblk = N >> 5, kbg = item / nblk, nb = item - kbg * nblk, n0 = 32 * nb;
    f32x4 s1 = (f32x4){0.f, 0.f, 0.f, 0.f}, s2 = s1;
#pragma unroll 1
    for (int kk = 0; kk < 4; ++kk) { const int k0 = 128 * (4 * kbg + kk);
        const GAS f32x4* src = (const GAS f32x4*)(W + (size_t)(k0 + (lane >> 3)) * N + n0 + 4 * (lane & 7));
        f32x4 v[16];
#pragma unroll
        for (int i = 0; i < 16; ++i) v[i] = __builtin_nontemporal_load(src + (size_t)i * 2 * N);
        if (FOLD) {
#pragma unroll
            for (int i = 0; i < 16; ++i) { const int k = k0 + 8 * i + (lane >> 3); const float gk = g[k], bk = b[k]; s2 = s2 + v[i] * bk; v[i] = v[i] * gk; s1 = s1 + v[i]; } }
#pragma unroll
        for (int i = 0; i < 16; ++i) { LAS float* d = scr + (8 * i + (lane >> 3)) * 33 + 4 * (lane & 7); d[0] = v[i][0]; d[1] = v[i][1]; d[2] = v[i][2]; d[3] = v[i][3]; }
        LDS_WAIT(); asm volatile("" ::: "memory");
        const int c = lane & 7;
#pragma unroll
        for (int j = 0; j < 4; ++j) { const int n = (lane >> 3) + 8 * j; const LAS float* q = scr + (16 * c) * 33 + n;
            v4u o; o.x = pk4_fp8(q[0 * 33] * scale, q[1 * 33] * scale, q[2 * 33] * scale, q[3 * 33] * scale); o.y = pk4_fp8(q[4 * 33] * scale, q[5 * 33] * scale, q[6 * 33] * scale, q[7 * 33] * scale);
            o.z = pk4_fp8(q[8 * 33] * scale, q[9 * 33] * scale, q[10 * 33] * scale, q[11 * 33] * scale); o.w = pk4_fp8(q[12 * 33] * scale, q[13 * 33] * scale, q[14 * 33] * scale, q[15 * 33] * scale);
            const int row = PERM_IN ? win_dst_col(n0 + n) : n0 + n;
            *(GAS v4u*)(WT + wpack_off(row, kofs + k0 + 16 * c, ldw)) = o; }
        LDS_WAIT(); asm volatile("" ::: "memory");
    }
    if (FOLD) {
#pragma unroll
        for (int j = 0; j < 4; ++j) { s1[j] += __shfl_xor(s1[j], 8); s1[j] += __shfl_xor(s1[j], 16); s1[j] += __shfl_xor(s1[j], 32); s2[j] += __shfl_xor(s2[j], 8); s2[j] += __shfl_xor(s2[j], 16); s2[j] += __shfl_xor(s2[j], 32); }
        float t1 = 0.f, t2 = 0.f;
#pragma unroll
        for (int j = 0; j < 4; ++j) { const float a1 = __shfl(s1[j], (lane >> 2) & 7), a2 = __shfl(s2[j], (lane >> 2) & 7); if ((lane & 3) == j) { t1 = a1; t2 = a2; } }
        if (lane < 32) { const int cc = n0 + lane, dc = PERM_IN ? win_dst_col(cc) : cc; atomic_addf(c1 + dc, t1); atomic_addf(c2 + dc, t2); } }
}
__device__ __forceinline__ void sincos_d(double a, float& c, float& s) {
    const double q = __builtin_rint(a * 0.63661977236758134308);
    const double r = (a - q * 1.5707963267948966192) - q * 6.123233995736766036e-17;
    const double r2 = r * r;
    const double sn = r * (1.0 + r2 * (-1.0 / 6 + r2 * (1.0 / 120 + r2 * (-1.0 / 5040 + r2 * (1.0 / 362880 + r2 * (-1.0 / 39916800 + r2 * (1.0 / 6227020800.0)))))));
    const double cs = 1.0 + r2 * (-0.5 + r2 * (1.0 / 24 + r2 * (-1.0 / 720 + r2 * (1.0 / 40320 + r2 * (-1.0 / 3628800 + r2 * (1.0 / 479001600 + r2 * (-1.0 / 87178291200.0)))))));
    const int qi = (int)q & 3;
    const double sv = (qi == 0) ? sn : (qi == 1) ? cs : (qi == 2) ? -sn : -cs;
    const double cv = (qi == 0) ? cs : (qi == 1) ? -sn : (qi == 2) ? -cs : sn;
    c = (float)cv; s = (float)sv;
}
enum { PT_X, PT_POS, PT_WIN, PT_WPA, PT_WPB, PT_WOUT, PT_SINKS, PT_LN1G, PT_LN1B, PT_WUP, PT_CW, PT_CB, PT_WDN, PT_LN2G, PT_LN2B, PT_OUT, PT_WS, PT_N };
struct Ptrs { const void* p[PT_N]; };
__device__ __forceinline__ GAS unsigned char* ldptr(const Frame& F, int i) {
    unsigned off = LDSCTL_OFF + 8 * i; asm volatile("" : "+v"(off));
    const unsigned long long v = *(volatile LAS unsigned long long*)(F.lds + off);
    const unsigned lo = __builtin_amdgcn_readfirstlane((unsigned)v), hi = __builtin_amdgcn_readfirstlane((unsigned)(v >> 32));
    return (GAS unsigned char*)(((unsigned long long)hi << 32) | lo);
}
struct PPtrs { gcf *x, *w_in, *w_pa, *w_pb, *w_out, *w_up, *w_dn, *ln1g, *ln1b, *ln2g, *ln2b; GAS const int* pos; GAS unsigned char* ws; };
__device__ __forceinline__ void p0_prologue(Frame& F) {
    PPtrs P; P.x = (gcf*)ldptr(F, PT_X); P.w_in = (gcf*)ldptr(F, PT_WIN); P.w_pa = (gcf*)ldptr(F, PT_WPA); P.w_pb = (gcf*)ldptr(F, PT_WPB); P.w_out = (gcf*)ldptr(F, PT_WOUT);
    P.w_up = (gcf*)ldptr(F, PT_WUP); P.w_dn = (gcf*)ldptr(F, PT_WDN); P.ln1g = (gcf*)ldptr(F, PT_LN1G); P.ln1b = (gcf*)ldptr(F, PT_LN1B); P.ln2g = (gcf*)ldptr(F, PT_LN2G); P.ln2b = (gcf*)ldptr(F, PT_LN2B); P.pos = (GAS const int*)ldptr(F, PT_POS); P.ws = ldptr(F, PT_WS);
    LAS float* scr = (LAS float*)(F.lds + F.wave * (128 * 33 * 4));
    const int gw = F.vcu * NWAVES + F.wave, NGW = F.G * NWAVES;
    constexpr int I_IN = (DM / 512) * (IN_COLS / 32), I_PA = (A_OUT / 512) * (DM / 32), I_PB = (B_QW / 512) * (DM / 32), I_OUT = (DM / 512) * (DM / 32), I_UP = (DM / 256) * (UP_COLS / 64), I_DN = (DFF / 256) * (DM / 64);
    constexpr int I_LAYER = I_IN + I_PA + I_PB + I_OUT + I_UP + I_DN;
    gf* cv = (gf*)(P.ws + WS_CVEC);
    for (int it = gw; it < DEPTH * I_LAYER; it += NGW) {
        const int l = it / I_LAYER; int r = it - l * I_LAYER;
        GAS unsigned char* wl = P.ws + WS_W + (size_t)l * LW_BYTES;
        if (r < I_IN) { if (l == 0) p0_transpose_item8<true, false>(P.w_in, DM, IN_COLS, wl + LW_IN, DM, 0, F8S_WIN, nullptr, nullptr, nullptr, nullptr, scr, r, F.lane);
                        else p0_transpose_item8<true, true>(P.w_in + (size_t)l * DM * IN_COLS, DM, IN_COLS, wl + LW_IN, DM, 0, F8S_WIN, P.ln2g + (l - 1) * DM, P.ln2b + (l - 1) * DM, cv + CV_C1IN + l * IN_COLS, cv + CV_C2IN + l * IN_COLS, scr, r, F.lane);
                        continue; } r -= I_IN;
        if (r < I_PA) { p0_transpose_item8<false, false>(P.w_pa + (size_t)l * A_OUT * DM, A_OUT, DM, wl + LW_PA, YW, 0, F8S_WPA, nullptr, nullptr, nullptr, nullptr, scr, r, F.lane); continue; } r -= I_PA;
        if (r < I_PB) { p0_transpose_item8<false, false>(P.w_pb + (size_t)l * B_QW * DM, B_QW, DM, wl + LW_PA, YW, A_OUT, F8S_WPB, nullptr, nullptr, nullptr, nullptr, scr, r, F.lane); continue; } r -= I_PB;
        if (r < I_OUT) { p0_transpose_item8<false, false>(P.w_out + (size_t)l * DM * DM, DM, DM, wl + LW_OUT, DM, 0, F8S_WOUT, nullptr, nullptr, nullptr, nullptr, scr, r, F.lane); continue; } r -= I_OUT;
        if (r < I_UP) { p0_transpose_item<true, true>(P.w_up + (size_t)l * DM * UP_COLS, DM, UP_COLS, (gbf*)(wl + LW_UP), P.ln1g + l * DM, P.ln1b + l * DM, cv + CV_C1UP + l * UP_COLS, cv + CV_C2UP + l * UP_COLS, scr, r, F.lane); continue; } r -= I_UP;
        p0_transpose_item<false, false>(P.w_dn + (size_t)l * DFF * DM, DFF, DM, (gbf*)(wl + LW_DN), nullptr, nullptr, nullptr, nullptr, scr, r, F.lane);
    }
    { const int gt = F.vcu * (NWAVES * 64) + F.tid, NT = F.G * NWAVES * 64; GAS unsigned char* X8 = P.ws + WS_XB;
      for (int i = gt; i < M * DM / 16; i += NT) { const GAS f32x4* q = (const GAS f32x4*)(P.x + (size_t)i * 16); const f32x4 a = q[0] * F8S_X, b = q[1] * F8S_X, c = q[2] * F8S_X, d = q[3] * F8S_X;
          v4u o; o.x = pk4_fp8(a[0], a[1], a[2], a[3]); o.y = pk4_fp8(b[0], b[1], b[2], b[3]); o.z = pk4_fp8(c[0], c[1], c[2], c[3]); o.w = pk4_fp8(d[0], d[1], d[2], d[3]); *(GAS v4u*)(X8 + (size_t)i * 16) = o; }
      gf* ra = (gf*)(P.ws + WS_ROPEA); gf* rb = (gf*)(P.ws + WS_ROPEB);
      constexpr double INVF[16] = {1.0, 0.44036660267178046, 0.19392274474868576, 0.08539710028576561, 0.03760603093086393, 0.016560440080994446, 0.007292664737217109, 0.003211445994752591,
                                   0.001414213562373095, 0.000622772421914596, 0.0002742481756762073, 0.00012076973741146504, 5.318295896944988e-05, 2.341999896140934e-05, 1.031338537721246e-05, 4.5416704806078695e-06};
      for (int m = gt; m < M; m += NT) { const double pos = (double)P.pos[m];
#pragma unroll
          for (int j = 0; j < 16; ++j) { float c, s; sincos_d(pos * INVF[j], c, s); ra[(size_t)m * 32 + j] = c; ra[(size_t)m * 32 + 16 + j] = s;
              if ((j & 1) == 0) { rb[(size_t)m * 16 + (j >> 1)] = c; rb[(size_t)m * 16 + 8 + (j >> 1)] = s; } } }
    }
}

__device__ __forceinline__ void ln_final_phase(Frame& F, GAS const unsigned short* H, gcf* g, gcf* b, gf* out) {
    const int gw = F.vcu * NWAVES + F.wave, NGW = F.G * NWAVES;
    for (int m = gw; m < M; m += NGW) {
        const GAS v4u* hr = (const GAS v4u*)(H + (size_t)m * DM) + F.lane;
        f32x4 v[8][2]; float s = 0.f;
#pragma unroll
        for (int j = 0; j < 8; ++j) { pg8::unpk8_f16(__builtin_bit_cast(pg8::u32x4, hr[64 * j]), v[j][0], v[j][1]); s += ((v[j][0][0] + v[j][0][1]) + (v[j][0][2] + v[j][0][3])) + ((v[j][1][0] + v[j][1][1]) + (v[j][1][2] + v[j][1][3])); }
        const float mean = wave_sum(s) * (1.f / DM); float s2 = 0.f;
#pragma unroll
        for (int j = 0; j < 8; ++j)
#pragma unroll
            for (int h = 0; h < 2; ++h) { v[j][h] = v[j][h] - mean; s2 += (v[j][h][0] * v[j][h][0] + v[j][h][1] * v[j][h][1]) + (v[j][h][2] * v[j][h][2] + v[j][h][3] * v[j][h][3]); }
        const float rstd = 1.f / sqrtf(wave_sum(s2) * (1.f / DM) + LN_EPS);
#pragma unroll
        for (int j = 0; j < 8; ++j)
#pragma unroll
            for (int h = 0; h < 2; ++h) { const int c = 8 * (F.lane + 64 * j) + 4 * h; *(GAS f32x4*)(out + (size_t)m * DM + c) = v[j][h] * rstd * *(const GAS f32x4*)(g + c) + *(const GAS f32x4*)(b + c); }
    }
}

__device__ __forceinline__ void stats_to_lds(Frame& F, gcf* STP, int pm) {
    const int row = F.tid >> 1, half = F.tid & 1;
    const GAS f32x4* p = (const GAS f32x4*)(STP + ((size_t)(pm * 256 + row) * 64 + 32 * half) * 2);
    float sm = 0.f, sq = 0.f;
#pragma unroll
    for (int i = 0; i < 16; ++i) { const f32x4 v = p[i]; sm += v[0] + v[2]; sq += v[1] + v[3]; }
    sm += pg8::lx(sm, 1, F.lane); sq += pg8::lx(sq, 1, F.lane);
    const float mu = sm * (1.f / DM), var = sq * (1.f / DM) - mu * mu;
    if (half == 0) *(LAS f32x2v*)(F.lds + pg8::ST_OFF + row * 8) = (f32x2v){mu, 1.f / sqrtf(var + LN_EPS)};
    __syncthreads();
}

__device__ __forceinline__ void conv_fixup(Frame& F, int pm, gcf* SBL, gcf* SBF, gcf* cw, gcf* cb, gbf* HA) {
    const bool first = (pm & (SEQ / 256 - 1)) == 0;
    const int pl = first ? pm : pm - 1;
#pragma unroll
    for (int i = 0; i < 4; ++i) { const int c = 4 * (F.tid + 512 * i);
        f32x4 o[2][2];
#pragma unroll
        for (int gvh = 0; gvh < 2; ++gvh) { const int cc = c + gvh * DFF;
            f32x4 um2 = *(const GAS f32x4*)(SBL + (size_t)pl * 2 * UP_COLS + cc), um1 = *(const GAS f32x4*)(SBL + (size_t)pl * 2 * UP_COLS + UP_COLS + cc);
            if (first) { um2 = (f32x4){0.f, 0.f, 0.f, 0.f}; um1 = um2; }
            const f32x4 u0 = *(const GAS f32x4*)(SBF + (size_t)pm * 2 * UP_COLS + cc), u1 = *(const GAS f32x4*)(SBF + (size_t)pm * 2 * UP_COLS + UP_COLS + cc);
            const f32x4 w0 = *(const GAS f32x4*)(cw + cc), w1 = *(const GAS f32x4*)(cw + UP_COLS + cc), w2 = *(const GAS f32x4*)(cw + 2 * UP_COLS + cc), bb = *(const GAS f32x4*)(cb + cc);
            o[0][gvh] = w0 * um2 + w1 * um1 + w2 * u0 + bb; o[1][gvh] = w0 * um1 + w1 * u0 + w2 * u1 + bb; }
#pragma unroll
        for (int t = 0; t < 2; ++t) { const f32x4 g = o[t][0], v = o[t][1];
            *(GAS unsigned long long*)(HA + (size_t)(pm * 256 + t) * DFF + c) = (unsigned long long)cvtpk(pg8::silu_mul(g[0], v[0]), pg8::silu_mul(g[1], v[1])) | ((unsigned long long)cvtpk(pg8::silu_mul(g[2], v[2]), pg8::silu_mul(g[3], v[3])) << 32); } }
    asm volatile("s_waitcnt vmcnt(0)" ::: "memory"); __syncthreads();
}

__device__ __forceinline__ void conv_phase(Frame& F, gcbf* U, gcf* cw, gcf* cb, gbf* HA) {
    const int gt = F.vcu * (NWAVES * 64) + F.tid, NT = F.G * NWAVES * 64;
    for (int item = gt; item < (DFF / 8) * (M / 64); item += NT) {
        const int c0 = 8 * (item & (DFF / 8 - 1)), t0 = 64 * (item >> 10);
        f32x4 wg[3][2], wv[3][2], bg[2], bv[2];
#pragma unroll
        for (int h = 0; h < 2; ++h) {
#pragma unroll
            for (int i = 0; i < 3; ++i) { wg[i][h] = *(const GAS f32x4*)(cw + (size_t)i * UP_COLS + c0 + 4 * h); wv[i][h] = *(const GAS f32x4*)(cw + (size_t)i * UP_COLS + DFF + c0 + 4 * h); }
            bg[h] = *(const GAS f32x4*)(cb + c0 + 4 * h); bv[h] = *(const GAS f32x4*)(cb + DFF + c0 + 4 * h); }
        f32x4 g1[2], g2[2], v1[2], v2[2];
        const bool first = (t0 & (SEQ - 1)) == 0;
        { const int ta = first ? t0 : t0 - 1, tb = first ? t0 : t0 - 2;
          const v4u a = *(const GAS v4u*)(U + (size_t)ta * UP_COLS + c0), av = *(const GAS v4u*)(U + (size_t)ta * UP_COLS + DFF + c0);
          const v4u b = *(const GAS v4u*)(U + (size_t)tb * UP_COLS + c0), bw = *(const GAS v4u*)(U + (size_t)tb * UP_COLS + DFF + c0);
          const float z = first ? 0.f : 1.f;
          g1[0] = (f32x4){bflo(a.x), bfhi(a.x), bflo(a.y), bfhi(a.y)} * z; g1[1] = (f32x4){bflo(a.z), bfhi(a.z), bflo(a.w), bfhi(a.w)} * z;
          v1[0] = (f32x4){bflo(av.x), bfhi(av.x), bflo(av.y), bfhi(av.y)} * z; v1[1] = (f32x4){bflo(av.z), bfhi(av.z), bflo(av.w), bfhi(av.w)} * z;
          g2[0] = (f32x4){bflo(b.x), bfhi(b.x), bflo(b.y), bfhi(b.y)} * z; g2[1] = (f32x4){bflo(b.z), bfhi(b.z), bflo(b.w), bfhi(b.w)} * z;
          v2[0] = (f32x4){bflo(bw.x), bfhi(bw.x), bflo(bw.y), bfhi(bw.y)} * z; v2[1] = (f32x4){bflo(bw.z), bfhi(bw.z), bflo(bw.w), bfhi(bw.w)} * z; }
#pragma unroll 4
        for (int t = t0; t < t0 + 64; ++t) {
            const v4u a = *(const GAS v4u*)(U + (size_t)t * UP_COLS + c0), av = *(const GAS v4u*)(U + (size_t)t * UP_COLS + DFF + c0);
            f32x4 gc[2], vc[2], hh[2];
            gc[0] = (f32x4){bflo(a.x), bfhi(a.x), bflo(a.y), bfhi(a.y)}; gc[1] = (f32x4){bflo(a.z), bfhi(a.z), bflo(a.w), bfhi(a.w)};
            vc[0] = (f32x4){bflo(av.x), bfhi(av.x), bflo(av.y), bfhi(av.y)}; vc[1] = (f32x4){bflo(av.z), bfhi(av.z), bflo(av.w), bfhi(av.w)};
#pragma unroll
            for (int h = 0; h < 2; ++h) {
                const f32x4 ug = wg[0][h] * g2[h] + wg[1][h] * g1[h] + wg[2][h] * gc[h] + bg[h];
                const f32x4 uv = wv[0][h] * v2[h] + wv[1][h] * v1[h] + wv[2][h] * vc[h] + bv[h];
#pragma unroll
                for (int j = 0; j < 4; ++j) hh[h][j] = ug[j] * sigmoidf_dev(ug[j]) * uv[j];
                g2[h] = g1[h]; g1[h] = gc[h]; v2[h] = v1[h]; v1[h] = vc[h]; }
            v4u o; o.x = cvtpk(hh[0][0], hh[0][1]); o.y = cvtpk(hh[0][2], hh[0][3]); o.z = cvtpk(hh[1][0], hh[1][1]); o.w = cvtpk(hh[1][2], hh[1][3]);
            *(GAS v4u*)(HA + (size_t)t * DFF + c0) = o;
        }
    }
}

__device__ __forceinline__ v4i16_t vtr(const LAS unsigned char* p) { return __builtin_amdgcn_ds_read_tr16_b64_v4i16((LAS v4i16_t*)p); }
template <int HD, int KS, int MAXD>
__device__ __forceinline__ void attn_wave(const LAS unsigned char* Kl, const LAS unsigned char* Vl, const bf16x8 (&qf)[HD / 32], int w, int lane, bool first_blk, float sink2, bool has_sink,
                                          f32x4 (&o)[HD / 16], float& mx_out, float& l_out) {
    int lane_o = lane; asm volatile("" : "+v"(lane_o));
    const int fr = lane_o & 15, fq = lane_o >> 4, sb = 32 * (w >> 1);
    f32x4 S[10];
    constexpr int KK = HD / 32;
    const LAS unsigned char* kp0 = Kl + (sb + 8 * (fr >> 2) + (fr & 3)) * KS + 16 * fq;
    bf16x8 ka[2][2 * KK];
#define AT_LDK(ks_, bb_) _Pragma("unroll") for (int t = 0; t < 2; ++t) _Pragma("unroll") for (int kk = 0; kk < KK; ++kk) ka[bb_][t * KK + kk] = *(const LAS bf16x8*)(kp0 + (32 * (ks_) + 4 * t) * KS + 64 * kk)
    AT_LDK(0, 0);
#pragma unroll
    for (int ks = 0; ks < 5; ++ks) {
        if (ks + 1 < 5) { AT_LDK(ks + 1, (ks + 1) & 1); }
        __builtin_amdgcn_sched_barrier(0);
        S[2 * ks] = (f32x4){0.f, 0.f, 0.f, 0.f}; S[2 * ks + 1] = (f32x4){0.f, 0.f, 0.f, 0.f};
#pragma unroll
        for (int kk = 0; kk < KK; ++kk)
#pragma unroll
            for (int t = 0; t < 2; ++t) S[2 * ks + t] = __builtin_amdgcn_mfma_f32_16x16x32_bf16(ka[ks & 1][t * KK + kk], qf[kk], S[2 * ks + t], 0, 0, 0);
        __builtin_amdgcn_sched_barrier(0);
    }
#undef AT_LDK
    const int Lq = fr - 8 * fq, c0 = 128 + 16 * w - sb; float mx = -INFINITY;
    const int thr0 = first_blk ? -1000 : MAXD - c0, thr4 = 128 - c0;
#pragma unroll
    for (int ks = 0; ks < 5; ++ks)
#pragma unroll
        for (int t = 0; t < 2; ++t)
#pragma unroll
            for (int r = 0; r < 4; ++r) { float s = S[2 * ks + t][r];
                if (ks == 0) s = (Lq <= thr0 + 4 * t + r) ? s : -INFINITY;
                else if (ks == 4) s = (Lq >= thr4 + 4 * t + r) ? s : -INFINITY;
                else s = (first_blk && sb + 32 * ks < 128) ? -INFINITY : s;
                S[2 * ks + t][r] = s; mx = fmaxf(mx, s); }
    mx = fmaxf(mx, pg8::lx(mx, 16, lane_o)); mx = fmaxf(mx, pg8::lx(mx, 32, lane_o));
    if (has_sink) mx = fmaxf(mx, sink2);
    float l = 0.f;
#pragma unroll
    for (int T = 0; T < 10; ++T)
#pragma unroll
        for (int r = 0; r < 4; ++r) { const float p = __builtin_amdgcn_exp2f(S[T][r] - mx); S[T][r] = p; l += p; }
    l += pg8::lx(l, 16, lane_o); l += pg8::lx(l, 32, lane_o);
    if (has_sink) l += __builtin_amdgcn_exp2f(sink2 - mx);
    bf16x8 pf[5];
#pragma unroll
    for (int ks = 0; ks < 5; ++ks) { v4u pw; pw.x = cvtpk(S[2 * ks][0], S[2 * ks][1]); pw.y = cvtpk(S[2 * ks][2], S[2 * ks][3]); pw.z = cvtpk(S[2 * ks + 1][0], S[2 * ks + 1][1]); pw.w = cvtpk(S[2 * ks + 1][2], S[2 * ks + 1][3]);
        pf[ks] = __builtin_bit_cast(bf16x8, pw); }
    const LAS unsigned char* vp = Vl + (sb + 8 * fq + ((lane_o & 15) >> 2)) * KS + 8 * (lane_o & 3);
    constexpr int ND = HD / 16;
    v4i16_t va[2][2 * ND];
#define AT_LDV(ks_, bb_) _Pragma("unroll") for (int dt = 0; dt < ND; ++dt) { va[bb_][2 * dt] = vtr(vp + (32 * (ks_)) * KS + 32 * dt); va[bb_][2 * dt + 1] = vtr(vp + (32 * (ks_) + 4) * KS + 32 * dt); }
    AT_LDV(0, 0);
#pragma unroll
    for (int dt = 0; dt < ND; ++dt) o[dt] = (f32x4){0.f, 0.f, 0.f, 0.f};
#pragma unroll
    for (int ks = 0; ks < 5; ++ks) {
        if (ks + 1 < 5) { AT_LDV(ks + 1, (ks + 1) & 1); }
        __builtin_amdgcn_sched_barrier(0);
#pragma unroll
        for (int dt = 0; dt < ND; ++dt) { const v4i16_t lo = va[ks & 1][2 * dt], hi = va[ks & 1][2 * dt + 1];
            const bf16x8 vf = (bf16x8){lo[0], lo[1], lo[2], lo[3], hi[0], hi[1], hi[2], hi[3]};
            o[dt] = __builtin_amdgcn_mfma_f32_16x16x32_bf16(vf, pf[ks], o[dt], 0, 0, 0); }
        __builtin_amdgcn_sched_barrier(0);
    }
#undef AT_LDV
    mx_out = mx; l_out = l;
}

__device__ __forceinline__ void attnA_phase(Frame& F, gcbf* PROJ, gbf* OG, gf* LSE) {
    LAS unsigned char* Kl = F.lds; LAS unsigned char* Vl = F.lds + 256 * KSA;
    const int lane = F.lane, w = F.wave, fr = lane & 15, fq = lane >> 4;
    for (int u = F.bid; u < 768; u += F.G) {
        const int b = u / 384, h = (u >> 5) % 12, cq = u & 31, grp = h >> 2, slot = h & 3;
        const int lr = 2 * grp;
        const int c = cq >> (5 - lr), qb = cq & ((32 >> lr) - 1);
        gcbf* kbase = PROJ + KA_OFF + h * 128; gcbf* vbase = PROJ + VA_OFF + h * 128;
        v4u kv[8], vv[8];
#pragma unroll
        for (int i = 0; i < 8; ++i) { const int rho = 32 * i + (F.tid >> 4), ch = F.tid & 15, p = 128 * (qb - 1) + rho, pc = p < 0 ? 0 : p;
            const size_t m = (size_t)b * SEQ + ((size_t)pc << lr) + c;
            kv[i] = *(const GAS v4u*)(kbase + m * IN_COLS + 8 * ch); vv[i] = *(const GAS v4u*)(vbase + m * IN_COLS + 8 * ch); }
        const int pq = 128 * qb + 16 * w + fr; const size_t mq = (size_t)b * SEQ + ((size_t)pq << lr) + c;
        bf16x8 qf[4];
#pragma unroll
        for (int kk = 0; kk < 4; ++kk) qf[kk] = *(const GAS bf16x8*)(PROJ + mq * IN_COLS + h * 128 + 32 * kk + 8 * fq);
#pragma unroll
        for (int i = 0; i < 8; ++i) { const int rho = 32 * i + (F.tid >> 4), ch = F.tid & 15; const bool z = (128 * (qb - 1) + rho) < 0;
            if (z) { kv[i] = (v4u){0u, 0u, 0u, 0u}; vv[i] = (v4u){0u, 0u, 0u, 0u}; }
            *(LAS v4u*)(Kl + rho * KSA + 16 * ch) = kv[i]; *(LAS v4u*)(Vl + rho * KSA + 16 * ch) = vv[i]; }
        __syncthreads();
        f32x4 o[8]; float mx, l;
        attn_wave<128, KSA, 128>(Kl, Vl, qf, w, lane, qb == 0, 0.f, false, o, mx, l);
        const float inv = 1.0f / l;
        gbf* op = OG + ((size_t)grp * M + mq) * 512 + slot * 128 + 4 * fq;
#pragma unroll
        for (int dt = 0; dt < 8; ++dt) { const f32x4 y = o[dt] * inv; *(GAS unsigned long long*)(op + 16 * dt) = (unsigned long long)cvtpk(y[0], y[1]) | ((unsigned long long)cvtpk(y[2], y[3]) << 32); }
        if (fq == 0) LSE[((size_t)grp * M + mq) * 4 + slot] = mx + __builtin_amdgcn_logf(l);
        __syncthreads();
    }
}
__device__ __forceinline__ void attnB_phase(Frame& F, gcbf* PROJ, gcf* sinks, GAS unsigned char* YB8) {
    LAS unsigned char* Kl = F.lds; LAS unsigned char* Vl = F.lds + 256 * KSB;
    const int lane = F.lane, w = F.wave, fr = lane & 15, fq = lane >> 4;
    for (int u = F.bid; u < 256; u += F.G) {
        const int b = u >> 7, kvh = (u >> 5) & 3, qb = u & 31;
        gcbf* kbase = PROJ + KB_OFF + kvh * 64; gcbf* vbase = PROJ + VB_OFF + kvh * 64;
        v4u kv[4], vv[4];
#pragma unroll
        for (int i = 0; i < 4; ++i) { const int idx = 512 * i + F.tid, rho = idx >> 3, ch = idx & 7, t = 128 * (qb - 1) + rho, tc = t < 0 ? 0 : t;
            const size_t m = (size_t)b * SEQ + tc;
            kv[i] = *(const GAS v4u*)(kbase + m * IN_COLS + 8 * ch); vv[i] = *(const GAS v4u*)(vbase + m * IN_COLS + 8 * ch); }
#pragma unroll
        for (int i = 0; i < 4; ++i) { const int idx = 512 * i + F.tid, rho = idx >> 3, ch = idx & 7; const bool z = (128 * (qb - 1) + rho) < 0;
            if (z) { kv[i] = (v4u){0u, 0u, 0u, 0u}; vv[i] = (v4u){0u, 0u, 0u, 0u}; }
            *(LAS v4u*)(Kl + rho * KSB + 16 * ch) = kv[i]; *(LAS v4u*)(Vl + rho * KSB + 16 * ch) = vv[i]; }
        __syncthreads();
        const size_t mq = (size_t)b * SEQ + 128 * qb + 16 * w + fr;
#pragma unroll 1
        for (int g = 0; g < 8; ++g) { const int hq = kvh * 8 + g;
            bf16x8 qf[2];
#pragma unroll
            for (int kk = 0; kk < 2; ++kk) qf[kk] = *(const GAS bf16x8*)(PROJ + mq * IN_COLS + QB_OFF + hq * 64 + 32 * kk + 8 * fq);
            f32x4 o[4]; float mx, l;
            const float sink2 = *(const __attribute__((address_space(4))) float*)(unsigned long long)(sinks + hq) * LOG2E;
            attn_wave<64, KSB, 127>(Kl, Vl, qf, w, lane, qb == 0, sink2, true, o, mx, l);
            const float inv = 1.0f / l;
            const float inv8 = inv * F8S_Y;
            GAS unsigned char* op = YB8 + mq * YW + A_OUT + hq * 64 + 4 * fq;
#pragma unroll
            for (int dt = 0; dt < 4; ++dt) { const f32x4 y = o[dt] * inv8; *(GAS unsigned*)(op + 16 * dt) = pk4_fp8(y[0], y[1], y[2], y[3]); } }
        __syncthreads();
    }
}
struct AUnitD { int b, h, grp, slot, lr, c, qb; };
__device__ __forceinline__ AUnitD attn_decodeA(int u) { AUnitD d; d.b = u / 384; d.h = (u >> 5) % 12; const int cq = u & 31; d.grp = d.h >> 2; d.slot = d.h & 3; d.lr = 2 * d.grp; d.c = cq >> (5 - d.lr); d.qb = cq & ((32 >> d.lr) - 1); return d; }
__device__ __forceinline__ v4u cvt8_bf16(unsigned w0, unsigned w1, float sc) {
    v4u r; r.x = __builtin_bit_cast(unsigned, __builtin_amdgcn_cvt_scalef32_pk_bf16_fp8(w0, sc, false)); r.y = __builtin_bit_cast(unsigned, __builtin_amdgcn_cvt_scalef32_pk_bf16_fp8(w0, sc, true));
    r.z = __builtin_bit_cast(unsigned, __builtin_amdgcn_cvt_scalef32_pk_bf16_fp8(w1, sc, false)); r.w = __builtin_bit_cast(unsigned, __builtin_amdgcn_cvt_scalef32_pk_bf16_fp8(w1, sc, true)); return r; }
__device__ __forceinline__ void attn_phase(Frame& F, const GAS unsigned char* Q8, gbf* OG, gf* LSE, gcf* sinks, GAS unsigned char* Y8) {
    typedef unsigned u32x2_ __attribute__((ext_vector_type(2)));
    const int lane = F.lane, w = F.wave, fr = lane & 15, fq = lane >> 4;
    v4u kv[4], vv[4]; u32x2_ qn[4];
#define AT_LOAD_A(d) do { const GAS unsigned char* kbase = Q8 + KA_OFF + (d).h * 128; const GAS unsigned char* vbase = Q8 + VA_OFF + (d).h * 128; \
        _Pragma("unroll") for (int i = 0; i < 4; ++i) { const int idx = 512 * i + F.tid, rho = idx >> 3, ch = idx & 7, p = 128 * ((d).qb - 1) + rho, pc = p < 0 ? 0 : p; \
            const size_t m = (size_t)(d).b * SEQ + ((size_t)pc << (d).lr) + (d).c; kv[i] = *(const GAS v4u*)(kbase + m * QW + 16 * ch); vv[i] = *(const GAS v4u*)(vbase + m * QW + 16 * ch); } \
        const size_t mq_ = (size_t)(d).b * SEQ + ((size_t)(128 * (d).qb + 16 * w + fr) << (d).lr) + (d).c; \
        _Pragma("unroll") for (int kk = 0; kk < 4; ++kk) qn[kk] = *(const GAS u32x2_*)(Q8 + mq_ * QW + (d).h * 128 + 32 * kk + 8 * fq); } while (0)
#define AT_LOAD_B(ub) do { const int b_ = (ub) >> 7, kvh_ = ((ub) >> 5) & 3, qb_ = (ub) & 31; const GAS unsigned char* kbase = Q8 + KB_OFF + kvh_ * 64; const GAS unsigned char* vbase = Q8 + VB_OFF + kvh_ * 64; \
        _Pragma("unroll") for (int i = 0; i < 2; ++i) { const int idx = 512 * i + F.tid, rho = idx >> 2, ch = idx & 3, t = 128 * (qb_ - 1) + rho, tc = t < 0 ? 0 : t; const size_t m = (size_t)b_ * SEQ + tc; \
            kv[i] = *(const GAS v4u*)(kbase + m * QW + 16 * ch); vv[i] = *(const GAS v4u*)(vbase + m * QW + 16 * ch); } \
        const size_t mq_ = (size_t)b_ * SEQ + 128 * qb_ + 16 * w + fr; \
        _Pragma("unroll") for (int kk = 0; kk < 2; ++kk) qn[kk] = *(const GAS u32x2_*)(Q8 + mq_ * QW + QB_OFF + (kvh_ * 8) * 64 + 32 * kk + 8 * fq); } while (0)
#define AT_CVTQ(dst, kk_) do { const unsigned a_ = qn[kk_].x, b_ = qn[kk_].y; dst = __builtin_bit_cast(bf16x8, cvt8_bf16(a_, b_, 1.0f / F8S_Q)); } while (0)
    const int nbw = F.G - IN_TAIL, bw = F.bid - IN_TAIL, per = (256 + nbw - 1) / nbw; const int ub0 = bw * per; const int nB = bw < 0 ? 0 : (ub0 >= 256 ? 0 : (ub0 + per > 256 ? 256 - ub0 : per));
    int u = F.bid; bool haveB = false;
    if (u < 768) {
        AUnitD cu = attn_decodeA(u); AT_LOAD_A(cu);
        for (;;) {
            LAS unsigned char* Kl = F.lds; LAS unsigned char* Vl = F.lds + 256 * KSA;
#pragma unroll
            for (int i = 0; i < 4; ++i) { const int idx = 512 * i + F.tid, rho = idx >> 3, ch = idx & 7; const bool z = (128 * (cu.qb - 1) + rho) < 0;
                if (z) { kv[i] = (v4u){0u, 0u, 0u, 0u}; vv[i] = (v4u){0u, 0u, 0u, 0u}; }
                const unsigned k0 = kv[i].x, k1 = kv[i].y, k2 = kv[i].z, k3 = kv[i].w, v0 = vv[i].x, v1 = vv[i].y, v2 = vv[i].z, v3 = vv[i].w;
                *(LAS v4u*)(Kl + rho * KSA + 32 * ch) = cvt8_bf16(k0, k1, 1.0f / F8S_K); *(LAS v4u*)(Kl + rho * KSA + 32 * ch + 16) = cvt8_bf16(k2, k3, 1.0f / F8S_K);
                *(LAS v4u*)(Vl + rho * KSA + 32 * ch) = cvt8_bf16(v0, v1, 1.0f / F8S_V); *(LAS v4u*)(Vl + rho * KSA + 32 * ch + 16) = cvt8_bf16(v2, v3, 1.0f / F8S_V); }
            bf16x8 qf[4];
#pragma unroll
            for (int kk = 0; kk < 4; ++kk) AT_CVTQ(qf[kk], kk);
            __syncthreads();
            const int un = u + F.G; const bool moreA = un < 768; AUnitD nu = cu;
            if (moreA) { nu = attn_decodeA(un); AT_LOAD_A(nu); } else if (nB > 0) { AT_LOAD_B(ub0); haveB = true; }
            f32x4 o[8]; float mx, l;
            attn_wave<128, KSA, 128>(Kl, Vl, qf, w, lane, cu.qb == 0, 0.f, false, o, mx, l);
            const float inv = 1.0f / l;
            const size_t mq = (size_t)cu.b * SEQ + ((size_t)(128 * cu.qb + 16 * w + fr) << cu.lr) + cu.c;
            gbf* op = OG + ((size_t)cu.grp * M + mq) * 512 + cu.slot * 128 + 4 * fq;
#pragma unroll
            for (int dt = 0; dt < 8; ++dt) { const f32x4 y = o[dt] * inv; *(GAS unsigned long long*)(op + 16 * dt) = (unsigned long long)cvtpk(y[0], y[1]) | ((unsigned long long)cvtpk(y[2], y[3]) << 32); }
            if (fq == 0) LSE[((size_t)cu.grp * M + mq) * 4 + cu.slot] = mx + __builtin_amdgcn_logf(l);
            __syncthreads();
            if (!moreA) break;
            u = un; cu = nu;
        }
    }
    for (int ub = ub0; ub < ub0 + nB; ++ub) {
        if (!haveB) AT_LOAD_B(ub);
        haveB = false;
        const int b = ub >> 7, kvh = (ub >> 5) & 3, qb = ub & 31;
        LAS unsigned char* Kl = F.lds; LAS unsigned char* Vl = F.lds + 256 * KSB;
#pragma unroll
        for (int i = 0; i < 2; ++i) { const int idx = 512 * i + F.tid, rho = idx >> 2, ch = idx & 3; const bool z = (128 * (qb - 1) + rho) < 0;
            if (z) { kv[i] = (v4u){0u, 0u, 0u, 0u}; vv[i] = (v4u){0u, 0u, 0u, 0u}; }
            const unsigned k0 = kv[i].x, k1 = kv[i].y, k2 = kv[i].z, k3 = kv[i].w, v0 = vv[i].x, v1 = vv[i].y, v2 = vv[i].z, v3 = vv[i].w;
            *(LAS v4u*)(Kl + rho * KSB + 32 * ch) = cvt8_bf16(k0, k1, 1.0f / F8S_K); *(LAS v4u*)(Kl + rho * KSB + 32 * ch + 16) = cvt8_bf16(k2, k3, 1.0f / F8S_K);
            *(LAS v4u*)(Vl + rho * KSB + 32 * ch) = cvt8_bf16(v0, v1, 1.0f / F8S_V); *(LAS v4u*)(Vl + rho * KSB + 32 * ch + 16) = cvt8_bf16(v2, v3, 1.0f / F8S_V); }
        __syncthreads();
        const size_t mq = (size_t)b * SEQ + 128 * qb + 16 * w + fr;
#pragma unroll 1
        for (int g = 0; g < 8; ++g) { const int hq = kvh * 8 + g;
            bf16x8 qf[2]; AT_CVTQ(qf[0], 0); AT_CVTQ(qf[1], 1);
            if (g < 7) {
#pragma unroll
                for (int kk = 0; kk < 2; ++kk) qn[kk] = *(const GAS u32x2_*)(Q8 + mq * QW + QB_OFF + (hq + 1) * 64 + 32 * kk + 8 * fq); }
            f32x4 o[4]; float mx, l;
            const float sink2 = *(const __attribute__((address_space(4))) float*)(unsigned long long)(sinks + hq) * LOG2E;
            attn_wave<64, KSB, 127>(Kl, Vl, qf, w, lane, qb == 0, sink2, true, o, mx, l);
            const float inv8 = (1.0f / l) * F8S_Y;
            GAS unsigned char* op = Y8 + mq * YW + A_OUT + hq * 64 + 4 * fq;
#pragma unroll
            for (int dt = 0; dt < 4; ++dt) { const f32x4 y = o[dt] * inv8; *(GAS unsigned*)(op + 16 * dt) = pk4_fp8(y[0], y[1], y[2], y[3]); } }
        __syncthreads();
    }
#undef AT_LOAD_A
#undef AT_LOAD_B
#undef AT_CVTQ
}

__device__ __forceinline__ void combine_phase(Frame& F, gcbf* OG, gcf* LSE, GAS unsigned char* YA8) {
    const int gt = F.vcu * (NWAVES * 64) + F.tid, NT = F.G * NWAVES * 64;
    for (int item = gt; item < M * 128; item += NT) {
        const int m = item >> 7, j = (item >> 5) & 3, d4 = item & 31;
        const float l0 = LSE[((size_t)0 * M + m) * 4 + j], l1 = LSE[((size_t)1 * M + m) * 4 + j], l2 = LSE[((size_t)2 * M + m) * 4 + j];
        const float mx = fmaxf(l0, fmaxf(l1, l2));
        const float e0 = __builtin_amdgcn_exp2f(l0 - mx), e1 = __builtin_amdgcn_exp2f(l1 - mx), e2 = __builtin_amdgcn_exp2f(l2 - mx), inv = 1.0f / (e0 + e1 + e2);
        const size_t off = (size_t)m * 512 + j * 128 + 4 * d4;
        const unsigned long long wa = *(const GAS unsigned long long*)(OG + off), wb = *(const GAS unsigned long long*)(OG + (size_t)M * 512 + off), wc = *(const GAS unsigned long long*)(OG + (size_t)2 * M * 512 + off);
        const f32x4 a = (f32x4){bflo((unsigned)wa), bfhi((unsigned)wa), bflo((unsigned)(wa >> 32)), bfhi((unsigned)(wa >> 32))}, bq = (f32x4){bflo((unsigned)wb), bfhi((unsigned)wb), bflo((unsigned)(wb >> 32)), bfhi((unsigned)(wb >> 32))},
                    cq = (f32x4){bflo((unsigned)wc), bfhi((unsigned)wc), bflo((unsigned)(wc >> 32)), bfhi((unsigned)(wc >> 32))};
        const f32x4 y = (a * e0 + bq * e1 + cq * e2) * (inv * F8S_Y);
        *(GAS unsigned*)(YA8 + (size_t)m * YW + j * 128 + 4 * d4) = pk4_fp8(y[0], y[1], y[2], y[3]);
    }
}

struct Args { Ptrs p; int ph_lo, ph_hi; };
__global__ void __launch_bounds__(NWAVES * 64, 2) fwd_kernel(Args args) {
    extern __shared__ __attribute__((aligned(16))) unsigned char lds[];
    Frame F;
    F.lds = (LAS unsigned char*)lds;
    F.MISC = (volatile LAS unsigned*)(F.lds + MISC_OFF);
    F.tid = threadIdx.x; F.lane = F.tid & 63; F.wave = __builtin_amdgcn_readfirstlane(F.tid >> 6);
    F.bid = blockIdx.x; F.G = gridDim.x; { const int bx = blockIdx.x; F.vcu = (F.G % 8 == 0) ? (bx % 8) * (F.G / 8) + bx / 8 : bx; }
    for (int u = F.tid; u < (LDS_BYTES - LDSCTL_OFF) / 4; u += NWAVES * 64) ((LAS unsigned*)(F.lds + LDSCTL_OFF))[u] = 0u;
    __syncthreads();
    if (F.tid == 0) {
#pragma unroll
        for (int i = 0; i < PT_N; ++i) ((LAS unsigned long long*)(F.lds + LDSCTL_OFF))[i] = (unsigned long long)args.p.p[i]; }
    __syncthreads();
    F.ctl = (gu32*)(ldptr(F, PT_WS) + WS_CTL);
    if (!MK_PER_PHASE) (void)xcd_barrier_post((unsigned*)(F.ctl + CW_BAR), F.MISC + 8);
#define GRID_BAR() do { if (MK_PER_PHASE) { if (F.tid == 0) __hip_atomic_store((gu32*)(ldptr(F, PT_WS) + WS_CTL) + CW_TMO, 0xBADBA0u, RLX_AGENT); } else { XcdBarrier bar_; bar_.bar = (unsigned*)((gu32*)(ldptr(F, PT_WS) + WS_CTL) + CW_BAR); bar_.x = xb_xcc_id(); bar_.st = (volatile LAS unsigned*)(F.lds + MISC_OFF) + 8; xcd_barrier(bar_); } } while (0)
#if MK_PER_PHASE
    const int lo = args.ph_lo, hi = args.ph_hi;
#else
    constexpr int lo = 0, hi = N_PHASES;
#endif
#define IN(k) (lo <= (k) && (k) < hi)
#define SEAM(k) do { if (IN((k) + 1)) GRID_BAR(); } while (0)
#define WSP(T, off) ((GAS T*)(ldptr(F, PT_WS) + (off)))
#define INP(T, i) ((GAS const T*)ldptr(F, (i)))
#define PHASE_IDS() int bid = blockIdx.x; asm volatile("" : "+s"(bid)); bid = __builtin_amdgcn_readfirstlane(bid); Frame Fp = F; asm volatile("" : "+v"(Fp.tid)); Fp.lane = Fp.tid & 63; Fp.wave = __builtin_amdgcn_readfirstlane(Fp.tid >> 6); asm volatile("" : "+s"(Fp.vcu)); Fp.vcu = __builtin_amdgcn_readfirstlane(Fp.vcu); Fp.bid = bid
#ifndef DBL_MASK
#define DBL_MASK 0
#endif
#define REPS(bit) ((((DBL_MASK) >> (bit)) & 1) + 1)
#define PHASE_BEGIN(k, bit) if (IN(k)) { _Pragma("unroll 1") for (int rep_ = 0; rep_ < REPS(bit); ++rep_) { PHASE_IDS();
#define PHASE_END(k, bit, seam) if (rep_ + 1 < REPS(bit)) GRID_BAR(); } if (seam) SEAM(k); }

    PHASE_BEGIN(0, 0) p0_prologue(Fp); PHASE_END(0, 0, true)

    for (int l = 0; l < DEPTH; ++l) {
        const int g0 = 1 + l * PH_PER_LAYER;
        const size_t wl = WS_W + (size_t)l * LW_BYTES;

        PHASE_BEGIN(g0 + 0, 1)
            pg8::Gemm g{(const bf16*)WSP(bf16, WS_XB), (const bf16*)WSP(bf16, wl + LW_IN), M, IN_COLS, DM / 2};   pg8::StaticOrder S; S.init(M, IN_COLS, F.G, bid); S.nr = IN_FULL_ROUNDS;
            if (l > 0) { pg8::Unit u0; S.next(0, u0); stats_to_lds(Fp, WSP(float, WS_STP2), u0.pm); }
            pg8::EpiIn E{WSP(unsigned char, WS_PROJ), WSP(float, WS_ROPEA), WSP(float, WS_ROPEB), WSP(float, WS_CVEC) + CV_C1IN + l * IN_COLS, WSP(float, WS_CVEC) + CV_C2IN + l * IN_COLS, F.lds, l > 0 ? 1 : 0, WSP(unsigned char, WS_G8)};
            pg8::gemm_phase<pg8::EpiIn, pg8::StaticOrder, true, true, F8_X, F8_WIN>(F.lds + RING_OFF, g, S, E);
        PHASE_END(g0 + 0, 1, true)
        PHASE_BEGIN(g0 + 1, 2)
            { pg8::Gemm g{(const bf16*)WSP(bf16, WS_XB), (const bf16*)WSP(bf16, wl + LW_IN), M, IN_COLS, DM / 2}; pg8::StaticOrder S; S.init(M, IN_COLS, F.G, bid); S.i0 = IN_FULL_ROUNDS;
              pg8::Unit u0;
              if (S.next(0, u0)) {
                  if (l > 0) stats_to_lds(Fp, WSP(float, WS_STP2), u0.pm);
                  pg8::EpiIn E{WSP(unsigned char, WS_PROJ), WSP(float, WS_ROPEA), WSP(float, WS_ROPEB), WSP(float, WS_CVEC) + CV_C1IN + l * IN_COLS, WSP(float, WS_CVEC) + CV_C2IN + l * IN_COLS, F.lds, l > 0 ? 1 : 0, WSP(unsigned char, WS_G8)};
                  pg8::gemm_phase<pg8::EpiIn, pg8::StaticOrder, true, true, F8_X, F8_WIN>(F.lds + RING_OFF, g, S, E);
                  __syncthreads(); } }
            attn_phase(Fp, WSP(unsigned char, WS_PROJ), WSP(bf16, WS_OG), WSP(float, WS_LSE), INP(float, PT_SINKS) + l * 32, WSP(unsigned char, WS_YA));
        PHASE_END(g0 + 1, 2, true)
        PHASE_BEGIN(g0 + 2, 3) combine_phase(Fp, WSP(bf16, WS_OG), WSP(float, WS_LSE), WSP(unsigned char, WS_YA)); PHASE_END(g0 + 2, 3, true)
        PHASE_BEGIN(g0 + 3, 4)
            pg8::Gemm g{(const bf16*)WSP(bf16, WS_YA), (const bf16*)WSP(bf16, wl + LW_PA), M, DM, YW / 2}; pg8::StaticOrder S; S.init(M, DM, F.G, bid);
            pg8::EpiGate E{WSP(unsigned char, WS_MG), WSP(unsigned char, WS_G8)};
            pg8::gemm_phase<pg8::EpiGate, pg8::StaticOrder, true, true, F8_Y, F8_WPA>(F.lds + RING_OFF, g, S, E);
        PHASE_END(g0 + 3, 4, true)
        PHASE_BEGIN(g0 + 4, 5)
            pg8::Gemm g{(const bf16*)WSP(bf16, WS_MG), (const bf16*)WSP(bf16, wl + LW_OUT), M, DM, DM / 2}; pg8::StaticOrder S; S.init(M, DM, F.G, bid);
            if (l > 0) { pg8::Unit u0; S.next(0, u0); stats_to_lds(Fp, WSP(float, WS_STP2), u0.pm); }
            pg8::EpiResLn<0, true> E{INP(float, PT_X), WSP(unsigned short, WS_HF), INP(float, PT_LN2G) + (l > 0 ? l - 1 : 0) * DM, INP(float, PT_LN2B) + (l > 0 ? l - 1 : 0) * DM, WSP(bf16, WS_XB), WSP(unsigned char, WS_XB), WSP(float, WS_STP1), F.lds, l > 0 ? 1 : 0};
            pg8::gemm_phase<pg8::EpiResLn<0, true>, pg8::StaticOrder, true, true, F8_MG, F8_WOUT>(F.lds + RING_OFF, g, S, E);
        PHASE_END(g0 + 4, 5, true)
        PHASE_BEGIN(g0 + 6, 7)
            pg8::Gemm g{(const bf16*)WSP(bf16, WS_XB), (const bf16*)WSP(bf16, wl + LW_UP), M, UP_COLS, DM}; pg8::StaticOrder S; S.init(M, UP_COLS, F.G, bid);
            { pg8::Unit u0; S.next(0, u0); stats_to_lds(Fp, WSP(float, WS_STP1), u0.pm); }
            pg8::EpiConv E{WSP(bf16, WS_HA), WSP(float, WS_CVEC) + CV_C1UP + l * UP_COLS, WSP(float, WS_CVEC) + CV_C2UP + l * UP_COLS, INP(float, PT_CW) + (size_t)l * 3 * UP_COLS, INP(float, PT_CB) + (size_t)l * UP_COLS, WSP(float, WS_SBL), WSP(float, WS_SBF), F.lds};
            pg8::gemm_phase<pg8::EpiConv, pg8::StaticOrder, true, true, 0, 0, true>(F.lds + RING_OFF, g, S, E);
        PHASE_END(g0 + 6, 7, true)
        PHASE_BEGIN(g0 + 8, 9)
            pg8::Gemm g{(const bf16*)WSP(bf16, WS_HA), (const bf16*)WSP(bf16, wl + LW_DN), M, DM, DFF}; pg8::StaticOrder S; S.init(M, DM, F.G, bid);
            { pg8::Unit u0; S.next(0, u0); conv_fixup(Fp, u0.pm, WSP(float, WS_SBL), WSP(float, WS_SBF), INP(float, PT_CW) + (size_t)l * 3 * UP_COLS, INP(float, PT_CB) + (size_t)l * UP_COLS, WSP(bf16, WS_HA)); stats_to_lds(Fp, WSP(float, WS_STP1), u0.pm); }
            pg8::EpiResLn<1, false> E{INP(float, PT_X), WSP(unsigned short, WS_HF), INP(float, PT_LN1G) + l * DM, INP(float, PT_LN1B) + l * DM, WSP(bf16, WS_XB), WSP(unsigned char, WS_XB), WSP(float, WS_STP2), F.lds, 1};
            pg8::gemm_phase<pg8::EpiResLn<1, false>, pg8::StaticOrder, true, true>(F.lds + RING_OFF, g, S, E);
        PHASE_END(g0 + 8, 9, true)
    }
    PHASE_BEGIN(N_PHASES - 1, 10) ln_final_phase(Fp, WSP(unsigned short, WS_HF), INP(float, PT_LN2G) + (DEPTH - 1) * DM, INP(float, PT_LN2B) + (DEPTH - 1) * DM, (GAS float*)ldptr(F, PT_OUT)); PHASE_END(N_PHASES - 1, 10, false)
#undef IN
#undef SEAM
#undef GRID_BAR
#undef WSP
#undef INP
#undef PHASE_IDS
#undef PHASE_BEGIN
#undef PHASE_END
}

extern "C" void kernel_launch(void* const* d_in, const int* in_sizes, int n_in, void* d_out, int out_size, void* d_ws, size_t ws_size, hipStream_t stream) {
    static int grid = 0;
    if (grid == 0) {
        if (n_in != 15 || in_sizes[0] != M * DM || out_size != M * DM || ws_size < WS_END) { fprintf(stderr, "kernel_launch: shape/workspace mismatch (n_in %d, in0 %d, out %d, ws %zu, need %zu); nothing launched\n", n_in, n_in > 0 ? in_sizes[0] : -1, out_size, ws_size, (size_t)WS_END); grid = -1; return; }
        int dev = 0, cus = 0, per_cu = 0;
        if (hipGetDevice(&dev) != hipSuccess || hipDeviceGetAttribute(&cus, hipDeviceAttributeMultiprocessorCount, dev) != hipSuccess) { fprintf(stderr, "kernel_launch: hipGetDevice / hipDeviceGetAttribute failed; nothing launched\n"); grid = -1; return; }
        if (hipFuncSetAttribute((const void*)fwd_kernel, hipFuncAttributeMaxDynamicSharedMemorySize, LDS_BYTES) != hipSuccess) { fprintf(stderr, "kernel_launch: hipFuncSetAttribute failed; nothing launched\n"); grid = -1; return; }
        if (hipOccupancyMaxActiveBlocksPerMultiprocessor(&per_cu, (const void*)fwd_kernel, NWAVES * 64, LDS_BYTES) != hipSuccess || per_cu < 1)
            fprintf(stderr, "kernel_launch: note: the occupancy query reports %d workgroups per CU\n", per_cu);
        (void)hipGetLastError();
        grid = 256;
        if (cus != 256) fprintf(stderr, "kernel_launch: note: %d CUs reported; this kernel is built for the 256-CU MI355X (grid stays 256)\n", cus);
    }
    if (grid < 0) return;
    if (hipMemsetAsync((char*)d_ws + WS_CTL, 0, CTL_ZERO_BYTES, stream) != hipSuccess) { fprintf(stderr, "kernel_launch: hipMemsetAsync of the control words failed; nothing launched\n"); return; }
    Args a{};
    a.p.p[PT_X] = d_in[0]; a.p.p[PT_POS] = d_in[1]; a.p.p[PT_WIN] = d_in[2]; a.p.p[PT_WPA] = d_in[3]; a.p.p[PT_WPB] = d_in[4]; a.p.p[PT_WOUT] = d_in[5]; a.p.p[PT_SINKS] = d_in[6];
    a.p.p[PT_LN1G] = d_in[7]; a.p.p[PT_LN1B] = d_in[8]; a.p.p[PT_WUP] = d_in[9]; a.p.p[PT_CW] = d_in[10]; a.p.p[PT_CB] = d_in[11]; a.p.p[PT_WDN] = d_in[12]; a.p.p[PT_LN2G] = d_in[13]; a.p.p[PT_LN2B] = d_in[14];
    a.p.p[PT_OUT] = d_out; a.p.p[PT_WS] = d_ws;
#if MK_PER_PHASE
    for (int ph = 0; ph < N_PHASES; ++ph) { a.ph_lo = ph; a.ph_hi = ph + 1; hipLaunchKernelGGL(fwd_kernel, dim3(grid), dim3(NWAVES * 64), LDS_BYTES, stream, a); }
#else
    a.ph_lo = 0; a.ph_hi = N_PHASES;
    hipLaunchKernelGGL(fwd_kernel, dim3(grid), dim3(NWAVES * 64), LDS_BYTES, stream, a);
#endif
    const hipError_t le = hipPeekAtLastError();
    if (le != hipSuccess) fprintf(stderr, "kernel_launch: launch failed: %s (grid %d x %d threads, %d B LDS)\n", hipGetErrorName(le), grid, NWAVES * 64, LDS_BYTES);
}
```

```cpp
#include <hip/hip_runtime.h>
#include <cstdio>
#include <cstdint>

constexpr int BATCH = 2, SEQ = 4096, DM = 4096, DEPTH = 4;
constexpr int M = BATCH * SEQ;
constexpr int IN_COLS = 15360;
constexpr int KA_OFF = 1536, VA_OFF = 3072, QB_OFF = 4608, KB_OFF = 6656, VB_OFF = 6912, G_OFF = 7168;
constexpr int A_OUT = 512, B_QW = 2048, DFF = 8192, UP_COLS = 16384;
constexpr int YW = A_OUT + B_QW;
constexpr float LN_EPS = 1e-5f;
constexpr float DN_ALPHA = 1.6817928305074290f;
constexpr float LOG2E = 1.4426950408889634f;
constexpr float QSCALE_A = 0.08838834764831845f * LOG2E;
constexpr float QSCALE_B = 0.125f * LOG2E;
constexpr int F8_X = 123  , F8_WIN = 117  , F8_Y = 122  , F8_WPA = 117  , F8_WPB = 117  , F8_MG = 118  , F8_WOUT = 116  ;
constexpr float F8S_X = 16.f, F8S_WIN = 1024.f, F8S_Y = 32.f, F8S_WPA = 1024.f, F8S_WPB = 1024.f, F8S_MG = 512.f, F8S_WOUT = 2048.f;
constexpr int QW = 7168;
constexpr float F8S_Q = 32.f, F8S_K = 16.f, F8S_V = 16.f;
constexpr float F8S_G = 256.f;
#define MK_PER_PHASE 0
#define DBL_MASK 0
namespace pg8 {
#define PG8_LAS __attribute__((address_space(3)))
typedef unsigned short bf16_t;
typedef short bf16x8 __attribute__((ext_vector_type(8)));
typedef float f32x4 __attribute__((ext_vector_type(4)));
typedef unsigned u32x4 __attribute__((ext_vector_type(4)));
constexpr int BM = 256, BK = 64, HALF = 128, HTB = HALF * BK * 2  , STAGE_BYTES = 8 * HTB, NXCD = 8, WGM = 8;

__host__ __device__ __forceinline__ int lds_byte(int r, int c) { const int st = (r >> 4) * 2 + (c >> 5), rr = r & 15, cc = c & 31, ob = rr * 64 + cc * 2; return st * 1024 + (ob ^ (((ob >> 9) & 1) << 5)); }
__host__ __device__ __forceinline__ void stage_rc(int b, int& R, int& C) { const int st = b / 1024, sb = b % 1024, swz = sb ^ (((sb >> 9) & 1) << 5); R = (st >> 1) * 16 + swz / 64; C = (st & 1) * 32 + (swz % 64) / 2; }
__host__ __device__ __forceinline__ int perm32(int rho) { const int n = rho >> 4, i = rho & 15; return 8 * (i >> 2) + 4 * n + (i & 3); }

struct Unit { int pm, pn; };
struct Gemm { const bf16_t* A; const bf16_t* Bt; int M, N, K; };

struct StaticOrder {
    int nM, nN, nwg, G, c, i0, nr;
    __host__ __device__ void init(int M, int N, int G_, int c_) { nM = M / BM; nN = N / BM; nwg = nM * nN; G = G_; c = c_; i0 = 0; nr = 1 << 20; }
    __host__ __device__ bool next(int i, Unit& u) const {
        if (i >= nr) return false;
        const long L = (long)(i + i0) * G + c; if (L >= nwg) return false;
        int wgid = (int)L; { const int q = nwg / NXCD, r = nwg % NXCD, xcd = wgid % NXCD, off = wgid / NXCD; wgid = (xcd < r ? xcd * (q + 1) : r * (q + 1) + (xcd - r) * q) + off; }
        const int nig = WGM * nN, gid = wgid / nig, fm = gid * WGM, gsz = (nM - fm) < WGM ? (nM - fm) : WGM;
        u.pm = fm + ((wgid % nig) % gsz); u.pn = (wgid % nig) / gsz; return true;
    }
    __device__ __forceinline__ void a_ready(const Unit&) const {}
    __device__ __forceinline__ void done(const Unit&) const {}
};
typedef float f32x2 __attribute__((ext_vector_type(2)));
typedef __bf16 pg8_bf16x2 __attribute__((ext_vector_type(2)));
__device__ __forceinline__ unsigned cvt_pk_bf16(float lo, float hi) { f32x2 v = {lo, hi}; pg8_bf16x2 b = __builtin_convertvector(v, pg8_bf16x2); return __builtin_bit_cast(unsigned, b); }
__device__ __forceinline__ unsigned pk4_fp8(float a, float b, float c, float d) {
    a = __builtin_fminf(__builtin_fmaxf(a, -448.f), 448.f); b = __builtin_fminf(__builtin_fmaxf(b, -448.f), 448.f); c = __builtin_fminf(__builtin_fmaxf(c, -448.f), 448.f); d = __builtin_fminf(__builtin_fmaxf(d, -448.f), 448.f);
    int w = 0; w = __builtin_amdgcn_cvt_pk_fp8_f32(a, b, w, false); w = __builtin_amdgcn_cvt_pk_fp8_f32(c, d, w, true); return (unsigned)w; }
__device__ __forceinline__ float lx(float v, int mask, int lane) { return __int_as_float(__builtin_amdgcn_ds_bpermute((lane ^ mask) << 2, __float_as_int(v))); }
__device__ __forceinline__ float lup16(float v, int lane) { return __int_as_float(__builtin_amdgcn_ds_bpermute(((lane & 15) ? lane - 1 : lane) << 2, __float_as_int(v))); }
typedef float f32x4_c __attribute__((ext_vector_type(4)));
__device__ __forceinline__ void unpk8_fp8(unsigned lo, unsigned hi, f32x4_c& a, f32x4_c& b) {
    const f32x2 a0 = __builtin_amdgcn_cvt_pk_f32_fp8((int)lo, false), a1 = __builtin_amdgcn_cvt_pk_f32_fp8((int)lo, true), b0 = __builtin_amdgcn_cvt_pk_f32_fp8((int)hi, false), b1 = __builtin_amdgcn_cvt_pk_f32_fp8((int)hi, true);
    a = (f32x4_c){a0[0], a0[1], a1[0], a1[1]}; b = (f32x4_c){b0[0], b0[1], b1[0], b1[1]}; }
#define PG8_GAS __attribute__((address_space(1)))
__device__ __forceinline__ void st8(PG8_GAS bf16_t* p, const f32x4 v0, const f32x4 v1) {
    u32x4 w; w.x = cvt_pk_bf16(v0[0], v0[1]); w.y = cvt_pk_bf16(v0[2], v0[3]); w.z = cvt_pk_bf16(v1[0], v1[1]); w.w = cvt_pk_bf16(v1[2], v1[3]);
    *(PG8_GAS u32x4*)p = w;
}
__device__ __forceinline__ f32x4 bf_lo4(unsigned a, unsigned b) { return (f32x4){__uint_as_float(a << 16), __uint_as_float(a & 0xffff0000u), __uint_as_float(b << 16), __uint_as_float(b & 0xffff0000u)}; }
__device__ __forceinline__ float sigmoidf_fast(float x) { return __builtin_amdgcn_rcpf(1.0f + __builtin_amdgcn_exp2f(-x * LOG2E)); }

typedef float f32x2s __attribute__((ext_vector_type(2)));
constexpr int ST_OFF = 131072;
struct LnCols { f32x4 a0, a1, b0, b1; };
__device__ __forceinline__ LnCols ln_cols(PG8_GAS const float* c1, PG8_GAS const float* c2, int col) {
    LnCols c; c.a0 = *(PG8_GAS const f32x4*)(c1 + col); c.a1 = *(PG8_GAS const f32x4*)(c1 + col + 4); c.b0 = *(PG8_GAS const f32x4*)(c2 + col); c.b1 = *(PG8_GAS const f32x4*)(c2 + col + 4); return c; }
__device__ __forceinline__ f32x4 fma4(const f32x4 a, const f32x4 b, const f32x4 c) { return __builtin_elementwise_fma(a, b, c); }
__device__ __forceinline__ void ln_fix8(f32x4& v0, f32x4& v1, const f32x2s st, const LnCols& c) { const f32x4 nm = (f32x4){-st.x, -st.x, -st.x, -st.x}, rs = (f32x4){st.y, st.y, st.y, st.y};
    v0 = fma4(fma4(c.a0, nm, v0), rs, c.b0); v1 = fma4(fma4(c.a1, nm, v1), rs, c.b1); }

constexpr int HALO_OFF = ST_OFF + 2048;
constexpr int GB_OFF = ST_OFF + 4096;
__device__ __forceinline__ float silu_mul(float g, float v) { return g * __builtin_amdgcn_rcpf(1.0f + __builtin_amdgcn_exp2f(-g * LOG2E)) * v; }
struct EpiConv {
    static constexpr bool PERM = true, AFTER_DRAIN = false; static constexpr int MID_T = -1;
    PG8_GAS bf16_t* HA; PG8_GAS const float* c1; PG8_GAS const float* c2; PG8_GAS const float* cw; PG8_GAS const float* cb; PG8_GAS float* SBL; PG8_GAS float* SBF; PG8_LAS unsigned char* lds;
    __device__ __forceinline__ void operator()(const f32x4 (&acc_)[2][2][4][2], const Unit& u, int wr, int wc, int fr, int fq) const {
        f32x4 (&acc)[2][2][4][2] = const_cast<f32x4 (&)[2][2][4][2]>(acc_);
        const int col0 = u.pn * BM + wc * 32 + 8 * fq, ch0 = u.pn * HALF + wc * 32 + 8 * fq, tok0 = 8 * (16 * wr + fr);
        const PG8_LAS f32x2s* ST = (const PG8_LAS f32x2s*)(lds + ST_OFF);
        PG8_LAS f32x4* HL = (PG8_LAS f32x4*)(lds + HALO_OFF) + (wc * 4 + fq) * 8;
        { const LnCols lg = ln_cols(c1, c2, col0), lv = ln_cols(c1, c2, col0 + HALF);
#pragma unroll
          for (int ai = 0; ai < 2; ++ai)
#pragma unroll
            for (int m = 0; m < 4; ++m) { const f32x2s st = ST[tok0 + 4 * ai + m]; ln_fix8(acc[ai][0][m][0], acc[ai][0][m][1], st, lg); ln_fix8(acc[ai][1][m][0], acc[ai][1][m][1], st, lv); } }
#define UG(s_, n_) acc[(s_) >> 2][0][(s_) & 3][n_]
#define UV(s_, n_) acc[(s_) >> 2][1][(s_) & 3][n_]
        asm volatile("" ::: "memory");
        if (wr == 0 && fr == 15) {
#pragma unroll
            for (int n = 0; n < 2; ++n) { HL[0 + 2 * n] = UG(6, n); HL[1 + 2 * n] = UG(7, n); HL[4 + 2 * n] = UV(6, n); HL[5 + 2 * n] = UV(7, n); } }
        if (wr == 1 && fr == 15) { PG8_GAS float* q = SBL + (size_t)u.pm * 2 * UP_COLS + ch0;
#pragma unroll
            for (int n = 0; n < 2; ++n) { *(PG8_GAS f32x4*)(q + 4 * n) = UG(6, n); *(PG8_GAS f32x4*)(q + UP_COLS + 4 * n) = UG(7, n); *(PG8_GAS f32x4*)(q + DFF + 4 * n) = UV(6, n); *(PG8_GAS f32x4*)(q + UP_COLS + DFF + 4 * n) = UV(7, n); } }
        if (wr == 0 && fr == 0) { PG8_GAS float* q = SBF + (size_t)u.pm * 2 * UP_COLS + ch0;
#pragma unroll
            for (int n = 0; n < 2; ++n) { *(PG8_GAS f32x4*)(q + 4 * n) = UG(0, n); *(PG8_GAS f32x4*)(q + UP_COLS + 4 * n) = UG(1, n); *(PG8_GAS f32x4*)(q + DFF + 4 * n) = UV(0, n); *(PG8_GAS f32x4*)(q + UP_COLS + DFF + 4 * n) = UV(1, n); } }
        asm volatile("s_waitcnt lgkmcnt(0)" ::: "memory"); __builtin_amdgcn_s_barrier(); asm volatile("" ::: "memory");
        PG8_GAS bf16_t* op = HA + (size_t)(u.pm * BM + tok0) * DFF + ch0; const int ln_ = fq * 16 + fr;
#pragma unroll
        for (int n = 0; n < 2; ++n) {
            f32x4 wg[3], wv[3];
#pragma unroll
            for (int i = 0; i < 3; ++i) { wg[i] = *(PG8_GAS const f32x4*)(cw + (size_t)i * UP_COLS + ch0 + 4 * n); wv[i] = *(PG8_GAS const f32x4*)(cw + (size_t)i * UP_COLS + DFF + ch0 + 4 * n); }
            const f32x4 bg = *(PG8_GAS const f32x4*)(cb + ch0 + 4 * n), bv = *(PG8_GAS const f32x4*)(cb + DFF + ch0 + 4 * n);
            f32x4 g1, g2, v1, v2;
#pragma unroll
            for (int j = 0; j < 4; ++j) { g1[j] = lup16(UG(7, n)[j], ln_); g2[j] = lup16(UG(6, n)[j], ln_); v1[j] = lup16(UV(7, n)[j], ln_); v2[j] = lup16(UV(6, n)[j], ln_); }
            if (fr == 0) { if (wr == 1) { g2 = HL[0 + 2 * n]; g1 = HL[1 + 2 * n]; v2 = HL[4 + 2 * n]; v1 = HL[5 + 2 * n]; }
                           else { g1 = (f32x4){0.f, 0.f, 0.f, 0.f}; g2 = g1; v1 = g1; v2 = g1; } }
            unsigned hp[8][2];
#pragma unroll
            for (int sI = 0; sI < 8; ++sI) {
                const f32x4 gm2 = sI >= 2 ? UG(sI >= 2 ? sI - 2 : 0, n) : (sI == 1 ? g1 : g2), gm1 = sI >= 1 ? UG(sI >= 1 ? sI - 1 : 0, n) : g1;
                const f32x4 vm2 = sI >= 2 ? UV(sI >= 2 ? sI - 2 : 0, n) : (sI == 1 ? v1 : v2), vm1 = sI >= 1 ? UV(sI >= 1 ? sI - 1 : 0, n) : v1;
                const f32x4 og = fma4(wg[2], UG(sI, n), fma4(wg[1], gm1, fma4(wg[0], gm2, bg))), ov = fma4(wv[2], UV(sI, n), fma4(wv[1], vm1, fma4(wv[0], vm2, bv)));
                hp[sI][0] = cvt_pk_bf16(silu_mul(og[0], ov[0]), silu_mul(og[1], ov[1])); hp[sI][1] = cvt_pk_bf16(silu_mul(og[2], ov[2]), silu_mul(og[3], ov[3])); }
#pragma unroll
            for (int sI = 0; sI < 8; ++sI) { typedef unsigned u32x2_ __attribute__((ext_vector_type(2))); u32x2_ w; w.x = hp[sI][0]; w.y = hp[sI][1]; *(PG8_GAS u32x2_*)(op + (size_t)sI * DFF + 4 * n) = w; }
        }
#undef UG
#undef UV
    }
};

struct EpiIn {
    static constexpr bool PERM = true, AFTER_DRAIN = false; static constexpr int MID_T = -1;
    PG8_GAS unsigned char* O; PG8_GAS const float* ropeA; PG8_GAS const float* ropeB;
    PG8_GAS const float* c1; PG8_GAS const float* c2; PG8_LAS const unsigned char* lds; int ln;
    PG8_GAS unsigned char* G8;
    static __device__ __forceinline__ void st8q(PG8_GAS unsigned char* p, const f32x4 a, const f32x4 b) { typedef unsigned u32x2_ __attribute__((ext_vector_type(2))); u32x2_ w; w.x = pk4_fp8(a[0], a[1], a[2], a[3]); w.y = pk4_fp8(b[0], b[1], b[2], b[3]); *(PG8_GAS u32x2_*)p = w; }
    __device__ __forceinline__ void operator()(const f32x4 (&acc_)[2][2][4][2], const Unit& u, int wr, int wc, int fr, int fq) const {
        const int row0 = u.pm * BM + wr * 64 + fr, pn = u.pn;
        PG8_GAS unsigned char* base = O + (size_t)row0 * QW + pn * BM + wc * 32 + 8 * fq;
        f32x4 (&acc)[2][2][4][2] = const_cast<f32x4 (&)[2][2][4][2]>(acc_);
        if (ln) { const PG8_LAS f32x2s* ST = (const PG8_LAS f32x2s*)(lds + ST_OFF); const int col0 = pn * BM + wc * 32 + 8 * fq;
          LnCols lc0 = ln_cols(c1, c2, col0), lc1 = ln_cols(c1, c2, col0 + HALF);
          const float ks = pn >= 28 ? -LOG2E : 1.0f;
          lc0.b0 *= ks; lc0.b1 *= ks; lc1.b0 *= ks; lc1.b1 *= ks;
#pragma unroll
          for (int ai = 0; ai < 2; ++ai)
#pragma unroll
            for (int m = 0; m < 4; ++m) { f32x2s st = ST[ai * HALF + wr * 64 + m * 16 + fr]; st.y *= ks; ln_fix8(acc[ai][0][m][0], acc[ai][0][m][1], st, lc0); ln_fix8(acc[ai][1][m][0], acc[ai][1][m][1], st, lc1); } }
        if (pn >= 28) {
            PG8_GAS unsigned char* gb8 = G8 + (size_t)row0 * (2 * DM) + (pn - 28) * BM + wc * 32 + 8 * fq;
#pragma unroll
            for (int ai = 0; ai < 2; ++ai)
#pragma unroll
                for (int m = 0; m < 4; ++m) { PG8_GAS unsigned char* rowp = gb8 + (size_t)(ai * HALF + m * 16) * (2 * DM);
#pragma unroll
                    for (int bj = 0; bj < 2; ++bj) { f32x4 v0 = acc[ai][bj][m][0], v1 = acc[ai][bj][m][1];
                        if (!ln) { v0 *= -LOG2E; v1 *= -LOG2E; }
#pragma unroll
                        for (int j = 0; j < 4; ++j) { v0[j] = __builtin_amdgcn_exp2f(v0[j]); v1[j] = __builtin_amdgcn_exp2f(v1[j]); }
                        typedef unsigned u32x2_ __attribute__((ext_vector_type(2))); u32x2_ w; w.x = pk4_fp8(v0[0], v0[1], v0[2], v0[3]); w.y = pk4_fp8(v1[0], v1[1], v1[2], v1[3]);
                        *(PG8_GAS u32x2_*)(rowp + bj * HALF) = w; } }
        } else if (pn < 12) {
            const float sc = pn < 6 ? QSCALE_A * F8S_Q : F8S_K;
#pragma unroll
            for (int ai = 0; ai < 2; ++ai) {
                f32x4 cc[4], ss[4];
#pragma unroll
                for (int m = 0; m < 4; ++m) { const int r = row0 + ai * HALF + m * 16; cc[m] = (f32x4){1.f, 1.f, 1.f, 1.f}; ss[m] = (f32x4){0.f, 0.f, 0.f, 0.f};
                    if (wc == 0) { cc[m] = *(PG8_GAS const f32x4*)(ropeA + (size_t)r * 32 + 4 * fq); ss[m] = *(PG8_GAS const f32x4*)(ropeA + (size_t)r * 32 + 16 + 4 * fq); } }
#pragma unroll
                for (int m = 0; m < 4; ++m) { PG8_GAS unsigned char* rowp = base + (size_t)(ai * HALF + m * 16) * QW; const f32x4 c = cc[m], s = ss[m];
#pragma unroll
                    for (int bj = 0; bj < 2; ++bj) { const f32x4 v0 = acc[ai][bj][m][0], v1 = acc[ai][bj][m][1];
                        const f32x4 n0 = (v0 * c - v1 * s) * sc, n1 = (v1 * c + v0 * s) * sc;
                        st8q(rowp + bj * HALF, n0, n1); } } }
        } else if (pn >= 18 && pn < 27) {
            const float sc = pn < 26 ? QSCALE_B * F8S_Q : F8S_K;
            const bool rotl = ((wc & 1) == 0) && (fq < 2);
#pragma unroll
            for (int ai = 0; ai < 2; ++ai) {
                f32x4 cc[4], ss[4];
#pragma unroll
                for (int m = 0; m < 4; ++m) { const int r = row0 + ai * HALF + m * 16;
                    cc[m] = *(PG8_GAS const f32x4*)(ropeB + (size_t)r * 16 + 4 * (fq & 1)); ss[m] = *(PG8_GAS const f32x4*)(ropeB + (size_t)r * 16 + 8 + 4 * (fq & 1));
                    if (!rotl) { cc[m] = (f32x4){1.f, 1.f, 1.f, 1.f}; ss[m] = (f32x4){0.f, 0.f, 0.f, 0.f}; } }
#pragma unroll
                for (int m = 0; m < 4; ++m) { PG8_GAS unsigned char* rowp = base + (size_t)(ai * HALF + m * 16) * QW; const f32x4 c = cc[m], s = ss[m];
#pragma unroll
                    for (int bj = 0; bj < 2; ++bj) { const f32x4 v0 = acc[ai][bj][m][0], v1 = acc[ai][bj][m][1];
                        const f32x4 n0 = (v0 * c - v1 * s) * sc, n1 = (v1 * c + v0 * s) * sc;
                        st8q(rowp + bj * HALF, n0, n1); } } }
        } else {
#pragma unroll
            for (int ai = 0; ai < 2; ++ai)
#pragma unroll
                for (int m = 0; m < 4; ++m) { PG8_GAS unsigned char* rowp = base + (size_t)(ai * HALF + m * 16) * QW;
#pragma unroll
                    for (int bj = 0; bj < 2; ++bj) st8q(rowp + bj * HALF, acc[ai][bj][m][0] * F8S_V, acc[ai][bj][m][1] * F8S_V); }
        }
    }
};

struct EpiGate {
    static constexpr bool PERM = true, AFTER_DRAIN = false; static constexpr int MID_T = 2;
    PG8_GAS unsigned char* MG8; PG8_GAS const unsigned char* G8;
    typedef unsigned u32x2_ __attribute__((ext_vector_type(2)));
    __device__ __forceinline__ void mid(f32x4 (&acc)[2][2][4][2], const Unit& u, int wr, int wc, int fr, int fq) const {
        const int row0 = u.pm * BM + wr * 64 + fr, col0 = u.pn * BM + wc * 32 + 8 * fq;
        u32x2_ ga[2][4][2], gb[2][4][2];
#pragma unroll
        for (int ai = 0; ai < 2; ++ai)
#pragma unroll
            for (int m = 0; m < 4; ++m) { const size_t r = (size_t)(row0 + ai * HALF + m * 16) * (2 * DM);
#pragma unroll
                for (int bj = 0; bj < 2; ++bj) { const int c = col0 + bj * HALF; ga[ai][m][bj] = *(PG8_GAS const u32x2_*)(G8 + r + c); gb[ai][m][bj] = *(PG8_GAS const u32x2_*)(G8 + r + DM + c); } }
#pragma unroll
        for (int ai = 0; ai < 2; ++ai)
#pragma unroll
            for (int m = 0; m < 4; ++m)
#pragma unroll
                for (int bj = 0; bj < 2; ++bj) { f32x4 a0, a1, b0, b1; unpk8_fp8(ga[ai][m][bj].x, ga[ai][m][bj].y, a0, a1); unpk8_fp8(gb[ai][m][bj].x, gb[ai][m][bj].y, b0, b1);
#pragma unroll
                    for (int j = 0; j < 4; ++j) { acc[ai][bj][m][0][j] *= (1.0f + b0[j]) * __builtin_amdgcn_rcpf(1.0f + a0[j]); acc[ai][bj][m][1][j] *= (1.0f + b1[j]) * __builtin_amdgcn_rcpf(1.0f + a1[j]); } }
    }
    __device__ __forceinline__ void operator()(const f32x4 (&acc)[2][2][4][2], const Unit& u, int wr, int wc, int fr, int fq) const {
        const int row0 = u.pm * BM + wr * 64 + fr, col0 = u.pn * BM + wc * 32 + 8 * fq;
        u32x2_ gb[2][4][2];
#pragma unroll
        for (int ai = 0; ai < 2; ++ai)
#pragma unroll
            for (int m = 0; m < 4; ++m) { const size_t r = (size_t)(row0 + ai * HALF + m * 16) * (2 * DM);
#pragma unroll
                for (int bj = 0; bj < 2; ++bj) gb[ai][m][bj] = *(PG8_GAS const u32x2_*)(G8 + r + DM + col0 + bj * HALF); }
#pragma unroll
        for (int ai = 0; ai < 2; ++ai)
#pragma unroll
            for (int m = 0; m < 4; ++m) { const size_t r = (size_t)(row0 + ai * HALF + m * 16);
#pragma unroll
                for (int bj = 0; bj < 2; ++bj) { const int c = col0 + bj * HALF; f32x4 b0, b1; unpk8_fp8(gb[ai][m][bj].x, gb[ai][m][bj].y, b0, b1);
                    f32x4 v0, v1;
#pragma unroll
                    for (int j = 0; j < 4; ++j) { v0[j] = acc[ai][bj][m][0][j] * __builtin_amdgcn_rcpf((1.0f + b0[j]) * (1.0f / F8S_MG)); v1[j] = acc[ai][bj][m][1][j] * __builtin_amdgcn_rcpf((1.0f + b1[j]) * (1.0f / F8S_MG)); }
                    u32x2_ w; w.x = pk4_fp8(v0[0], v0[1], v0[2], v0[3]); w.y = pk4_fp8(v1[0], v1[1], v1[2], v1[3]);
                    *(PG8_GAS u32x2_*)(MG8 + r * DM + c) = w; } }
    }
};

typedef _Float16 f16x2_ __attribute__((ext_vector_type(2)));
__device__ __forceinline__ unsigned pk_f16(float lo, float hi) { f32x2 v = {lo, hi}; f16x2_ h = __builtin_convertvector(v, f16x2_); return __builtin_bit_cast(unsigned, h); }
__device__ __forceinline__ void unpk8_f16(const u32x4 w, f32x4& a, f32x4& b) {
    const unsigned wx = w.x, wy = w.y, wz = w.z, ww = w.w;
    const f16x2_ h0 = __builtin_bit_cast(f16x2_, wx), h1 = __builtin_bit_cast(f16x2_, wy), h2 = __builtin_bit_cast(f16x2_, wz), h3 = __builtin_bit_cast(f16x2_, ww);
    a = (f32x4){(float)h0[0], (float)h0[1], (float)h1[0], (float)h1[1]}; b = (f32x4){(float)h2[0], (float)h2[1], (float)h3[0], (float)h3[1]}; }
template <int OPK, bool XIN  > struct EpiResLn {
    static constexpr bool PERM = true, AFTER_DRAIN = false; static constexpr int MID_T = -1;
    PG8_GAS const float* xin; PG8_GAS unsigned short* H; PG8_GAS const float* g; PG8_GAS const float* b; PG8_GAS bf16_t* OB; PG8_GAS unsigned char* O8; PG8_GAS float* STP; PG8_LAS const unsigned char* lds; int lnres;
    __device__ __forceinline__ void operator()(const f32x4 (&acc)[2][2][4][2], const Unit& u, int wr, int wc, int fr, int fq) const {
        const int row0 = u.pm * BM + wr * 64 + fr, col0 = u.pn * BM + wc * 32 + 8 * fq;
        const PG8_LAS f32x2s* ST = (const PG8_LAS f32x2s*)(lds + ST_OFF);
        PG8_LAS float* GB = (PG8_LAS float*)(const_cast<PG8_LAS unsigned char*>(lds) + GB_OFF) + (wr * 4 + wc) * 128;
        if (lnres) { const int l5 = (fq * 16 + fr) & 31, hf = (fq * 16 + fr) >> 5, cc = u.pn * BM + hf * HALF + wc * 32 + l5; GB[hf * 32 + l5] = g[cc]; GB[64 + hf * 32 + l5] = b[cc]; }
        asm volatile("s_waitcnt lgkmcnt(0)" ::: "memory");
#define ERL_G(bj, n) (*(const PG8_LAS f32x4*)(GB + (bj) * 32 + 8 * fq + 4 * (n)))
#define ERL_B(bj, n) (*(const PG8_LAS f32x4*)(GB + 64 + (bj) * 32 + 8 * fq + 4 * (n)))
#define ERL_ROW(ai, m, X0, X1) do { const int row = row0 + (ai) * HALF + (m) * 16; const size_t off = (size_t)row * DM + col0; \
            f32x2s st = ST[(ai) * HALF + wr * 64 + (m) * 16 + fr]; if (!lnres) st = (f32x2s){0.f, 1.f}; \
            float sm = 0.f, sq = 0.f; \
            _Pragma("unroll") for (int bj = 0; bj < 2; ++bj) { f32x4 h[2]; \
                _Pragma("unroll") for (int n = 0; n < 2; ++n) { f32x4 x = n ? X1(bj) : X0(bj); if (lnres) x = (x - st.x) * st.y * ERL_G(bj, n) + ERL_B(bj, n); \
                    h[n] = x * DN_ALPHA + acc[ai][bj][m][n]; \
                    sm += (h[n][0] + h[n][1]) + (h[n][2] + h[n][3]); sq += (h[n][0] * h[n][0] + h[n][1] * h[n][1]) + (h[n][2] * h[n][2] + h[n][3] * h[n][3]); } \
                u32x4 hw; hw.x = pk_f16(h[0][0], h[0][1]); hw.y = pk_f16(h[0][2], h[0][3]); hw.z = pk_f16(h[1][0], h[1][1]); hw.w = pk_f16(h[1][2], h[1][3]); \
                *(PG8_GAS u32x4*)(H + off + bj * HALF) = hw; \
                if (OPK == 0) st8(OB + off + bj * HALF, h[0], h[1]); \
                else { typedef unsigned u32x2_ __attribute__((ext_vector_type(2))); u32x2_ w; w.x = pk4_fp8(h[0][0] * F8S_X, h[0][1] * F8S_X, h[0][2] * F8S_X, h[0][3] * F8S_X); w.y = pk4_fp8(h[1][0] * F8S_X, h[1][1] * F8S_X, h[1][2] * F8S_X, h[1][3] * F8S_X); \
                    *(PG8_GAS u32x2_*)(O8 + off + bj * HALF) = w; } } \
            { const int ln_ = fq * 16 + fr; sm += lx(sm, 16, ln_); sq += lx(sq, 16, ln_); sm += lx(sm, 32, ln_); sq += lx(sq, 32, ln_); } \
            if (fq == 0) *(PG8_GAS f32x2s*)(STP + ((size_t)row * 64 + u.pn * 4 + wc) * 2) = (f32x2s){sm, sq}; } while (0)
        if (!XIN || lnres) {
#pragma unroll
            for (int ai = 0; ai < 2; ++ai) {
                u32x4 xw[4][2];
#pragma unroll
                for (int m = 0; m < 4; ++m)
#pragma unroll
                    for (int bj = 0; bj < 2; ++bj) xw[m][bj] = *(PG8_GAS const u32x4*)(H + (size_t)(row0 + ai * HALF + m * 16) * DM + col0 + bj * HALF);
#pragma unroll
                for (int m = 0; m < 4; ++m) { f32x4 xa[2], xb[2];
#pragma unroll
                    for (int bj = 0; bj < 2; ++bj) unpk8_f16(xw[m][bj], xa[bj], xb[bj]);
#define ERL_XA(bj) xa[bj]
#define ERL_XB(bj) xb[bj]
                    ERL_ROW(ai, m, ERL_XA, ERL_XB); __builtin_amdgcn_sched_barrier(0); } }
        } else if constexpr (XIN) {
#pragma unroll
            for (int ai = 0; ai < 2; ++ai)
#pragma unroll
                for (int m = 0; m < 4; ++m) {
                    f32x4 xv[2][2];
#pragma unroll
                    for (int bj = 0; bj < 2; ++bj) { const size_t off = (size_t)(row0 + ai * HALF + m * 16) * DM + col0 + bj * HALF; xv[bj][0] = *(PG8_GAS const f32x4*)(xin + off); xv[bj][1] = *(PG8_GAS const f32x4*)(xin + off + 4); }
#define ERL_YA(bj) xv[bj][0]
#define ERL_YB(bj) xv[bj][1]
                    ERL_ROW(ai, m, ERL_YA, ERL_YB); __builtin_amdgcn_sched_barrier(0); }
        }
#undef ERL_ROW
#undef ERL_G
#undef ERL_B
#undef ERL_XA
#undef ERL_XB
#undef ERL_YA
#undef ERL_YB
    }
};

template <class Epi, class Sched, bool ALIGN_EPI = false, bool SP2 = false, int F8SA = 0, int F8SB = 0, bool ROWPERM = false>
__device__ __forceinline__ void gemm_phase(PG8_LAS unsigned char* lds, const Gemm g, const Sched& S, const Epi& E) {
    int tid_ = threadIdx.x; asm volatile("" : "+v"(tid_));
    const int tid = tid_, wid = __builtin_amdgcn_readfirstlane(tid >> 6), lane = tid & 63, wr = wid >> 2, wc = wid & 3, fr = lane & 15, fq = lane >> 4;
    int K_ = g.K; asm volatile("" : "+s"(K_));
    const int K = K_, nt = K / BK;
    unsigned voffA[2], voffB[2];
#pragma unroll
    for (int i = 0; i < 2; ++i) { int R, C; stage_rc(tid * 16 + i * 8192, R, C); const int Rb = Epi::PERM ? ((R & ~31) + perm32(R & 31)) : R;
        const int Ra = ROWPERM ? 8 * (16 * (R >> 6) + (R & 15)) + ((R >> 4) & 3) : R;
        voffA[i] = (unsigned)(Ra * K + C) * 2u; voffB[i] = (unsigned)(Rb * BK + C) * 2u; }
    const size_t kstep = (size_t)(BK * 2);
    const size_t hstep = (size_t)HALF * K * 2;
    const size_t hstepA = ROWPERM ? (size_t)4 * K * 2 : hstep;
    const size_t tstep = 2 * hstep;
    const size_t kstepB = (size_t)BM * BK * 2, hstepB = (size_t)HALF * BK * 2;
    const unsigned ldsw = (unsigned)wid * 1024u;
    const int aoff = lds_byte(wr * 64 + fr, fq * 8), boff = lds_byte(wc * 32 + fr, fq * 8);
#define PG8_SA(b, h) (((b) * 2 + (h)) * HTB)
#define PG8_SB(b, h) ((4 + (b) * 2 + (h)) * HTB)
#define PG8_STAGE(bufoff, gbase, voff) do { _Pragma("unroll") for (int _i = 0; _i < 2; ++_i) \
        __builtin_amdgcn_global_load_lds((const unsigned*)((const char*)(gbase) + (voff)[_i]), (PG8_LAS unsigned*)(lds + (bufoff) + ldsw + _i * 8192), 16, 0, 0); } while (0)
#define PG8_LDA(dst, b, h) do { _Pragma("unroll") for (int m = 0; m < 4; ++m) _Pragma("unroll") for (int k = 0; k < 2; ++k) dst[m][k] = *(const PG8_LAS bf16x8*)(lds + PG8_SA(b, h) + aoff + m * 2048 + k * 1024); } while (0)
#define PG8_LDB(dst, b, h) do { _Pragma("unroll") for (int n = 0; n < 2; ++n) _Pragma("unroll") for (int k = 0; k < 2; ++k) dst[n][k] = *(const PG8_LAS bf16x8*)(lds + PG8_SB(b, h) + boff + n * 2048 + k * 1024); } while (0)
#define PG8_MMA(ai, bj, At, Bt) do { __builtin_amdgcn_s_setprio(1); _Pragma("unroll") for (int m = 0; m < 4; ++m) _Pragma("unroll") for (int n = 0; n < 2; ++n) { \
        if constexpr (F8SA != 0) { typedef int i32x4_ __attribute__((ext_vector_type(4))); typedef int i32x8_ __attribute__((ext_vector_type(8))); \
            const i32x8_ b8 = __builtin_shufflevector(__builtin_bit_cast(i32x4_, Bt[n][0]), __builtin_bit_cast(i32x4_, Bt[n][1]), 0, 1, 2, 3, 4, 5, 6, 7), a8 = __builtin_shufflevector(__builtin_bit_cast(i32x4_, At[m][0]), __builtin_bit_cast(i32x4_, At[m][1]), 0, 1, 2, 3, 4, 5, 6, 7); \
            asm volatile("v_mfma_scale_f32_16x16x128_f8f6f4 %0, %1, %2, %0, %3, %4 op_sel_hi:[0,0,0]" : "+v"(acc[ai][bj][m][n]) : "v"(b8), "v"(a8), "v"(f8_sb), "v"(f8_sa)); } \
        else { _Pragma("unroll") for (int k = 0; k < 2; ++k) acc[ai][bj][m][n] = __builtin_amdgcn_mfma_f32_16x16x32_bf16(Bt[n][k], At[m][k], acc[ai][bj][m][n], 0, 0, 0); } } \
        __builtin_amdgcn_s_setprio(0); } while (0)
#define PG8_WAIT_V(n) asm volatile("s_waitcnt vmcnt(" #n ")" ::: "memory")
#define PG8_WAIT_L(n) asm volatile("s_waitcnt lgkmcnt(" #n ")" ::: "memory")
#define PG8_BAR __builtin_amdgcn_s_barrier()
#define PG8_SCHED __builtin_amdgcn_sched_barrier(0)
    int f8_sa = F8SA, f8_sb = F8SB; asm volatile("" : "+v"(f8_sa), "+v"(f8_sb));
    Unit cur, nxt; int ui = 0;
    if (!S.next(0, cur)) return;
    f32x4 acc[2][2][4][2];
#pragma unroll
    for (int a = 0; a < 2; ++a)
#pragma unroll
        for (int b = 0; b < 2; ++b)
#pragma unroll
            for (int m = 0; m < 4; ++m)
#pragma unroll
                for (int n = 0; n < 2; ++n) acc[a][b][m][n] = (f32x4){0.f, 0.f, 0.f, 0.f};
    bf16x8 At[4][2], B0[2][2], B1[2][2];
    const char* cA = (const char*)g.A + (size_t)cur.pm * tstep; const char* cB = (const char*)g.Bt + (size_t)cur.pn * tstep;
    S.a_ready(cur);
    if constexpr (SP2) {
        PG8_STAGE(PG8_SB(0, 0), cB, voffB); PG8_STAGE(PG8_SB(0, 1), cB + hstepB, voffB); PG8_STAGE(PG8_SA(0, 0), cA, voffA); PG8_STAGE(PG8_SA(0, 1), cA + hstepA, voffA);
        if (wr == 1) PG8_BAR;
        PG8_WAIT_V(2); PG8_BAR;
        PG8_STAGE(PG8_SB(1, 0), cB + kstepB, voffB); PG8_STAGE(PG8_SA(1, 0), cA + kstep, voffA); PG8_STAGE(PG8_SB(1, 1), cB + hstepB + kstepB, voffB);
        PG8_WAIT_V(6); PG8_BAR;
    } else {
        PG8_STAGE(PG8_SB(0, 0), cB, voffB); PG8_STAGE(PG8_SA(0, 0), cA, voffA); PG8_STAGE(PG8_SB(0, 1), cB + hstepB, voffB); PG8_STAGE(PG8_SA(0, 1), cA + hstepA, voffA);
        if (wr == 1) PG8_BAR;
        PG8_WAIT_V(4); PG8_BAR;
        PG8_STAGE(PG8_SB(1, 0), cB + kstepB, voffB); PG8_STAGE(PG8_SA(1, 0), cA + kstep, voffA); PG8_STAGE(PG8_SB(1, 1), cB + hstepB + kstepB, voffB);
        PG8_WAIT_V(6); PG8_BAR;
    }
    for (;;) {
        const bool has_next = S.next(ui + 1, nxt);
        const char* nA = has_next ? (const char*)g.A + (size_t)nxt.pm * tstep : cA; const char* nB = has_next ? (const char*)g.Bt + (size_t)nxt.pn * tstep : cB;
        for (int t = 0; t < nt; t += 2) {
            const bool last = (t == nt - 2);
            const char* a1 = cA + (size_t)(t + 1) * kstep;
            const char* a2 = last ? nA : cA + (size_t)(t + 2) * kstep; const char* b2 = last ? nB : cB + (size_t)(t + 2) * kstepB;
            const char* a3 = a2 + kstep; const char* b3 = b2 + kstepB;
            if (last && has_next) S.a_ready(nxt);
            if constexpr (SP2) {
            PG8_LDB(B0, 0, 0); PG8_LDB(B1, 0, 1); PG8_SCHED; PG8_LDA(At, 0, 0); PG8_STAGE(PG8_SA(1, 1), a1 + hstepA, voffA);
            PG8_WAIT_V(8); PG8_WAIT_L(0); PG8_BAR; PG8_MMA(0, 0, At, B0); PG8_MMA(0, 1, At, B1); PG8_BAR; PG8_SCHED;
            PG8_LDA(At, 0, 1); PG8_STAGE(PG8_SB(0, 0), b2, voffB); PG8_STAGE(PG8_SB(0, 1), b2 + hstepB, voffB); PG8_STAGE(PG8_SA(0, 0), a2, voffA);
            PG8_WAIT_V(8); PG8_WAIT_L(0); PG8_BAR; PG8_MMA(1, 0, At, B0); PG8_MMA(1, 1, At, B1); PG8_BAR; PG8_SCHED;
            PG8_LDB(B0, 1, 0); PG8_LDB(B1, 1, 1); PG8_SCHED; PG8_LDA(At, 1, 0); PG8_STAGE(PG8_SA(0, 1), a2 + hstepA, voffA);
            PG8_WAIT_V(8); PG8_WAIT_L(0); PG8_BAR; PG8_MMA(0, 0, At, B0); PG8_MMA(0, 1, At, B1); PG8_BAR; PG8_SCHED;
            PG8_LDA(At, 1, 1); PG8_STAGE(PG8_SB(1, 0), b3, voffB); PG8_STAGE(PG8_SB(1, 1), b3 + hstepB, voffB); PG8_STAGE(PG8_SA(1, 0), a3, voffA);
            PG8_WAIT_V(8); PG8_WAIT_L(0); PG8_BAR; PG8_MMA(1, 0, At, B0); PG8_MMA(1, 1, At, B1); PG8_BAR; PG8_SCHED;
            } else {
            PG8_LDB(B0, 0, 0); PG8_SCHED; PG8_LDA(At, 0, 0); PG8_STAGE(PG8_SA(1, 1), a1 + hstepA, voffA);
            PG8_WAIT_L(8); PG8_BAR; PG8_WAIT_L(0); PG8_MMA(0, 0, At, B0); PG8_BAR; PG8_SCHED;
            PG8_LDB(B1, 0, 1); PG8_STAGE(PG8_SB(0, 0), b2, voffB);
            PG8_BAR; PG8_WAIT_L(0); PG8_MMA(0, 1, At, B1); PG8_BAR;
            PG8_LDA(At, 0, 1); PG8_STAGE(PG8_SA(0, 0), a2, voffA);
            PG8_BAR; PG8_WAIT_L(0); PG8_MMA(1, 0, At, B0); PG8_BAR; PG8_SCHED;
            PG8_STAGE(PG8_SB(0, 1), b2 + hstepB, voffB);
            PG8_WAIT_V(6); PG8_BAR; PG8_MMA(1, 1, At, B1); PG8_BAR;
            PG8_LDB(B0, 1, 0); PG8_SCHED; PG8_LDA(At, 1, 0); PG8_STAGE(PG8_SA(0, 1), a2 + hstepA, voffA);
            PG8_WAIT_L(8); PG8_BAR; PG8_WAIT_L(0); PG8_MMA(0, 0, At, B0); PG8_BAR; PG8_SCHED;
            PG8_LDB(B1, 1, 1); PG8_STAGE(PG8_SB(1, 0), b3, voffB);
            PG8_BAR; PG8_WAIT_L(0); PG8_MMA(0, 1, At, B1); PG8_BAR;
            PG8_LDA(At, 1, 1); PG8_STAGE(PG8_SA(1, 0), a3, voffA);
            PG8_BAR; PG8_WAIT_L(0); PG8_MMA(1, 0, At, B0); PG8_BAR; PG8_SCHED;
            PG8_STAGE(PG8_SB(1, 1), b3 + hstepB, voffB);
            PG8_WAIT_V(6); PG8_BAR; PG8_MMA(1, 1, At, B1); PG8_BAR;
            }
            if constexpr (Epi::MID_T >= 0) { if (t == Epi::MID_T) {
                if constexpr (F8SA != 0) asm volatile("s_nop 15\n\ts_nop 15" ::: "memory");
                int fr_m = fr, fq_m = fq; asm volatile("" : "+v"(fr_m), "+v"(fq_m)); E.mid(acc, cur, wr, wc, fr_m, fq_m);
                asm volatile("s_nop 7" ::: "memory"); } }
        }
        if constexpr (F8SA != 0) asm volatile("s_nop 15\n\ts_nop 15" ::: "memory");
        if constexpr (ALIGN_EPI) { if (wr == 0) PG8_BAR; }
        if constexpr (!Epi::AFTER_DRAIN) { int fr_e = fr, fq_e = fq; asm volatile("" : "+v"(fr_e), "+v"(fq_e));   E(acc, cur, wr, wc, fr_e, fq_e); S.done(cur); }
        if (!has_next) break;
#pragma unroll
        for (int a = 0; a < 2; ++a)
#pragma unroll
            for (int b = 0; b < 2; ++b)
#pragma unroll
                for (int m = 0; m < 4; ++m)
#pragma unroll
                    for (int n = 0; n < 2; ++n) acc[a][b][m][n] = (f32x4){0.f, 0.f, 0.f, 0.f};
        cur = nxt; cA = nA; cB = nB; ++ui;
        if constexpr (ALIGN_EPI) { if (wr == 1) PG8_BAR; }
    }
    PG8_WAIT_V(0);
    if constexpr (!ALIGN_EPI) { if (wr == 0) PG8_BAR; }
    PG8_BAR;
    if constexpr (Epi::AFTER_DRAIN) { E.fused(acc, cur, wr, wc, fr, fq, lds, wid, lane); S.done(cur); }
#undef PG8_SA
#undef PG8_SB
#undef PG8_STAGE
#undef PG8_LDA
#undef PG8_LDB
#undef PG8_MMA
#undef PG8_WAIT_V
#undef PG8_WAIT_L
#undef PG8_BAR
#undef PG8_SCHED
}
}
__device__ __forceinline__ float sigmoidf_dev(float x) { return __builtin_amdgcn_rcpf(1.0f + __builtin_amdgcn_exp2f(-x * LOG2E)); }

constexpr int NWAVES = 8;
#ifndef MK_PER_PHASE
#define MK_PER_PHASE 0
#endif
constexpr int PH_PER_LAYER = 10;
constexpr int N_PHASES = 2 + DEPTH * PH_PER_LAYER;

constexpr size_t MiB = 1u << 20;
constexpr size_t WS_CTL = 0, CTL_ZERO_BYTES = 2 * MiB;
constexpr size_t WS_CVEC = 1 * MiB;
constexpr int CV_C1IN = 0, CV_C2IN = 4 * IN_COLS, CV_C1UP = 8 * IN_COLS, CV_C2UP = 8 * IN_COLS + 4 * UP_COLS;
static_assert((size_t)(8 * IN_COLS + 8 * UP_COLS) * 4 <= MiB, "fold vectors fit their MiB");
constexpr size_t WS_ROPEA = 2 * MiB;
constexpr size_t WS_ROPEB = 3 * MiB;
constexpr size_t WS_LSE = 4 * MiB;
constexpr size_t WS_STP1 = 5 * MiB, WS_STP2 = 9 * MiB;
constexpr size_t WS_SBL = 13 * MiB, WS_SBF = 17 * MiB;
constexpr size_t WS_W = 24 * MiB;
constexpr size_t LW_IN = 0, LW_PA = 120 * MiB, LW_PB = 124 * MiB, LW_OUT = 140 * MiB, LW_UP = 172 * MiB, LW_DN = 300 * MiB, LW_BYTES = 364 * MiB;
constexpr size_t WS_XB = WS_W + DEPTH * LW_BYTES;
constexpr size_t WS_XF = WS_XB + 64 * MiB;
constexpr size_t WS_HF = WS_XF + 128 * MiB;
constexpr size_t WS_PROJ = WS_HF + 128 * MiB;
constexpr size_t WS_OG = WS_PROJ + 240 * MiB;
constexpr size_t WS_YA = WS_OG + 48 * MiB;
constexpr size_t WS_YB = WS_YA + 8 * MiB;
constexpr size_t WS_MG = WS_YB + 32 * MiB;
constexpr size_t WS_U = WS_MG + 64 * MiB;
constexpr size_t WS_HA = WS_U + 256 * MiB;
constexpr size_t WS_G8 = WS_HA + 128 * MiB;
constexpr size_t WS_MT = WS_HA + 128 * MiB;
constexpr size_t WS_END = WS_MT + 64 * MiB;
static_assert((size_t)IN_COLS * DM * 2 == 120 * MiB && (size_t)M * IN_COLS * 2 == 240 * MiB && (size_t)3 * M * 512 * 4 == 48 * MiB, "ws map");
constexpr int CW_TMO = 0, CW_CODE = 1;
constexpr int IN_FULL_ROUNDS = (M / 256) * (IN_COLS / 256) / 256;
constexpr int IN_TAIL = (M / 256) * (IN_COLS / 256) - IN_FULL_ROUNDS * 256;
constexpr int CW_BAR = 4096;

constexpr int RING_OFF = 0, RING_BYTES = 131072;
constexpr int KSA = 272, KSB = 144;
constexpr int SCRATCH_BYTES = 2 * 256 * KSA;
constexpr int LDSCTL_OFF = SCRATCH_BYTES, MISC_OFF = LDSCTL_OFF + 320;
constexpr int LDS_BYTES = 147456;
static_assert(MISC_OFF + 128 <= LDS_BYTES && 8 * 128 * 33 * 4 <= SCRATCH_BYTES && RING_BYTES <= SCRATCH_BYTES, "LDS map");

#define GAS __attribute__((address_space(1)))
#define LAS __attribute__((address_space(3)))
typedef unsigned short bf16;
typedef unsigned v4u __attribute__((ext_vector_type(4)));
typedef float f32x4 __attribute__((ext_vector_type(4)));
typedef short bf16x8 __attribute__((ext_vector_type(8)));
typedef GAS unsigned gu32;
typedef GAS unsigned long long gu64;
#define RLX_AGENT __ATOMIC_RELAXED, __HIP_MEMORY_SCOPE_AGENT
#define LDS_WAIT() asm volatile("s_waitcnt lgkmcnt(0)" ::: "memory")
#define VM_WAIT() asm volatile("s_waitcnt vmcnt(0)" ::: "memory")
__device__ __forceinline__ unsigned long long rt() { return __builtin_amdgcn_s_memrealtime(); }
__device__ __forceinline__ unsigned f2bf(float f) { unsigned u = __builtin_bit_cast(unsigned, f); return (u + 0x7fffu + ((u >> 16) & 1u)) >> 16; }
__device__ __forceinline__ unsigned pk2(float lo, float hi) { return f2bf(lo) | (f2bf(hi) << 16); }

#define XB_TMO      128
#define XB_XCNT(j)  (256  + 64 * (j))
#define XB_XSUB(j)  (1280 + 64 * (j))
#define XB_XGEN(j)  (2304 + 64 * (j))
#define XB_TOP      3328
#define XB_TOPGEN   3392
#define XCD_BAR_WORDS 3456
#define XB_SPIN_CAP (1u << 18)

__device__ __forceinline__ unsigned xb_ld(unsigned* p)              { return __hip_atomic_load((GAS unsigned*)p, __ATOMIC_RELAXED, __HIP_MEMORY_SCOPE_AGENT); }
__device__ __forceinline__ unsigned xb_add(unsigned* p, unsigned v) { return __hip_atomic_fetch_add((GAS unsigned*)p, v, __ATOMIC_RELAXED, __HIP_MEMORY_SCOPE_AGENT); }
__device__ __forceinline__ unsigned xb_xcc_id() { return (unsigned)__builtin_amdgcn_s_getreg((3 << 11) | 20) & 0xFu; }
#define XB_SPIN(cond, bar) do { unsigned _sp = 0; while (cond) { __builtin_amdgcn_s_sleep(1); \
    if ((++_sp & 255u) == 0u) { if (xb_ld(&(bar)[XB_TMO])) break; if (_sp > XB_SPIN_CAP) { (void)xb_add(&(bar)[XB_TMO], 1u); break; } } } } while (0)

struct XcdBarrier {
    unsigned* bar; unsigned x;
    volatile LAS unsigned* st;
};

__device__ __forceinline__ XcdBarrier xcd_barrier_post(unsigned* bar, volatile LAS unsigned* st) {
    XcdBarrier b; b.bar = bar; b.x = xb_xcc_id(); b.st = st;
    if (threadIdx.x == 0) (void)xb_add(&bar[XB_XCNT(b.x)], 1u);
    return b;
}
__device__ __forceinline__ void xcd_barrier_complete(unsigned* bar, unsigned x, unsigned& nloc, unsigned& nx) {
    const unsigned G = gridDim.x * gridDim.y * gridDim.z;
    unsigned sum, cnt, mine, sp = 0u;
    for (;;) {
        sum = 0u; cnt = 0u; mine = 0u;
#pragma unroll
        for (unsigned j = 0; j < 16; ++j) { const unsigned c = xb_ld(&bar[XB_XCNT(j)]); sum += c; cnt += (c > 0u) ? 1u : 0u; mine = (j == x) ? c : mine; }
        if (sum == G) break;
        __builtin_amdgcn_s_sleep(1);
        if ((++sp & 255u) == 0u) { if (xb_ld(&bar[XB_TMO])) break; if (sp > XB_SPIN_CAP) { (void)xb_add(&bar[XB_TMO], 1u); break; } }
    }
    nloc = mine > 0u ? mine : 1u; nx = cnt > 0u ? cnt : 1u;
}

__device__ __forceinline__ void xcd_barrier(const XcdBarrier& b) {
    asm volatile("s_waitcnt vmcnt(0)" ::: "memory");
    __syncthreads();
    if (threadIdx.x == 0) {
        unsigned* bar = b.bar; unsigned bx = b.x; asm volatile("" : "+s"(bar), "+s"(bx));
        __builtin_amdgcn_s_waitcnt(0);
        unsigned nloc = b.st[0], nx = b.st[1];
        if (nloc == 0u) { xcd_barrier_complete(bar, bx, nloc, nx); b.st[0] = nloc; b.st[1] = nx; }
        const unsigned old = xb_add(&bar[XB_XSUB(bx)], 1u);
        const unsigned gen = old / nloc;
        if (old + 1u == (gen + 1u) * nloc) {
            __builtin_amdgcn_fence(__ATOMIC_RELEASE, "agent");
            asm volatile("s_waitcnt vmcnt(0)" ::: "memory");
            const unsigned og = xb_add(&bar[XB_TOP], 1u);
            const unsigned tg = og / nx;
            if (og + 1u == (tg + 1u) * nx) xb_add(&bar[XB_TOPGEN], 1u);
            else XB_SPIN(xb_ld(&bar[XB_TOPGEN]) == tg, bar);
            __builtin_amdgcn_fence(__ATOMIC_ACQUIRE, "agent");
            xb_add(&bar[XB_XGEN(bx)], 1u);
            asm volatile("s_waitcnt vmcnt(0)" ::: "memory");
        } else {
            XB_SPIN(xb_ld(&bar[XB_XGEN(bx)]) == gen, bar);
            __builtin_amdgcn_fence(__ATOMIC_ACQUIRE, "agent");
            asm volatile("s_waitcnt vmcnt(0)" ::: "memory");
        }
    }
    __syncthreads();
}

typedef short v4i16_t __attribute__((ext_vector_type(4)));
using pg8::pk4_fp8;
typedef GAS const float gcf; typedef GAS float gf; typedef GAS bf16 gbf; typedef GAS const bf16 gcbf;
typedef float f32x2v __attribute__((ext_vector_type(2)));
typedef __bf16 bf16x2v __attribute__((ext_vector_type(2)));
__device__ __forceinline__ unsigned cvtpk(float lo, float hi) { f32x2v v = {lo, hi}; bf16x2v b = __builtin_convertvector(v, bf16x2v); return __builtin_bit_cast(unsigned, b); }
__device__ __forceinline__ float bflo(unsigned w) { return __uint_as_float(w << 16); }
__device__ __forceinline__ float bfhi(unsigned w) { return __uint_as_float(w & 0xffff0000u); }

struct Frame {
    LAS unsigned char* lds;
    volatile LAS unsigned* MISC;
    gu32* ctl;
    int tid, lane, wave;
    int vcu, G, bid;
};

__device__ __forceinline__ float wave_sum(float v) {
#pragma unroll
    for (int o = 1; o < 64; o <<= 1) v += __shfl_xor(v, o);
    return v;
}

__device__ __forceinline__ int win_dst_col(int c) {
    if (c < VA_OFF) { const int d = c & 127; if (d < 32) { const int nd = d < 16 ? 8 * (d >> 2) + (d & 3) : 8 * ((d - 16) >> 2) + 4 + (d & 3); return c - d + nd; } return c; }
    if (c >= QB_OFF && c < VB_OFF) { const int d = c & 63; if (d < 16) { const int nd = d < 8 ? 8 * (d >> 2) + (d & 3) : 8 * ((d - 8) >> 2) + 4 + (d & 3); return c - d + nd; } return c; }
    return c;
}
__device__ __forceinline__ void atomic_addf(gf* p, float v) { (void)__hip_atomic_fetch_add(p, v, __ATOMIC_RELAXED, __HIP_MEMORY_SCOPE_AGENT); }
__device__ __forceinline__ int up_dst_row(int c) { const int hf = c >= DFF ? 1 : 0, cc = c - hf * DFF; return 256 * (cc >> 7) + 128 * hf + (cc & 127); }
__device__ __forceinline__ size_t wpack_off(int n, int kb, int ldb) { return ((size_t)((n >> 8) * (ldb >> 7) + (kb >> 7)) * 256 + (n & 255)) * 128 + (kb & 127); }
template <bool FOLD, bool UPPERM>
__device__ __forceinline__ void p0_transpose_item(gcf* W, int K, int N, gbf* WT, gcf* g, gcf* b, gf* c1, gf* c2, LAS float* scr, int item, int lane) {
    const int nblk = N >> 6, kbg = item / nblk, nb = item - kbg * nblk, n0 = 64 * nb;
    f32x4 s1 = (f32x4){0.f, 0.f, 0.f, 0.f}, s2 = s1;
#pragma unroll 1
    for (int kk = 0; kk < 4; ++kk) { const int k0 = 64 * (4 * kbg + kk);
        const GAS f32x4* src = (const GAS f32x4*)(W + (size_t)(k0 + (lane >> 4)) * N + n0 + 4 * (lane & 15));
        f32x4 v[16];
#pragma unroll
        for (int i = 0; i < 16; ++i) v[i] = src[(size_t)i * N];
        if (FOLD) {
#pragma unroll
            for (int i = 0; i < 16; ++i) { const int k = k0 + 4 * i + (lane >> 4); const float gk = g[k], bk = b[k]; s2 = s2 + v[i] * bk; v[i] = v[i] * gk; s1 = s1 + v[i]; } }
#pragma unroll
        for (int i = 0; i < 16; ++i) { LAS float* d = scr + (4 * i + (lane >> 4)) * 65 + 4 * (lane & 15); d[0] = v[i][0]; d[1] = v[i][1]; d[2] = v[i][2]; d[3] = v[i][3]; }
        LDS_WAIT(); asm volatile("" ::: "memory");
        const int c = lane & 7;
#pragma unroll
        for (int j = 0; j < 8; ++j) { const int n = (lane >> 3) + 8 * j; const LAS float* q = scr + (8 * c) * 65 + n;
            v4u o; o.x = cvtpk(q[0 * 65], q[1 * 65]); o.y = cvtpk(q[2 * 65], q[3 * 65]); o.z = cvtpk(q[4 * 65], q[5 * 65]); o.w = cvtpk(q[6 * 65], q[7 * 65]);
            *(GAS v4u*)((GAS unsigned char*)WT + wpack_off(UPPERM ? up_dst_row(n0 + n) : n0 + n, 2 * (k0 + 8 * c), 2 * K)) = o; }
        LDS_WAIT(); asm volatile("" ::: "memory");
    }
    if (FOLD) {
#pragma unroll
        for (int j = 0; j < 4; ++j) { s1[j] += __shfl_xor(s1[j], 16); s1[j] += __shfl_xor(s1[j], 32); s2[j] += __shfl_xor(s2[j], 16); s2[j] += __shfl_xor(s2[j], 32); }
        float t1 = 0.f, t2 = 0.f;
#pragma unroll
        for (int j = 0; j < 4; ++j) { const float a1 = __shfl(s1[j], lane >> 2), a2 = __shfl(s2[j], lane >> 2); if ((lane & 3) == j) { t1 = a1; t2 = a2; } }
        const int dc = UPPERM ? up_dst_row(n0 + lane) : n0 + lane; atomic_addf(c1 + dc, t1); atomic_addf(c2 + dc, t2); }
}
template <bool PERM_IN, bool FOLD>
__device__ __forceinline__ void p0_transpose_item8(gcf* W, int K, int N, GAS unsigned char* WT, int ldw  , int kofs  , float scale, gcf* g, gcf* b, gf* c1, gf* c2, LAS float* scr, int item, int lane) {
    const int nblk = N >> 5, kbg = item / nblk, nb = item - kbg * nblk, n0 = 32 * nb;
    f32x4 s1 = (f32x4){0.f, 0.f, 0.f, 0.f}, s2 = s1;
#pragma unroll 1
    for (int kk = 0; kk < 4; ++kk) { const int k0 = 128 * (4 * kbg + kk);
        const GAS f32x4* src = (const GAS f32x4*)(W + (size_t)(k0 + (lane >> 3)) * N + n0 + 4 * (lane & 7));
        f32x4 v[16];
#pragma unroll
        for (int i = 0; i < 16; ++i) v[i] = src[(size_t)i * 2 * N];
        if (FOLD) {
#pragma unroll
            for (int i = 0; i < 16; ++i) { const int k = k0 + 8 * i + (lane >> 3); const float gk = g[k], bk = b[k]; s2 = s2 + v[i] * bk; v[i] = v[i] * gk; s1 = s1 + v[i]; } }
#pragma unroll
        for (int i = 0; i < 16; ++i) { LAS float* d = scr + (8 * i + (lane >> 3)) * 33 + 4 * (lane & 7); d[0] = v[i][0]; d[1] = v[i][1]; d[2] = v[i][2]; d[3] = v[i][3]; }
        LDS_WAIT(); asm volatile("" ::: "memory");
        const int c = lane & 7;
#pragma unroll
        for (int j = 0; j < 4; ++j) { const int n = (lane >> 3) + 8 * j; const LAS float* q = scr + (16 * c) * 33 + n;
            v4u o; o.x = pk4_fp8(q[0 * 33] * scale, q[1 * 33] * scale, q[2 * 33] * scale, q[3 * 33] * scale); o.y = pk4_fp8(q[4 * 33] * scale, q[5 * 33] * scale, q[6 * 33] * scale, q[7 * 33] * scale);
            o.z = pk4_fp8(q[8 * 33] * scale, q[9 * 33] * scale, q[10 * 33] * scale, q[11 * 33] * scale); o.w = pk4_fp8(q[12 * 33] * scale, q[13 * 33] * scale, q[14 * 33] * scale, q[15 * 33] * scale);
            const int row = PERM_IN ? win_dst_col(n0 + n) : n0 + n;
            *(GAS v4u*)(WT + wpack_off(row, kofs + k0 + 16 * c, ldw)) = o; }
        LDS_WAIT(); asm volatile("" ::: "memory");
    }
    if (FOLD) {
#pragma unroll
        for (int j = 0; j < 4; ++j) { s1[j] += __shfl_xor(s1[j], 8); s1[j] += __shfl_xor(s1[j], 16); s1[j] += __shfl_xor(s1[j], 32); s2[j] += __shfl_xor(s2[j], 8); s2[j] += __shfl_xor(s2[j], 16); s2[j] += __shfl_xor(s2[j], 32); }
        float t1 = 0.f, t2 = 0.f;
#pragma unroll
        for (int j = 0; j < 4; ++j) { const float a1 = __shfl(s1[j], (lane >> 2) & 7), a2 = __shfl(s2[j], (lane >> 2) & 7); if ((lane & 3) == j) { t1 = a1; t2 = a2; } }
        if (lane < 32) { const int cc = n0 + lane, dc = PERM_IN ? win_dst_col(cc) : cc; atomic_addf(c1 + dc, t1); atomic_addf(c2 + dc, t2); } }
}
__device__ __forceinline__ void sincos_d(double a, float& c, float& s) {
    const double q = __builtin_rint(a * 0.63661977236758134308);
    const double r = (a - q * 1.5707963267948966192) - q * 6.123233995736766036e-17;
    const double r2 = r * r;
    const double sn = r * (1.0 + r2 * (-1.0 / 6 + r2 * (1.0 / 120 + r2 * (-1.0 / 5040 + r2 * (1.0 / 362880 + r2 * (-1.0 / 39916800 + r2 * (1.0 / 6227020800.0)))))));
    const double cs = 1.0 + r2 * (-0.5 + r2 * (1.0 / 24 + r2 * (-1.0 / 720 + r2 * (1.0 / 40320 + r2 * (-1.0 / 3628800 + r2 * (1.0 / 479001600 + r2 * (-1.0 / 87178291200.0)))))));
    const int qi = (int)q & 3;
    const double sv = (qi == 0) ? sn : (qi == 1) ? cs : (qi == 2) ? -sn : -cs;
    const double cv = (qi == 0) ? cs : (qi == 1) ? -sn : (qi == 2) ? -cs : sn;
    c = (float)cv; s = (float)sv;
}
enum { PT_X, PT_POS, PT_WIN, PT_WPA, PT_WPB, PT_WOUT, PT_SINKS, PT_LN1G, PT_LN1B, PT_WUP, PT_CW, PT_CB, PT_WDN, PT_LN2G, PT_LN2B, PT_OUT, PT_WS, PT_N };
struct Ptrs { const void* p[PT_N]; };
__device__ __forceinline__ GAS unsigned char* ldptr(const Frame& F, int i) {
    unsigned off = LDSCTL_OFF + 8 * i; asm volatile("" : "+v"(off));
    const unsigned long long v = *(volatile LAS unsigned long long*)(F.lds + off);
    const unsigned lo = __builtin_amdgcn_readfirstlane((unsigned)v), hi = __builtin_amdgcn_readfirstlane((unsigned)(v >> 32));
    return (GAS unsigned char*)(((unsigned long long)hi << 32) | lo);
}
struct PPtrs { gcf *x, *w_in, *w_pa, *w_pb, *w_out, *w_up, *w_dn, *ln1g, *ln1b, *ln2g, *ln2b; GAS const int* pos; GAS unsigned char* ws; };
__device__ __forceinline__ void p0_prologue(Frame& F) {
    PPtrs P; P.x = (gcf*)ldptr(F, PT_X); P.w_in = (gcf*)ldptr(F, PT_WIN); P.w_pa = (gcf*)ldptr(F, PT_WPA); P.w_pb = (gcf*)ldptr(F, PT_WPB); P.w_out = (gcf*)ldptr(F, PT_WOUT);
    P.w_up = (gcf*)ldptr(F, PT_WUP); P.w_dn = (gcf*)ldptr(F, PT_WDN); P.ln1g = (gcf*)ldptr(F, PT_LN1G); P.ln1b = (gcf*)ldptr(F, PT_LN1B); P.ln2g = (gcf*)ldptr(F, PT_LN2G); P.ln2b = (gcf*)ldptr(F, PT_LN2B); P.pos = (GAS const int*)ldptr(F, PT_POS); P.ws = ldptr(F, PT_WS);
    LAS float* scr = (LAS float*)(F.lds + F.wave * (128 * 33 * 4));
    const int gw = F.vcu * NWAVES + F.wave, NGW = F.G * NWAVES;
    constexpr int I_IN = (DM / 512) * (IN_COLS / 32), I_PA = (A_OUT / 512) * (DM / 32), I_PB = (B_QW / 512) * (DM / 32), I_OUT = (DM / 512) * (DM / 32), I_UP = (DM / 256) * (UP_COLS / 64), I_DN = (DFF / 256) * (DM / 64);
    constexpr int I_LAYER = I_IN + I_PA + I_PB + I_OUT + I_UP + I_DN;
    gf* cv = (gf*)(P.ws + WS_CVEC);
    for (int it = gw; it < DEPTH * I_LAYER; it += NGW) {
        const int l = it / I_LAYER; int r = it - l * I_LAYER;
        GAS unsigned char* wl = P.ws + WS_W + (size_t)l * LW_BYTES;
        if (r < I_IN) { if (l == 0) p0_transpose_item8<true, false>(P.w_in, DM, IN_COLS, wl + LW_IN, DM, 0, F8S_WIN, nullptr, nullptr, nullptr, nullptr, scr, r, F.lane);
                        else p0_transpose_item8<true, true>(P.w_in + (size_t)l * DM * IN_COLS, DM, IN_COLS, wl + LW_IN, DM, 0, F8S_WIN, P.ln2g + (l - 1) * DM, P.ln2b + (l - 1) * DM, cv + CV_C1IN + l * IN_COLS, cv + CV_C2IN + l * IN_COLS, scr, r, F.lane);
                        continue; } r -= I_IN;
        if (r < I_PA) { p0_transpose_item8<false, false>(P.w_pa + (size_t)l * A_OUT * DM, A_OUT, DM, wl + LW_PA, YW, 0, F8S_WPA, nullptr, nullptr, nullptr, nullptr, scr, r, F.lane); continue; } r -= I_PA;
        if (r < I_PB) { p0_transpose_item8<false, false>(P.w_pb + (size_t)l * B_QW * DM, B_QW, DM, wl + LW_PA, YW, A_OUT, F8S_WPB, nullptr, nullptr, nullptr, nullptr, scr, r, F.lane); continue; } r -= I_PB;
        if (r < I_OUT) { p0_transpose_item8<false, false>(P.w_out + (size_t)l * DM * DM, DM, DM, wl + LW_OUT, DM, 0, F8S_WOUT, nullptr, nullptr, nullptr, nullptr, scr, r, F.lane); continue; } r -= I_OUT;
        if (r < I_UP) { p0_transpose_item<true, true>(P.w_up + (size_t)l * DM * UP_COLS, DM, UP_COLS, (gbf*)(wl + LW_UP), P.ln1g + l * DM, P.ln1b + l * DM, cv + CV_C1UP + l * UP_COLS, cv + CV_C2UP + l * UP_COLS, scr, r, F.lane); continue; } r -= I_UP;
        p0_transpose_item<false, false>(P.w_dn + (size_t)l * DFF * DM, DFF, DM, (gbf*)(wl + LW_DN), nullptr, nullptr, nullptr, nullptr, scr, r, F.lane);
    }
    { const int gt = F.vcu * (NWAVES * 64) + F.tid, NT = F.G * NWAVES * 64; GAS unsigned char* X8 = P.ws + WS_XB;
      for (int i = gt; i < M * DM / 16; i += NT) { const GAS f32x4* q = (const GAS f32x4*)(P.x + (size_t)i * 16); const f32x4 a = q[0] * F8S_X, b = q[1] * F8S_X, c = q[2] * F8S_X, d = q[3] * F8S_X;
          v4u o; o.x = pk4_fp8(a[0], a[1], a[2], a[3]); o.y = pk4_fp8(b[0], b[1], b[2], b[3]); o.z = pk4_fp8(c[0], c[1], c[2], c[3]); o.w = pk4_fp8(d[0], d[1], d[2], d[3]); *(GAS v4u*)(X8 + (size_t)i * 16) = o; }
      gf* ra = (gf*)(P.ws + WS_ROPEA); gf* rb = (gf*)(P.ws + WS_ROPEB);
      constexpr double INVF[16] = {1.0, 0.44036660267178046, 0.19392274474868576, 0.08539710028576561, 0.03760603093086393, 0.016560440080994446, 0.007292664737217109, 0.003211445994752591,
                                   0.001414213562373095, 0.000622772421914596, 0.0002742481756762073, 0.00012076973741146504, 5.318295896944988e-05, 2.341999896140934e-05, 1.031338537721246e-05, 4.5416704806078695e-06};
      for (int m = gt; m < M; m += NT) { const double pos = (double)P.pos[m];
#pragma unroll
          for (int j = 0; j < 16; ++j) { float c, s; sincos_d(pos * INVF[j], c, s); ra[(size_t)m * 32 + j] = c; ra[(size_t)m * 32 + 16 + j] = s;
              if ((j & 1) == 0) { rb[(size_t)m * 16 + (j >> 1)] = c; rb[(size_t)m * 16 + 8 + (j >> 1)] = s; } } }
    }
}

__device__ __forceinline__ void ln_final_phase(Frame& F, GAS const unsigned short* H, gcf* g, gcf* b, gf* out) {
    const int gw = F.vcu * NWAVES + F.wave, NGW = F.G * NWAVES;
    for (int m = gw; m < M; m += NGW) {
        const GAS v4u* hr = (const GAS v4u*)(H + (size_t)m * DM) + F.lane;
        f32x4 v[8][2]; float s = 0.f;
#pragma unroll
        for (int j = 0; j < 8; ++j) { pg8::unpk8_f16(__builtin_bit_cast(pg8::u32x4, hr[64 * j]), v[j][0], v[j][1]); s += ((v[j][0][0] + v[j][0][1]) + (v[j][0][2] + v[j][0][3])) + ((v[j][1][0] + v[j][1][1]) + (v[j][1][2] + v[j][1][3])); }
        const float mean = wave_sum(s) * (1.f / DM); float s2 = 0.f;
#pragma unroll
        for (int j = 0; j < 8; ++j)
#pragma unroll
            for (int h = 0; h < 2; ++h) { v[j][h] = v[j][h] - mean; s2 += (v[j][h][0] * v[j][h][0] + v[j][h][1] * v[j][h][1]) + (v[j][h][2] * v[j][h][2] + v[j][h][3] * v[j][h][3]); }
        const float rstd = 1.f / sqrtf(wave_sum(s2) * (1.f / DM) + LN_EPS);
#pragma unroll
        for (int j = 0; j < 8; ++j)
#pragma unroll
            for (int h = 0; h < 2; ++h) { const int c = 8 * (F.lane + 64 * j) + 4 * h; *(GAS f32x4*)(out + (size_t)m * DM + c) = v[j][h] * rstd * *(const GAS f32x4*)(g + c) + *(const GAS f32x4*)(b + c); }
    }
}

__device__ __forceinline__ void stats_to_lds(Frame& F, gcf* STP, int pm) {
    const int row = F.tid >> 1, half = F.tid & 1;
    const GAS f32x4* p = (const GAS f32x4*)(STP + ((size_t)(pm * 256 + row) * 64 + 32 * half) * 2);
    float sm = 0.f, sq = 0.f;
#pragma unroll
    for (int i = 0; i < 16; ++i) { const f32x4 v = p[i]; sm += v[0] + v[2]; sq += v[1] + v[3]; }
    sm += pg8::lx(sm, 1, F.lane); sq += pg8::lx(sq, 1, F.lane);
    const float mu = sm * (1.f / DM), var = sq * (1.f / DM) - mu * mu;
    if (half == 0) *(LAS f32x2v*)(F.lds + pg8::ST_OFF + row * 8) = (f32x2v){mu, 1.f / sqrtf(var + LN_EPS)};
    __syncthreads();
}

__device__ __forceinline__ void conv_fixup(Frame& F, int pm, gcf* SBL, gcf* SBF, gcf* cw, gcf* cb, gbf* HA) {
    const bool first = (pm & (SEQ / 256 - 1)) == 0;
    const int pl = first ? pm : pm - 1;
#pragma unroll
    for (int i = 0; i < 4; ++i) { const int c = 4 * (F.tid + 512 * i);
        f32x4 o[2][2];
#pragma unroll
        for (int gvh = 0; gvh < 2; ++gvh) { const int cc = c + gvh * DFF;
            f32x4 um2 = *(const GAS f32x4*)(SBL + (size_t)pl * 2 * UP_COLS + cc), um1 = *(const GAS f32x4*)(SBL + (size_t)pl * 2 * UP_COLS + UP_COLS + cc);
            if (first) { um2 = (f32x4){0.f, 0.f, 0.f, 0.f}; um1 = um2; }
            const f32x4 u0 = *(const GAS f32x4*)(SBF + (size_t)pm * 2 * UP_COLS + cc), u1 = *(const GAS f32x4*)(SBF + (size_t)pm * 2 * UP_COLS + UP_COLS + cc);
            const f32x4 w0 = *(const GAS f32x4*)(cw + cc), w1 = *(const GAS f32x4*)(cw + UP_COLS + cc), w2 = *(const GAS f32x4*)(cw + 2 * UP_COLS + cc), bb = *(const GAS f32x4*)(cb + cc);
            o[0][gvh] = w0 * um2 + w1 * um1 + w2 * u0 + bb; o[1][gvh] = w0 * um1 + w1 * u0 + w2 * u1 + bb; }
#pragma unroll
        for (int t = 0; t < 2; ++t) { const f32x4 g = o[t][0], v = o[t][1];
            *(GAS unsigned long long*)(HA + (size_t)(pm * 256 + t) * DFF + c) = (unsigned long long)cvtpk(pg8::silu_mul(g[0], v[0]), pg8::silu_mul(g[1], v[1])) | ((unsigned long long)cvtpk(pg8::silu_mul(g[2], v[2]), pg8::silu_mul(g[3], v[3])) << 32); } }
    asm volatile("s_waitcnt vmcnt(0)" ::: "memory"); __syncthreads();
}

__device__ __forceinline__ void conv_phase(Frame& F, gcbf* U, gcf* cw, gcf* cb, gbf* HA) {
    const int gt = F.vcu * (NWAVES * 64) + F.tid, NT = F.G * NWAVES * 64;
    for (int item = gt; item < (DFF / 8) * (M / 64); item += NT) {
        const int c0 = 8 * (item & (DFF / 8 - 1)), t0 = 64 * (item >> 10);
        f32x4 wg[3][2], wv[3][2], bg[2], bv[2];
#pragma unroll
        for (int h = 0; h < 2; ++h) {
#pragma unroll
            for (int i = 0; i < 3; ++i) { wg[i][h] = *(const GAS f32x4*)(cw + (size_t)i * UP_COLS + c0 + 4 * h); wv[i][h] = *(const GAS f32x4*)(cw + (size_t)i * UP_COLS + DFF + c0 + 4 * h); }
            bg[h] = *(const GAS f32x4*)(cb + c0 + 4 * h); bv[h] = *(const GAS f32x4*)(cb + DFF + c0 + 4 * h); }
        f32x4 g1[2], g2[2], v1[2], v2[2];
        const bool first = (t0 & (SEQ - 1)) == 0;
        { const int ta = first ? t0 : t0 - 1, tb = first ? t0 : t0 - 2;
          const v4u a = *(const GAS v4u*)(U + (size_t)ta * UP_COLS + c0), av = *(const GAS v4u*)(U + (size_t)ta * UP_COLS + DFF + c0);
          const v4u b = *(const GAS v4u*)(U + (size_t)tb * UP_COLS + c0), bw = *(const GAS v4u*)(U + (size_t)tb * UP_COLS + DFF + c0);
          const float z = first ? 0.f : 1.f;
          g1[0] = (f32x4){bflo(a.x), bfhi(a.x), bflo(a.y), bfhi(a.y)} * z; g1[1] = (f32x4){bflo(a.z), bfhi(a.z), bflo(a.w), bfhi(a.w)} * z;
          v1[0] = (f32x4){bflo(av.x), bfhi(av.x), bflo(av.y), bfhi(av.y)} * z; v1[1] = (f32x4){bflo(av.z), bfhi(av.z), bflo(av.w), bfhi(av.w)} * z;
          g2[0] = (f32x4){bflo(b.x), bfhi(b.x), bflo(b.y), bfhi(b.y)} * z; g2[1] = (f32x4){bflo(b.z), bfhi(b.z), bflo(b.w), bfhi(b.w)} * z;
          v2[0] = (f32x4){bflo(bw.x), bfhi(bw.x), bflo(bw.y), bfhi(bw.y)} * z; v2[1] = (f32x4){bflo(bw.z), bfhi(bw.z), bflo(bw.w), bfhi(bw.w)} * z; }
#pragma unroll 4
        for (int t = t0; t < t0 + 64; ++t) {
            const v4u a = *(const GAS v4u*)(U + (size_t)t * UP_COLS + c0), av = *(const GAS v4u*)(U + (size_t)t * UP_COLS + DFF + c0);
            f32x4 gc[2], vc[2], hh[2];
            gc[0] = (f32x4){bflo(a.x), bfhi(a.x), bflo(a.y), bfhi(a.y)}; gc[1] = (f32x4){bflo(a.z), bfhi(a.z), bflo(a.w), bfhi(a.w)};
            vc[0] = (f32x4){bflo(av.x), bfhi(av.x), bflo(av.y), bfhi(av.y)}; vc[1] = (f32x4){bflo(av.z), bfhi(av.z), bflo(av.w), bfhi(av.w)};
#pragma unroll
            for (int h = 0; h < 2; ++h) {
                const f32x4 ug = wg[0][h] * g2[h] + wg[1][h] * g1[h] + wg[2][h] * gc[h] + bg[h];
                const f32x4 uv = wv[0][h] * v2[h] + wv[1][h] * v1[h] + wv[2][h] * vc[h] + bv[h];
#pragma unroll
                for (int j = 0; j < 4; ++j) hh[h][j] = ug[j] * sigmoidf_dev(ug[j]) * uv[j];
                g2[h] = g1[h]; g1[h] = gc[h]; v2[h] = v1[h]; v1[h] = vc[h]; }
            v4u o; o.x = cvtpk(hh[0][0], hh[0][1]); o.y = cvtpk(hh[0][2], hh[0][3]); o.z = cvtpk(hh[1][0], hh[1][1]); o.w = cvtpk(hh[1][2], hh[1][3]);
            *(GAS v4u*)(HA + (size_t)t * DFF + c0) = o;
        }
    }
}

__device__ __forceinline__ v4i16_t vtr(const LAS unsigned char* p) { return __builtin_amdgcn_ds_read_tr16_b64_v4i16((LAS v4i16_t*)p); }
template <int HD, int KS, int MAXD>
__device__ __forceinline__ void attn_wave(const LAS unsigned char* Kl, const LAS unsigned char* Vl, const bf16x8 (&qf)[HD / 32], int w, int lane, bool first_blk, float sink2, bool has_sink,
                                          f32x4 (&o)[HD / 16], float& mx_out, float& l_out) {
    int lane_o = lane; asm volatile("" : "+v"(lane_o));
    const int fr = lane_o & 15, fq = lane_o >> 4, sb = 32 * (w >> 1);
    f32x4 S[10];
    constexpr int KK = HD / 32;
    const LAS unsigned char* kp0 = Kl + (sb + 8 * (fr >> 2) + (fr & 3)) * KS + 16 * fq;
    bf16x8 ka[2][2 * KK];
#define AT_LDK(ks_, bb_) _Pragma("unroll") for (int t = 0; t < 2; ++t) _Pragma("unroll") for (int kk = 0; kk < KK; ++kk) ka[bb_][t * KK + kk] = *(const LAS bf16x8*)(kp0 + (32 * (ks_) + 4 * t) * KS + 64 * kk)
    AT_LDK(0, 0);
#pragma unroll
    for (int ks = 0; ks < 5; ++ks) {
        if (ks + 1 < 5) { AT_LDK(ks + 1, (ks + 1) & 1); }
        __builtin_amdgcn_sched_barrier(0);
        S[2 * ks] = (f32x4){0.f, 0.f, 0.f, 0.f}; S[2 * ks + 1] = (f32x4){0.f, 0.f, 0.f, 0.f};
#pragma unroll
        for (int kk = 0; kk < KK; ++kk)
#pragma unroll
            for (int t = 0; t < 2; ++t) S[2 * ks + t] = __builtin_amdgcn_mfma_f32_16x16x32_bf16(ka[ks & 1][t * KK + kk], qf[kk], S[2 * ks + t], 0, 0, 0);
        __builtin_amdgcn_sched_barrier(0);
    }
#undef AT_LDK
    const int Lq = fr - 8 * fq, c0 = 128 + 16 * w - sb; float mx = -INFINITY;
    const int thr0 = first_blk ? -1000 : MAXD - c0, thr4 = 128 - c0;
#pragma unroll
    for (int ks = 0; ks < 5; ++ks)
#pragma unroll
        for (int t = 0; t < 2; ++t)
#pragma unroll
            for (int r = 0; r < 4; ++r) { float s = S[2 * ks + t][r];
                if (ks == 0) s = (Lq <= thr0 + 4 * t + r) ? s : -INFINITY;
                else if (ks == 4) s = (Lq >= thr4 + 4 * t + r) ? s : -INFINITY;
                else s = (first_blk && sb + 32 * ks < 128) ? -INFINITY : s;
                S[2 * ks + t][r] = s; mx = fmaxf(mx, s); }
    mx = fmaxf(mx, pg8::lx(mx, 16, lane_o)); mx = fmaxf(mx, pg8::lx(mx, 32, lane_o));
    if (has_sink) mx = fmaxf(mx, sink2);
    float l = 0.f;
#pragma unroll
    for (int T = 0; T < 10; ++T)
#pragma unroll
        for (int r = 0; r < 4; ++r) { const float p = __builtin_amdgcn_exp2f(S[T][r] - mx); S[T][r] = p; l += p; }
    l += pg8::lx(l, 16, lane_o); l += pg8::lx(l, 32, lane_o);
    if (has_sink) l += __builtin_amdgcn_exp2f(sink2 - mx);
    bf16x8 pf[5];
#pragma unroll
    for (int ks = 0; ks < 5; ++ks) { v4u pw; pw.x = cvtpk(S[2 * ks][0], S[2 * ks][1]); pw.y = cvtpk(S[2 * ks][2], S[2 * ks][3]); pw.z = cvtpk(S[2 * ks + 1][0], S[2 * ks + 1][1]); pw.w = cvtpk(S[2 * ks + 1][2], S[2 * ks + 1][3]);
        pf[ks] = __builtin_bit_cast(bf16x8, pw); }
    const LAS unsigned char* vp = Vl + (sb + 8 * fq + ((lane_o & 15) >> 2)) * KS + 8 * (lane_o & 3);
    constexpr int ND = HD / 16;
    v4i16_t va[2][2 * ND];
#define AT_LDV(ks_, bb_) _Pragma("unroll") for (int dt = 0; dt < ND; ++dt) { va[bb_][2 * dt] = vtr(vp + (32 * (ks_)) * KS + 32 * dt); va[bb_][2 * dt + 1] = vtr(vp + (32 * (ks_) + 4) * KS + 32 * dt); }
    AT_LDV(0, 0);
#pragma unroll
    for (int dt = 0; dt < ND; ++dt) o[dt] = (f32x4){0.f, 0.f, 0.f, 0.f};
#pragma unroll
    for (int ks = 0; ks < 5; ++ks) {
        if (ks + 1 < 5) { AT_LDV(ks + 1, (ks + 1) & 1); }
        __builtin_amdgcn_sched_barrier(0);
#pragma unroll
        for (int dt = 0; dt < ND; ++dt) { const v4i16_t lo = va[ks & 1][2 * dt], hi = va[ks & 1][2 * dt + 1];
            const bf16x8 vf = (bf16x8){lo[0], lo[1], lo[2], lo[3], hi[0], hi[1], hi[2], hi[3]};
            o[dt] = __builtin_amdgcn_mfma_f32_16x16x32_bf16(vf, pf[ks], o[dt], 0, 0, 0); }
        __builtin_amdgcn_sched_barrier(0);
    }
#undef AT_LDV
    mx_out = mx; l_out = l;
}

__device__ __forceinline__ void attnA_phase(Frame& F, gcbf* PROJ, gbf* OG, gf* LSE) {
    LAS unsigned char* Kl = F.lds; LAS unsigned char* Vl = F.lds + 256 * KSA;
    const int lane = F.lane, w = F.wave, fr = lane & 15, fq = lane >> 4;
    for (int u = F.bid; u < 768; u += F.G) {
        const int b = u / 384, h = (u >> 5) % 12, cq = u & 31, grp = h >> 2, slot = h & 3;
        const int lr = 2 * grp;
        const int c = cq >> (5 - lr), qb = cq & ((32 >> lr) - 1);
        gcbf* kbase = PROJ + KA_OFF + h * 128; gcbf* vbase = PROJ + VA_OFF + h * 128;
        v4u kv[8], vv[8];
#pragma unroll
        for (int i = 0; i < 8; ++i) { const int rho = 32 * i + (F.tid >> 4), ch = F.tid & 15, p = 128 * (qb - 1) + rho, pc = p < 0 ? 0 : p;
            const size_t m = (size_t)b * SEQ + ((size_t)pc << lr) + c;
            kv[i] = *(const GAS v4u*)(kbase + m * IN_COLS + 8 * ch); vv[i] = *(const GAS v4u*)(vbase + m * IN_COLS + 8 * ch); }
        const int pq = 128 * qb + 16 * w + fr; const size_t mq = (size_t)b * SEQ + ((size_t)pq << lr) + c;
        bf16x8 qf[4];
#pragma unroll
        for (int kk = 0; kk < 4; ++kk) qf[kk] = *(const GAS bf16x8*)(PROJ + mq * IN_COLS + h * 128 + 32 * kk + 8 * fq);
#pragma unroll
        for (int i = 0; i < 8; ++i) { const int rho = 32 * i + (F.tid >> 4), ch = F.tid & 15; const bool z = (128 * (qb - 1) + rho) < 0;
            if (z) { kv[i] = (v4u){0u, 0u, 0u, 0u}; vv[i] = (v4u){0u, 0u, 0u, 0u}; }
            *(LAS v4u*)(Kl + rho * KSA + 16 * ch) = kv[i]; *(LAS v4u*)(Vl + rho * KSA + 16 * ch) = vv[i]; }
        __syncthreads();
        f32x4 o[8]; float mx, l;
        attn_wave<128, KSA, 128>(Kl, Vl, qf, w, lane, qb == 0, 0.f, false, o, mx, l);
        const float inv = 1.0f / l;
        gbf* op = OG + ((size_t)grp * M + mq) * 512 + slot * 128 + 4 * fq;
#pragma unroll
        for (int dt = 0; dt < 8; ++dt) { const f32x4 y = o[dt] * inv; *(GAS unsigned long long*)(op + 16 * dt) = (unsigned long long)cvtpk(y[0], y[1]) | ((unsigned long long)cvtpk(y[2], y[3]) << 32); }
        if (fq == 0) LSE[((size_t)grp * M + mq) * 4 + slot] = mx + __builtin_amdgcn_logf(l);
        __syncthreads();
    }
}
__device__ __forceinline__ void attnB_phase(Frame& F, gcbf* PROJ, gcf* sinks, GAS unsigned char* YB8) {
    LAS unsigned char* Kl = F.lds; LAS unsigned char* Vl = F.lds + 256 * KSB;
    const int lane = F.lane, w = F.wave, fr = lane & 15, fq = lane >> 4;
    for (int u = F.bid; u < 256; u += F.G) {
        const int b = u >> 7, kvh = (u >> 5) & 3, qb = u & 31;
        gcbf* kbase = PROJ + KB_OFF + kvh * 64; gcbf* vbase = PROJ + VB_OFF + kvh * 64;
        v4u kv[4], vv[4];
#pragma unroll
        for (int i = 0; i < 4; ++i) { const int idx = 512 * i + F.tid, rho = idx >> 3, ch = idx & 7, t = 128 * (qb - 1) + rho, tc = t < 0 ? 0 : t;
            const size_t m = (size_t)b * SEQ + tc;
            kv[i] = *(const GAS v4u*)(kbase + m * IN_COLS + 8 * ch); vv[i] = *(const GAS v4u*)(vbase + m * IN_COLS + 8 * ch); }
#pragma unroll
        for (int i = 0; i < 4; ++i) { const int idx = 512 * i + F.tid, rho = idx >> 3, ch = idx & 7; const bool z = (128 * (qb - 1) + rho) < 0;
            if (z) { kv[i] = (v4u){0u, 0u, 0u, 0u}; vv[i] = (v4u){0u, 0u, 0u, 0u}; }
            *(LAS v4u*)(Kl + rho * KSB + 16 * ch) = kv[i]; *(LAS v4u*)(Vl + rho * KSB + 16 * ch) = vv[i]; }
        __syncthreads();
        const size_t mq = (size_t)b * SEQ + 128 * qb + 16 * w + fr;
#pragma unroll 1
        for (int g = 0; g < 8; ++g) { const int hq = kvh * 8 + g;
            bf16x8 qf[2];
#pragma unroll
            for (int kk = 0; kk < 2; ++kk) qf[kk] = *(const GAS bf16x8*)(PROJ + mq * IN_COLS + QB_OFF + hq * 64 + 32 * kk + 8 * fq);
            f32x4 o[4]; float mx, l;
            const float sink2 = *(const __attribute__((address_space(4))) float*)(unsigned long long)(sinks + hq) * LOG2E;
            attn_wave<64, KSB, 127>(Kl, Vl, qf, w, lane, qb == 0, sink2, true, o, mx, l);
            const float inv = 1.0f / l;
            const float inv8 = inv * F8S_Y;
            GAS unsigned char* op = YB8 + mq * YW + A_OUT + hq * 64 + 4 * fq;
#pragma unroll
            for (int dt = 0; dt < 4; ++dt) { const f32x4 y = o[dt] * inv8; *(GAS unsigned*)(op + 16 * dt) = pk4_fp8(y[0], y[1], y[2], y[3]); } }
        __syncthreads();
    }
}
struct AUnitD { int b, h, grp, slot, lr, c, qb; };
__device__ __forceinline__ AUnitD attn_decodeA(int u) { AUnitD d; d.b = u / 384; d.h = (u >> 5) % 12; const int cq = u & 31; d.grp = d.h >> 2; d.slot = d.h & 3; d.lr = 2 * d.grp; d.c = cq >> (5 - d.lr); d.qb = cq & ((32 >> d.lr) - 1); return d; }
__device__ __forceinline__ v4u cvt8_bf16(unsigned w0, unsigned w1, float sc) {
    v4u r; r.x = __builtin_bit_cast(unsigned, __builtin_amdgcn_cvt_scalef32_pk_bf16_fp8(w0, sc, false)); r.y = __builtin_bit_cast(unsigned, __builtin_amdgcn_cvt_scalef32_pk_bf16_fp8(w0, sc, true));
    r.z = __builtin_bit_cast(unsigned, __builtin_amdgcn_cvt_scalef32_pk_bf16_fp8(w1, sc, false)); r.w = __builtin_bit_cast(unsigned, __builtin_amdgcn_cvt_scalef32_pk_bf16_fp8(w1, sc, true)); return r; }
__device__ __forceinline__ void attn_phase(Frame& F, const GAS unsigned char* Q8, gbf* OG, gf* LSE, gcf* sinks, GAS unsigned char* Y8) {
    typedef unsigned u32x2_ __attribute__((ext_vector_type(2)));
    const int lane = F.lane, w = F.wave, fr = lane & 15, fq = lane >> 4;
    v4u kv[4], vv[4]; u32x2_ qn[4];
#define AT_LOAD_A(d) do { const GAS unsigned char* kbase = Q8 + KA_OFF + (d).h * 128; const GAS unsigned char* vbase = Q8 + VA_OFF + (d).h * 128; \
        _Pragma("unroll") for (int i = 0; i < 4; ++i) { const int idx = 512 * i + F.tid, rho = idx >> 3, ch = idx & 7, p = 128 * ((d).qb - 1) + rho, pc = p < 0 ? 0 : p; \
            const size_t m = (size_t)(d).b * SEQ + ((size_t)pc << (d).lr) + (d).c; kv[i] = *(const GAS v4u*)(kbase + m * QW + 16 * ch); vv[i] = *(const GAS v4u*)(vbase + m * QW + 16 * ch); } \
        const size_t mq_ = (size_t)(d).b * SEQ + ((size_t)(128 * (d).qb + 16 * w + fr) << (d).lr) + (d).c; \
        _Pragma("unroll") for (int kk = 0; kk < 4; ++kk) qn[kk] = *(const GAS u32x2_*)(Q8 + mq_ * QW + (d).h * 128 + 32 * kk + 8 * fq); } while (0)
#define AT_LOAD_B(ub) do { const int b_ = (ub) >> 7, kvh_ = ((ub) >> 5) & 3, qb_ = (ub) & 31; const GAS unsigned char* kbase = Q8 + KB_OFF + kvh_ * 64; const GAS unsigned char* vbase = Q8 + VB_OFF + kvh_ * 64; \
        _Pragma("unroll") for (int i = 0; i < 2; ++i) { const int idx = 512 * i + F.tid, rho = idx >> 2, ch = idx & 3, t = 128 * (qb_ - 1) + rho, tc = t < 0 ? 0 : t; const size_t m = (size_t)b_ * SEQ + tc; \
            kv[i] = *(const GAS v4u*)(kbase + m * QW + 16 * ch); vv[i] = *(const GAS v4u*)(vbase + m * QW + 16 * ch); } \
        const size_t mq_ = (size_t)b_ * SEQ + 128 * qb_ + 16 * w + fr; \
        _Pragma("unroll") for (int kk = 0; kk < 2; ++kk) qn[kk] = *(const GAS u32x2_*)(Q8 + mq_ * QW + QB_OFF + (kvh_ * 8) * 64 + 32 * kk + 8 * fq); } while (0)
#define AT_CVTQ(dst, kk_) do { const unsigned a_ = qn[kk_].x, b_ = qn[kk_].y; dst = __builtin_bit_cast(bf16x8, cvt8_bf16(a_, b_, 1.0f / F8S_Q)); } while (0)
    const int nbw = F.G - IN_TAIL, bw = F.bid - IN_TAIL, per = (256 + nbw - 1) / nbw; const int ub0 = bw * per; const int nB = bw < 0 ? 0 : (ub0 >= 256 ? 0 : (ub0 + per > 256 ? 256 - ub0 : per));
    int u = F.bid; bool haveB = false;
    if (u < 768) {
        AUnitD cu = attn_decodeA(u); AT_LOAD_A(cu);
        for (;;) {
            LAS unsigned char* Kl = F.lds; LAS unsigned char* Vl = F.lds + 256 * KSA;
#pragma unroll
            for (int i = 0; i < 4; ++i) { const int idx = 512 * i + F.tid, rho = idx >> 3, ch = idx & 7; const bool z = (128 * (cu.qb - 1) + rho) < 0;
                if (z) { kv[i] = (v4u){0u, 0u, 0u, 0u}; vv[i] = (v4u){0u, 0u, 0u, 0u}; }
                const unsigned k0 = kv[i].x, k1 = kv[i].y, k2 = kv[i].z, k3 = kv[i].w, v0 = vv[i].x, v1 = vv[i].y, v2 = vv[i].z, v3 = vv[i].w;
                *(LAS v4u*)(Kl + rho * KSA + 32 * ch) = cvt8_bf16(k0, k1, 1.0f / F8S_K); *(LAS v4u*)(Kl + rho * KSA + 32 * ch + 16) = cvt8_bf16(k2, k3, 1.0f / F8S_K);
                *(LAS v4u*)(Vl + rho * KSA + 32 * ch) = cvt8_bf16(v0, v1, 1.0f / F8S_V); *(LAS v4u*)(Vl + rho * KSA + 32 * ch + 16) = cvt8_bf16(v2, v3, 1.0f / F8S_V); }
            bf16x8 qf[4];
#pragma unroll
            for (int kk = 0; kk < 4; ++kk) AT_CVTQ(qf[kk], kk);
            __syncthreads();
            const int un = u + F.G; const bool moreA = un < 768; AUnitD nu = cu;
            if (moreA) { nu = attn_decodeA(un); AT_LOAD_A(nu); } else if (nB > 0) { AT_LOAD_B(ub0); haveB = true; }
            f32x4 o[8]; float mx, l;
            attn_wave<128, KSA, 128>(Kl, Vl, qf, w, lane, cu.qb == 0, 0.f, false, o, mx, l);
            const float inv = 1.0f / l;
            const size_t mq = (size_t)cu.b * SEQ + ((size_t)(128 * cu.qb + 16 * w + fr) << cu.lr) + cu.c;
            gbf* op = OG + ((size_t)cu.grp * M + mq) * 512 + cu.slot * 128 + 4 * fq;
#pragma unroll
            for (int dt = 0; dt < 8; ++dt) { const f32x4 y = o[dt] * inv; *(GAS unsigned long long*)(op + 16 * dt) = (unsigned long long)cvtpk(y[0], y[1]) | ((unsigned long long)cvtpk(y[2], y[3]) << 32); }
            if (fq == 0) LSE[((size_t)cu.grp * M + mq) * 4 + cu.slot] = mx + __builtin_amdgcn_logf(l);
            __syncthreads();
            if (!moreA) break;
            u = un; cu = nu;
        }
    }
    for (int ub = ub0; ub < ub0 + nB; ++ub) {
        if (!haveB) AT_LOAD_B(ub);
        haveB = false;
        const int b = ub >> 7, kvh = (ub >> 5) & 3, qb = ub & 31;
        LAS unsigned char* Kl = F.lds; LAS unsigned char* Vl = F.lds + 256 * KSB;
#pragma unroll
        for (int i = 0; i < 2; ++i) { const int idx = 512 * i + F.tid, rho = idx >> 2, ch = idx & 3; const bool z = (128 * (qb - 1) + rho) < 0;
            if (z) { kv[i] = (v4u){0u, 0u, 0u, 0u}; vv[i] = (v4u){0u, 0u, 0u, 0u}; }
            const unsigned k0 = kv[i].x, k1 = kv[i].y, k2 = kv[i].z, k3 = kv[i].w, v0 = vv[i].x, v1 = vv[i].y, v2 = vv[i].z, v3 = vv[i].w;
            *(LAS v4u*)(Kl + rho * KSB + 32 * ch) = cvt8_bf16(k0, k1, 1.0f / F8S_K); *(LAS v4u*)(Kl + rho * KSB + 32 * ch + 16) = cvt8_bf16(k2, k3, 1.0f / F8S_K);
            *(LAS v4u*)(Vl + rho * KSB + 32 * ch) = cvt8_bf16(v0, v1, 1.0f / F8S_V); *(LAS v4u*)(Vl + rho * KSB + 32 * ch + 16) = cvt8_bf16(v2, v3, 1.0f / F8S_V); }
        __syncthreads();
        const size_t mq = (size_t)b * SEQ + 128 * qb + 16 * w + fr;
#pragma unroll 1
        for (int g = 0; g < 8; ++g) { const int hq = kvh * 8 + g;
            bf16x8 qf[2]; AT_CVTQ(qf[0], 0); AT_CVTQ(qf[1], 1);
            if (g < 7) {
#pragma unroll
                for (int kk = 0; kk < 2; ++kk) qn[kk] = *(const GAS u32x2_*)(Q8 + mq * QW + QB_OFF + (hq + 1) * 64 + 32 * kk + 8 * fq); }
            f32x4 o[4]; float mx, l;
            const float sink2 = *(const __attribute__((address_space(4))) float*)(unsigned long long)(sinks + hq) * LOG2E;
            attn_wave<64, KSB, 127>(Kl, Vl, qf, w, lane, qb == 0, sink2, true, o, mx, l);
            const float inv8 = (1.0f / l) * F8S_Y;
            GAS unsigned char* op = Y8 + mq * YW + A_OUT + hq * 64 + 4 * fq;
#pragma unroll
            for (int dt = 0; dt < 4; ++dt) { const f32x4 y = o[dt] * inv8; *(GAS unsigned*)(op + 16 * dt) = pk4_fp8(y[0], y[1], y[2], y[3]); } }
        __syncthreads();
    }
#undef AT_LOAD_A
#undef AT_LOAD_B
#undef AT_CVTQ
}

__device__ __forceinline__ void combine_phase(Frame& F, gcbf* OG, gcf* LSE, GAS unsigned char* YA8) {
    const int gt = F.vcu * (NWAVES * 64) + F.tid, NT = F.G * NWAVES * 64;
    for (int item = gt; item < M * 128; item += NT) {
        const int m = item >> 7, j = (item >> 5) & 3, d4 = item & 31;
        const float l0 = LSE[((size_t)0 * M + m) * 4 + j], l1 = LSE[((size_t)1 * M + m) * 4 + j], l2 = LSE[((size_t)2 * M + m) * 4 + j];
        const float mx = fmaxf(l0, fmaxf(l1, l2));
        const float e0 = __builtin_amdgcn_exp2f(l0 - mx), e1 = __builtin_amdgcn_exp2f(l1 - mx), e2 = __builtin_amdgcn_exp2f(l2 - mx), inv = 1.0f / (e0 + e1 + e2);
        const size_t off = (size_t)m * 512 + j * 128 + 4 * d4;
        const unsigned long long wa = *(const GAS unsigned long long*)(OG + off), wb = *(const GAS unsigned long long*)(OG + (size_t)M * 512 + off), wc = *(const GAS unsigned long long*)(OG + (size_t)2 * M * 512 + off);
        const f32x4 a = (f32x4){bflo((unsigned)wa), bfhi((unsigned)wa), bflo((unsigned)(wa >> 32)), bfhi((unsigned)(wa >> 32))}, bq = (f32x4){bflo((unsigned)wb), bfhi((unsigned)wb), bflo((unsigned)(wb >> 32)), bfhi((unsigned)(wb >> 32))},
                    cq = (f32x4){bflo((unsigned)wc), bfhi((unsigned)wc), bflo((unsigned)(wc >> 32)), bfhi((unsigned)(wc >> 32))};
        const f32x4 y = (a * e0 + bq * e1 + cq * e2) * (inv * F8S_Y);
        *(GAS unsigned*)(YA8 + (size_t)m * YW + j * 128 + 4 * d4) = pk4_fp8(y[0], y[1], y[2], y[3]);
    }
}

struct Args { Ptrs p; int ph_lo, ph_hi; };
__global__ void __launch_bounds__(NWAVES * 64, 2) fwd_kernel(Args args) {
    extern __shared__ __attribute__((aligned(16))) unsigned char lds[];
    Frame F;
    F.lds = (LAS unsigned char*)lds;
    F.MISC = (volatile LAS unsigned*)(F.lds + MISC_OFF);
    F.tid = threadIdx.x; F.lane = F.tid & 63; F.wave = __builtin_amdgcn_readfirstlane(F.tid >> 6);
    F.bid = blockIdx.x; F.G = gridDim.x; { const int bx = blockIdx.x; F.vcu = (F.G % 8 == 0) ? (bx % 8) * (F.G / 8) + bx / 8 : bx; }
    for (int u = F.tid; u < (LDS_BYTES - LDSCTL_OFF) / 4; u += NWAVES * 64) ((LAS unsigned*)(F.lds + LDSCTL_OFF))[u] = 0u;
    __syncthreads();
    if (F.tid == 0) {
#pragma unroll
        for (int i = 0; i < PT_N; ++i) ((LAS unsigned long long*)(F.lds + LDSCTL_OFF))[i] = (unsigned long long)args.p.p[i]; }
    __syncthreads();
    F.ctl = (gu32*)(ldptr(F, PT_WS) + WS_CTL);
    if (!MK_PER_PHASE) (void)xcd_barrier_post((unsigned*)(F.ctl + CW_BAR), F.MISC + 8);
#define GRID_BAR() do { if (MK_PER_PHASE) { if (F.tid == 0) __hip_atomic_store((gu32*)(ldptr(F, PT_WS) + WS_CTL) + CW_TMO, 0xBADBA0u, RLX_AGENT); } else { XcdBarrier bar_; bar_.bar = (unsigned*)((gu32*)(ldptr(F, PT_WS) + WS_CTL) + CW_BAR); bar_.x = xb_xcc_id(); bar_.st = (volatile LAS unsigned*)(F.lds + MISC_OFF) + 8; xcd_barrier(bar_); } } while (0)
#if MK_PER_PHASE
    const int lo = args.ph_lo, hi = args.ph_hi;
#else
    constexpr int lo = 0, hi = N_PHASES;
#endif
#define IN(k) (lo <= (k) && (k) < hi)
#define SEAM(k) do { if (IN((k) + 1)) GRID_BAR(); } while (0)
#define WSP(T, off) ((GAS T*)(ldptr(F, PT_WS) + (off)))
#define INP(T, i) ((GAS const T*)ldptr(F, (i)))
#define PHASE_IDS() int bid = blockIdx.x; asm volatile("" : "+s"(bid)); bid = __builtin_amdgcn_readfirstlane(bid); Frame Fp = F; asm volatile("" : "+v"(Fp.tid)); Fp.lane = Fp.tid & 63; Fp.wave = __builtin_amdgcn_readfirstlane(Fp.tid >> 6); asm volatile("" : "+s"(Fp.vcu)); Fp.vcu = __builtin_amdgcn_readfirstlane(Fp.vcu); Fp.bid = bid
#ifndef DBL_MASK
#define DBL_MASK 0
#endif
#define REPS(bit) ((((DBL_MASK) >> (bit)) & 1) + 1)
#define PHASE_BEGIN(k, bit) if (IN(k)) { _Pragma("unroll 1") for (int rep_ = 0; rep_ < REPS(bit); ++rep_) { PHASE_IDS();
#define PHASE_END(k, bit, seam) if (rep_ + 1 < REPS(bit)) GRID_BAR(); } if (seam) SEAM(k); }

    PHASE_BEGIN(0, 0) p0_prologue(Fp); PHASE_END(0, 0, true)

    for (int l = 0; l < DEPTH; ++l) {
        const int g0 = 1 + l * PH_PER_LAYER;
        const size_t wl = WS_W + (size_t)l * LW_BYTES;

        PHASE_BEGIN(g0 + 0, 1)
            pg8::Gemm g{(const bf16*)WSP(bf16, WS_XB), (const bf16*)WSP(bf16, wl + LW_IN), M, IN_COLS, DM / 2};   pg8::StaticOrder S; S.init(M, IN_COLS, F.G, bid); S.nr = IN_FULL_ROUNDS;
            if (l > 0) { pg8::Unit u0; S.next(0, u0); stats_to_lds(Fp, WSP(float, WS_STP2), u0.pm); }
            pg8::EpiIn E{WSP(unsigned char, WS_PROJ), WSP(float, WS_ROPEA), WSP(float, WS_ROPEB), WSP(float, WS_CVEC) + CV_C1IN + l * IN_COLS, WSP(float, WS_CVEC) + CV_C2IN + l * IN_COLS, F.lds, l > 0 ? 1 : 0, WSP(unsigned char, WS_G8)};
            pg8::gemm_phase<pg8::EpiIn, pg8::StaticOrder, true, true, F8_X, F8_WIN>(F.lds + RING_OFF, g, S, E);
        PHASE_END(g0 + 0, 1, true)
        PHASE_BEGIN(g0 + 1, 2)
            { pg8::Gemm g{(const bf16*)WSP(bf16, WS_XB), (const bf16*)WSP(bf16, wl + LW_IN), M, IN_COLS, DM / 2}; pg8::StaticOrder S; S.init(M, IN_COLS, F.G, bid); S.i0 = IN_FULL_ROUNDS;
              pg8::Unit u0;
              if (S.next(0, u0)) {
                  if (l > 0) stats_to_lds(Fp, WSP(float, WS_STP2), u0.pm);
                  pg8::EpiIn E{WSP(unsigned char, WS_PROJ), WSP(float, WS_ROPEA), WSP(float, WS_ROPEB), WSP(float, WS_CVEC) + CV_C1IN + l * IN_COLS, WSP(float, WS_CVEC) + CV_C2IN + l * IN_COLS, F.lds, l > 0 ? 1 : 0, WSP(unsigned char, WS_G8)};
                  pg8::gemm_phase<pg8::EpiIn, pg8::StaticOrder, true, true, F8_X, F8_WIN>(F.lds + RING_OFF, g, S, E);
                  __syncthreads(); } }
            attn_phase(Fp, WSP(unsigned char, WS_PROJ), WSP(bf16, WS_OG), WSP(float, WS_LSE), INP(float, PT_SINKS) + l * 32, WSP(unsigned char, WS_YA));
        PHASE_END(g0 + 1, 2, true)
        PHASE_BEGIN(g0 + 2, 3) combine_phase(Fp, WSP(bf16, WS_OG), WSP(float, WS_LSE), WSP(unsigned char, WS_YA)); PHASE_END(g0 + 2, 3, true)
        PHASE_BEGIN(g0 + 3, 4)
            pg8::Gemm g{(const bf16*)WSP(bf16, WS_YA), (const bf16*)WSP(bf16, wl + LW_PA), M, DM, YW / 2}; pg8::StaticOrder S; S.init(M, DM, F.G, bid);
            pg8::EpiGate E{WSP(unsigned char, WS_MG), WSP(unsigned char, WS_G8)};
            pg8::gemm_phase<pg8::EpiGate, pg8::StaticOrder, true, true, F8_Y, F8_WPA>(F.lds + RING_OFF, g, S, E);
        PHASE_END(g0 + 3, 4, true)
        PHASE_BEGIN(g0 + 4, 5)
            pg8::Gemm g{(const bf16*)WSP(bf16, WS_MG), (const bf16*)WSP(bf16, wl + LW_OUT), M, DM, DM / 2}; pg8::StaticOrder S; S.init(M, DM, F.G, bid);
            if (l > 0) { pg8::Unit u0; S.next(0, u0); stats_to_lds(Fp, WSP(float, WS_STP2), u0.pm); }
            pg8::EpiResLn<0, true> E{INP(float, PT_X), WSP(unsigned short, WS_HF), INP(float, PT_LN2G) + (l > 0 ? l - 1 : 0) * DM, INP(float, PT_LN2B) + (l > 0 ? l - 1 : 0) * DM, WSP(bf16, WS_XB), WSP(unsigned char, WS_XB), WSP(float, WS_STP1), F.lds, l > 0 ? 1 : 0};
            pg8::gemm_phase<pg8::EpiResLn<0, true>, pg8::StaticOrder, true, true, F8_MG, F8_WOUT>(F.lds + RING_OFF, g, S, E);
        PHASE_END(g0 + 4, 5, true)
        PHASE_BEGIN(g0 + 6, 7)
            pg8::Gemm g{(const bf16*)WSP(bf16, WS_XB), (const bf16*)WSP(bf16, wl + LW_UP), M, UP_COLS, DM}; pg8::StaticOrder S; S.init(M, UP_COLS, F.G, bid);
            { pg8::Unit u0; S.next(0, u0); stats_to_lds(Fp, WSP(float, WS_STP1), u0.pm); }
            pg8::EpiConv E{WSP(bf16, WS_HA), WSP(float, WS_CVEC) + CV_C1UP + l * UP_COLS, WSP(float, WS_CVEC) + CV_C2UP + l * UP_COLS, INP(float, PT_CW) + (size_t)l * 3 * UP_COLS, INP(float, PT_CB) + (size_t)l * UP_COLS, WSP(float, WS_SBL), WSP(float, WS_SBF), F.lds};
            pg8::gemm_phase<pg8::EpiConv, pg8::StaticOrder, true, true, 0, 0, true>(F.lds + RING_OFF, g, S, E);
        PHASE_END(g0 + 6, 7, true)
        PHASE_BEGIN(g0 + 8, 9)
            pg8::Gemm g{(const bf16*)WSP(bf16, WS_HA), (const bf16*)WSP(bf16, wl + LW_DN), M, DM, DFF}; pg8::StaticOrder S; S.init(M, DM, F.G, bid);
            { pg8::Unit u0; S.next(0, u0); conv_fixup(Fp, u0.pm, WSP(float, WS_SBL), WSP(float, WS_SBF), INP(float, PT_CW) + (size_t)l * 3 * UP_COLS, INP(float, PT_CB) + (size_t)l * UP_COLS, WSP(bf16, WS_HA)); stats_to_lds(Fp, WSP(float, WS_STP1), u0.pm); }
            pg8::EpiResLn<1, false> E{INP(float, PT_X), WSP(unsigned short, WS_HF), INP(float, PT_LN1G) + l * DM, INP(float, PT_LN1B) + l * DM, WSP(bf16, WS_XB), WSP(unsigned char, WS_XB), WSP(float, WS_STP2), F.lds, 1};
            pg8::gemm_phase<pg8::EpiResLn<1, false>, pg8::StaticOrder, true, true>(F.lds + RING_OFF, g, S, E);
        PHASE_END(g0 + 8, 9, true)
    }
    PHASE_BEGIN(N_PHASES - 1, 10) ln_final_phase(Fp, WSP(unsigned short, WS_HF), INP(float, PT_LN2G) + (DEPTH - 1) * DM, INP(float, PT_LN2B) + (DEPTH - 1) * DM, (GAS float*)ldptr(F, PT_OUT)); PHASE_END(N_PHASES - 1, 10, false)
#undef IN
#undef SEAM
#undef GRID_BAR
#undef WSP
#undef INP
#undef PHASE_IDS
#undef PHASE_BEGIN
#undef PHASE_END
}

extern "C" void kernel_launch(void* const* d_in, const int* in_sizes, int n_in, void* d_out, int out_size, void* d_ws, size_t ws_size, hipStream_t stream) {
    static int grid = 0;
    if (grid == 0) {
        if (n_in != 15 || in_sizes[0] != M * DM || out_size != M * DM || ws_size < WS_END) { fprintf(stderr, "kernel_launch: shape/workspace mismatch (n_in %d, in0 %d, out %d, ws %zu, need %zu); nothing launched\n", n_in, n_in > 0 ? in_sizes[0] : -1, out_size, ws_size, (size_t)WS_END); grid = -1; return; }
        int dev = 0, cus = 0, per_cu = 0;
        if (hipGetDevice(&dev) != hipSuccess || hipDeviceGetAttribute(&cus, hipDeviceAttributeMultiprocessorCount, dev) != hipSuccess) { fprintf(stderr, "kernel_launch: hipGetDevice / hipDeviceGetAttribute failed; nothing launched\n"); grid = -1; return; }
        if (hipFuncSetAttribute((const void*)fwd_kernel, hipFuncAttributeMaxDynamicSharedMemorySize, LDS_BYTES) != hipSuccess) { fprintf(stderr, "kernel_launch: hipFuncSetAttribute failed; nothing launched\n"); grid = -1; return; }
        if (hipOccupancyMaxActiveBlocksPerMultiprocessor(&per_cu, (const void*)fwd_kernel, NWAVES * 64, LDS_BYTES) != hipSuccess || per_cu < 1)
            fprintf(stderr, "kernel_launch: note: the occupancy query reports %d workgroups per CU\n", per_cu);
        (void)hipGetLastError();
        grid = 256;
        if (cus != 256) fprintf(stderr, "kernel_launch: note: %d CUs reported; this kernel is built for the 256-CU MI355X (grid stays 256)\n", cus);
    }
    if (grid < 0) return;
    if (hipMemsetAsync((char*)d_ws + WS_CTL, 0, CTL_ZERO_BYTES, stream) != hipSuccess) { fprintf(stderr, "kernel_launch: hipMemsetAsync of the control words failed; nothing launched\n"); return; }
    Args a{};
    a.p.p[PT_X] = d_in[0]; a.p.p[PT_POS] = d_in[1]; a.p.p[PT_WIN] = d_in[2]; a.p.p[PT_WPA] = d_in[3]; a.p.p[PT_WPB] = d_in[4]; a.p.p[PT_WOUT] = d_in[5]; a.p.p[PT_SINKS] = d_in[6];
    a.p.p[PT_LN1G] = d_in[7]; a.p.p[PT_LN1B] = d_in[8]; a.p.p[PT_WUP] = d_in[9]; a.p.p[PT_CW] = d_in[10]; a.p.p[PT_CB] = d_in[11]; a.p.p[PT_WDN] = d_in[12]; a.p.p[PT_LN2G] = d_in[13]; a.p.p[PT_LN2B] = d_in[14];
    a.p.p[PT_OUT] = d_out; a.p.p[PT_WS] = d_ws;
#if MK_PER_PHASE
    for (int ph = 0; ph < N_PHASES; ++ph) { a.ph_lo = ph; a.ph_hi = ph + 1; hipLaunchKernelGGL(fwd_kernel, dim3(grid), dim3(NWAVES * 64), LDS_BYTES, stream, a); }
#else
    a.ph_lo = 0; a.ph_hi = N_PHASES;
    hipLaunchKernelGGL(fwd_kernel, dim3(grid), dim3(NWAVES * 64), LDS_BYTES, stream, a);
#endif
    const hipError_t le = hipPeekAtLastError();
    if (le != hipSuccess) fprintf(stderr, "kernel_launch: launch failed: %s (grid %d x %d threads, %d B LDS)\n", hipGetErrorName(le), grid, NWAVES * 64, LDS_BYTES);
}
```

```cpp
#include <hip/hip_runtime.h>
#include <cstdio>
#include <cstdint>

constexpr int BATCH = 2, SEQ = 4096, DM = 4096, DEPTH = 4;
constexpr int M = BATCH * SEQ;
constexpr int IN_COLS = 15360;
constexpr int KA_OFF = 1536, VA_OFF = 3072, QB_OFF = 4608, KB_OFF = 6656, VB_OFF = 6912, G_OFF = 7168;
constexpr int A_OUT = 512, B_QW = 2048, DFF = 8192, UP_COLS = 16384;
constexpr int YW = A_OUT + B_QW;
constexpr float LN_EPS = 1e-5f;
constexpr float DN_ALPHA = 1.6817928305074290f;
constexpr float LOG2E = 1.4426950408889634f;
constexpr float QSCALE_A = 0.08838834764831845f * LOG2E;
constexpr float QSCALE_B = 0.125f * LOG2E;
constexpr int F8_X = 123  , F8_WIN = 117  , F8_Y = 122  , F8_WPA = 117  , F8_WPB = 117  , F8_MG = 118  , F8_WOUT = 116  ;
constexpr float F8S_X = 16.f, F8S_WIN = 1024.f, F8S_Y = 32.f, F8S_WPA = 1024.f, F8S_WPB = 1024.f, F8S_MG = 512.f, F8S_WOUT = 2048.f;
constexpr int QW = 7168;
constexpr float F8S_Q = 32.f, F8S_K = 16.f, F8S_V = 16.f;
constexpr float F8S_G = 256.f;
#define MK_PER_PHASE 0
#define DBL_MASK 0
namespace pg8 {
#define PG8_LAS __attribute__((address_space(3)))
typedef unsigned short bf16_t;
typedef short bf16x8 __attribute__((ext_vector_type(8)));
typedef float f32x4 __attribute__((ext_vector_type(4)));
typedef unsigned u32x4 __attribute__((ext_vector_type(4)));
constexpr int BM = 256, BK = 64, HALF = 128, HTB = HALF * BK * 2  , STAGE_BYTES = 8 * HTB, NXCD = 8, WGM = 8;

__host__ __device__ __forceinline__ int lds_byte(int r, int c) { const int st = (r >> 4) * 2 + (c >> 5), rr = r & 15, cc = c & 31, ob = rr * 64 + cc * 2; return st * 1024 + (ob ^ (((ob >> 9) & 1) << 5)); }
__host__ __device__ __forceinline__ void stage_rc(int b, int& R, int& C) { const int st = b / 1024, sb = b % 1024, swz = sb ^ (((sb >> 9) & 1) << 5); R = (st >> 1) * 16 + swz / 64; C = (st & 1) * 32 + (swz % 64) / 2; }
__host__ __device__ __forceinline__ int perm32(int rho) { const int n = rho >> 4, i = rho & 15; return 8 * (i >> 2) + 4 * n + (i & 3); }

struct Unit { int pm, pn; };
struct Gemm { const bf16_t* A; const bf16_t* Bt; int M, N, K; };

struct StaticOrder {
    int nM, nN, nwg, G, c, i0, nr;
    __host__ __device__ void init(int M, int N, int G_, int c_) { nM = M / BM; nN = N / BM; nwg = nM * nN; G = G_; c = c_; i0 = 0; nr = 1 << 20; }
    __host__ __device__ bool next(int i, Unit& u) const {
        if (i >= nr) return false;
        const long L = (long)(i + i0) * G + c; if (L >= nwg) return false;
        int wgid = (int)L; { const int q = nwg / NXCD, r = nwg % NXCD, xcd = wgid % NXCD, off = wgid / NXCD; wgid = (xcd < r ? xcd * (q + 1) : r * (q + 1) + (xcd - r) * q) + off; }
        const int nig = WGM * nN, gid = wgid / nig, fm = gid * WGM, gsz = (nM - fm) < WGM ? (nM - fm) : WGM;
        u.pm = fm + ((wgid % nig) % gsz); u.pn = (wgid % nig) / gsz; return true;
    }
    __device__ __forceinline__ void a_ready(const Unit&) const {}
    __device__ __forceinline__ void done(const Unit&) const {}
};
typedef float f32x2 __attribute__((ext_vector_type(2)));
typedef __bf16 pg8_bf16x2 __attribute__((ext_vector_type(2)));
__device__ __forceinline__ unsigned cvt_pk_bf16(float lo, float hi) { f32x2 v = {lo, hi}; pg8_bf16x2 b = __builtin_convertvector(v, pg8_bf16x2); return __builtin_bit_cast(unsigned, b); }
__device__ __forceinline__ unsigned pk4_fp8(float a, float b, float c, float d) {
    a = __builtin_fminf(__builtin_fmaxf(a, -448.f), 448.f); b = __builtin_fminf(__builtin_fmaxf(b, -448.f), 448.f); c = __builtin_fminf(__builtin_fmaxf(c, -448.f), 448.f); d = __builtin_fminf(__builtin_fmaxf(d, -448.f), 448.f);
    int w = 0; w = __builtin_amdgcn_cvt_pk_fp8_f32(a, b, w, false); w = __builtin_amdgcn_cvt_pk_fp8_f32(c, d, w, true); return (unsigned)w; }
__device__ __forceinline__ float lx(float v, int mask, int lane) { return __int_as_float(__builtin_amdgcn_ds_bpermute((lane ^ mask) << 2, __float_as_int(v))); }
__device__ __forceinline__ float lup16(float v, int lane) { return __int_as_float(__builtin_amdgcn_ds_bpermute(((lane & 15) ? lane - 1 : lane) << 2, __float_as_int(v))); }
typedef float f32x4_c __attribute__((ext_vector_type(4)));
__device__ __forceinline__ void unpk8_fp8(unsigned lo, unsigned hi, f32x4_c& a, f32x4_c& b) {
    const f32x2 a0 = __builtin_amdgcn_cvt_pk_f32_fp8((int)lo, false), a1 = __builtin_amdgcn_cvt_pk_f32_fp8((int)lo, true), b0 = __builtin_amdgcn_cvt_pk_f32_fp8((int)hi, false), b1 = __builtin_amdgcn_cvt_pk_f32_fp8((int)hi, true);
    a = (f32x4_c){a0[0], a0[1], a1[0], a1[1]}; b = (f32x4_c){b0[0], b0[1], b1[0], b1[1]}; }
#define PG8_GAS __attribute__((address_space(1)))
__device__ __forceinline__ void st8(PG8_GAS bf16_t* p, const f32x4 v0, const f32x4 v1) {
    u32x4 w; w.x = cvt_pk_bf16(v0[0], v0[1]); w.y = cvt_pk_bf16(v0[2], v0[3]); w.z = cvt_pk_bf16(v1[0], v1[1]); w.w = cvt_pk_bf16(v1[2], v1[3]);
    *(PG8_GAS u32x4*)p = w;
}
__device__ __forceinline__ f32x4 bf_lo4(unsigned a, unsigned b) { return (f32x4){__uint_as_float(a << 16), __uint_as_float(a & 0xffff0000u), __uint_as_float(b << 16), __uint_as_float(b & 0xffff0000u)}; }
__device__ __forceinline__ float sigmoidf_fast(float x) { return __builtin_amdgcn_rcpf(1.0f + __builtin_amdgcn_exp2f(-x * LOG2E)); }

typedef float f32x2s __attribute__((ext_vector_type(2)));
constexpr int ST_OFF = 131072;
struct LnCols { f32x4 a0, a1, b0, b1; };
__device__ __forceinline__ LnCols ln_cols(PG8_GAS const float* c1, PG8_GAS const float* c2, int col) {
    LnCols c; c.a0 = *(PG8_GAS const f32x4*)(c1 + col); c.a1 = *(PG8_GAS const f32x4*)(c1 + col + 4); c.b0 = *(PG8_GAS const f32x4*)(c2 + col); c.b1 = *(PG8_GAS const f32x4*)(c2 + col + 4); return c; }
__device__ __forceinline__ f32x4 fma4(const f32x4 a, const f32x4 b, const f32x4 c) { return __builtin_elementwise_fma(a, b, c); }
__device__ __forceinline__ void ln_fix8(f32x4& v0, f32x4& v1, const f32x2s st, const LnCols& c) { const f32x4 nm = (f32x4){-st.x, -st.x, -st.x, -st.x}, rs = (f32x4){st.y, st.y, st.y, st.y};
    v0 = fma4(fma4(c.a0, nm, v0), rs, c.b0); v1 = fma4(fma4(c.a1, nm, v1), rs, c.b1); }

constexpr int HALO_OFF = ST_OFF + 2048;
constexpr int CW_OFF = 147456;
constexpr int GB_OFF = ST_OFF + 4096;
__device__ __forceinline__ float silu_mul(float g, float v) { return g * __builtin_amdgcn_rcpf(1.0f + __builtin_amdgcn_exp2f(-g * LOG2E)) * v; }
struct EpiConv {
    static constexpr bool PERM = true, AFTER_DRAIN = false; static constexpr int MID_T = -1;
    PG8_GAS bf16_t* HA; PG8_GAS const float* c1; PG8_GAS const float* c2; PG8_GAS const float* cw; PG8_GAS const float* cb; PG8_GAS float* SBL; PG8_GAS float* SBF; PG8_LAS unsigned char* lds;
    __device__ __forceinline__ void operator()(const f32x4 (&acc_)[2][2][4][2], const Unit& u, int wr, int wc, int fr, int fq) const {
        f32x4 (&acc)[2][2][4][2] = const_cast<f32x4 (&)[2][2][4][2]>(acc_);
        const int col0 = u.pn * BM + wc * 32 + 8 * fq, ch0 = u.pn * HALF + wc * 32 + 8 * fq, tok0 = 8 * (16 * wr + fr);
        const PG8_LAS f32x2s* ST = (const PG8_LAS f32x2s*)(lds + ST_OFF);
        PG8_LAS f32x4* HL = (PG8_LAS f32x4*)(lds + HALO_OFF) + (wc * 4 + fq) * 8;
        { const int t_ = (wr * 4 + wc) * 64 + fq * 16 + fr;
#pragma unroll
          for (int j = 0; j < 2; ++j) { const int sg = (t_ >> 7) + 4 * j, e = t_ & 127; const float* src = (sg < 6 ? (const float*)cw + (size_t)(sg >> 1) * UP_COLS : (const float*)cb) + (sg & 1) * DFF + u.pn * HALF + e;
              __builtin_amdgcn_global_load_lds((const unsigned*)src, (PG8_LAS unsigned*)(lds + CW_OFF + sg * 512 + (t_ & 64) * 4), 4, 0, 0); } }
        const PG8_LAS float* CWL = (const PG8_LAS float*)(lds + CW_OFF) + wc * 32 + 8 * fq;
        { const LnCols lg = ln_cols(c1, c2, col0), lv = ln_cols(c1, c2, col0 + HALF);
#pragma unroll
          for (int ai = 0; ai < 2; ++ai)
#pragma unroll
            for (int m = 0; m < 4; ++m) { const f32x2s st = ST[tok0 + 4 * ai + m]; ln_fix8(acc[ai][0][m][0], acc[ai][0][m][1], st, lg); ln_fix8(acc[ai][1][m][0], acc[ai][1][m][1], st, lv); } }
#define UG(s_, n_) acc[(s_) >> 2][0][(s_) & 3][n_]
#define UV(s_, n_) acc[(s_) >> 2][1][(s_) & 3][n_]
        asm volatile("" ::: "memory");
        if (wr == 0 && fr == 15) {
#pragma unroll
            for (int n = 0; n < 2; ++n) { HL[0 + 2 * n] = UG(6, n); HL[1 + 2 * n] = UG(7, n); HL[4 + 2 * n] = UV(6, n); HL[5 + 2 * n] = UV(7, n); } }
        if (wr == 1 && fr == 15) { PG8_GAS float* q = SBL + (size_t)u.pm * 2 * UP_COLS + ch0;
#pragma unroll
            for (int n = 0; n < 2; ++n) { *(PG8_GAS f32x4*)(q + 4 * n) = UG(6, n); *(PG8_GAS f32x4*)(q + UP_COLS + 4 * n) = UG(7, n); *(PG8_GAS f32x4*)(q + DFF + 4 * n) = UV(6, n); *(PG8_GAS f32x4*)(q + UP_COLS + DFF + 4 * n) = UV(7, n); } }
        if (wr == 0 && fr == 0) { PG8_GAS float* q = SBF + (size_t)u.pm * 2 * UP_COLS + ch0;
#pragma unroll
            for (int n = 0; n < 2; ++n) { *(PG8_GAS f32x4*)(q + 4 * n) = UG(0, n); *(PG8_GAS f32x4*)(q + UP_COLS + 4 * n) = UG(1, n); *(PG8_GAS f32x4*)(q + DFF + 4 * n) = UV(0, n); *(PG8_GAS f32x4*)(q + UP_COLS + DFF + 4 * n) = UV(1, n); } }
        asm volatile("s_waitcnt vmcnt(0) lgkmcnt(0)" ::: "memory"); __builtin_amdgcn_s_barrier(); asm volatile("" ::: "memory");
        PG8_GAS bf16_t* op = HA + (size_t)(u.pm * BM + tok0) * DFF + ch0; const int ln_ = fq * 16 + fr;
#pragma unroll
        for (int n = 0; n < 2; ++n) {
            f32x4 wg[3], wv[3];
#pragma unroll
            for (int i = 0; i < 3; ++i) { wg[i] = *(const PG8_LAS f32x4*)(CWL + (2 * i) * 128 + 4 * n); wv[i] = *(const PG8_LAS f32x4*)(CWL + (2 * i + 1) * 128 + 4 * n); }
            const f32x4 bg = *(const PG8_LAS f32x4*)(CWL + 6 * 128 + 4 * n), bv = *(const PG8_LAS f32x4*)(CWL + 7 * 128 + 4 * n);
            f32x4 g1, g2, v1, v2;
#pragma unroll
            for (int j = 0; j < 4; ++j) { g1[j] = lup16(UG(7, n)[j], ln_); g2[j] = lup16(UG(6, n)[j], ln_); v1[j] = lup16(UV(7, n)[j], ln_); v2[j] = lup16(UV(6, n)[j], ln_); }
            if (fr == 0) { if (wr == 1) { g2 = HL[0 + 2 * n]; g1 = HL[1 + 2 * n]; v2 = HL[4 + 2 * n]; v1 = HL[5 + 2 * n]; }
                           else { g1 = (f32x4){0.f, 0.f, 0.f, 0.f}; g2 = g1; v1 = g1; v2 = g1; } }
            unsigned hp[8][2];
#pragma unroll
            for (int sI = 0; sI < 8; ++sI) {
                const f32x4 gm2 = sI >= 2 ? UG(sI >= 2 ? sI - 2 : 0, n) : (sI == 1 ? g1 : g2), gm1 = sI >= 1 ? UG(sI >= 1 ? sI - 1 : 0, n) : g1;
                const f32x4 vm2 = sI >= 2 ? UV(sI >= 2 ? sI - 2 : 0, n) : (sI == 1 ? v1 : v2), vm1 = sI >= 1 ? UV(sI >= 1 ? sI - 1 : 0, n) : v1;
                const f32x4 og = fma4(wg[2], UG(sI, n), fma4(wg[1], gm1, fma4(wg[0], gm2, bg))), ov = fma4(wv[2], UV(sI, n), fma4(wv[1], vm1, fma4(wv[0], vm2, bv)));
                hp[sI][0] = cvt_pk_bf16(silu_mul(og[0], ov[0]), silu_mul(og[1], ov[1])); hp[sI][1] = cvt_pk_bf16(silu_mul(og[2], ov[2]), silu_mul(og[3], ov[3])); }
#pragma unroll
            for (int sI = 0; sI < 8; ++sI) { typedef unsigned u32x2_ __attribute__((ext_vector_type(2))); u32x2_ w; w.x = hp[sI][0]; w.y = hp[sI][1]; *(PG8_GAS u32x2_*)(op + (size_t)sI * DFF + 4 * n) = w; }
        }
#undef UG
#undef UV
    }
};

struct EpiIn {
    static constexpr bool PERM = true, AFTER_DRAIN = false; static constexpr int MID_T = -1;
    PG8_GAS unsigned char* O; PG8_GAS const float* ropeA; PG8_GAS const float* ropeB;
    PG8_GAS const float* c1; PG8_GAS const float* c2; PG8_LAS const unsigned char* lds; int ln;
    PG8_GAS unsigned char* G8;
    static __device__ __forceinline__ void st8q(PG8_GAS unsigned char* p, const f32x4 a, const f32x4 b) { typedef unsigned u32x2_ __attribute__((ext_vector_type(2))); u32x2_ w; w.x = pk4_fp8(a[0], a[1], a[2], a[3]); w.y = pk4_fp8(b[0], b[1], b[2], b[3]); *(PG8_GAS u32x2_*)p = w; }
    __device__ __forceinline__ void operator()(const f32x4 (&acc_)[2][2][4][2], const Unit& u, int wr, int wc, int fr, int fq) const {
        const int row0 = u.pm * BM + wr * 64 + fr, pn = u.pn;
        PG8_GAS unsigned char* base = O + (size_t)row0 * QW + pn * BM + wc * 32 + 8 * fq;
        f32x4 (&acc)[2][2][4][2] = const_cast<f32x4 (&)[2][2][4][2]>(acc_);
        if (ln) { const PG8_LAS f32x2s* ST = (const PG8_LAS f32x2s*)(lds + ST_OFF); const int col0 = pn * BM + wc * 32 + 8 * fq;
          LnCols lc0 = ln_cols(c1, c2, col0), lc1 = ln_cols(c1, c2, col0 + HALF);
          const float ks = pn >= 28 ? -LOG2E : 1.0f;
          lc0.b0 *= ks; lc0.b1 *= ks; lc1.b0 *= ks; lc1.b1 *= ks;
#pragma unroll
          for (int ai = 0; ai < 2; ++ai)
#pragma unroll
            for (int m = 0; m < 4; ++m) { f32x2s st = ST[ai * HALF + wr * 64 + m * 16 + fr]; st.y *= ks; ln_fix8(acc[ai][0][m][0], acc[ai][0][m][1], st, lc0); ln_fix8(acc[ai][1][m][0], acc[ai][1][m][1], st, lc1); } }
        if (pn >= 28) {
            PG8_GAS unsigned char* gb8 = G8 + (size_t)row0 * (2 * DM) + (pn - 28) * BM + wc * 32 + 8 * fq;
#pragma unroll
            for (int ai = 0; ai < 2; ++ai)
#pragma unroll
                for (int m = 0; m < 4; ++m) { PG8_GAS unsigned char* rowp = gb8 + (size_t)(ai * HALF + m * 16) * (2 * DM);
#pragma unroll
                    for (int bj = 0; bj < 2; ++bj) { f32x4 v0 = acc[ai][bj][m][0], v1 = acc[ai][bj][m][1];
                        if (!ln) { v0 *= -LOG2E; v1 *= -LOG2E; }
#pragma unroll
                        for (int j = 0; j < 4; ++j) { v0[j] = __builtin_amdgcn_exp2f(v0[j]); v1[j] = __builtin_amdgcn_exp2f(v1[j]); }
                        typedef unsigned u32x2_ __attribute__((ext_vector_type(2))); u32x2_ w; w.x = pk4_fp8(v0[0], v0[1], v0[2], v0[3]); w.y = pk4_fp8(v1[0], v1[1], v1[2], v1[3]);
                        *(PG8_GAS u32x2_*)(rowp + bj * HALF) = w; } }
        } else if (pn < 12) {
            const float sc = pn < 6 ? QSCALE_A * F8S_Q : F8S_K;
#pragma unroll
            for (int ai = 0; ai < 2; ++ai) {
                f32x4 cc[4], ss[4];
#pragma unroll
                for (int m = 0; m < 4; ++m) { const int r = row0 + ai * HALF + m * 16; cc[m] = (f32x4){1.f, 1.f, 1.f, 1.f}; ss[m] = (f32x4){0.f, 0.f, 0.f, 0.f};
                    if (wc == 0) { cc[m] = *(PG8_GAS const f32x4*)(ropeA + (size_t)r * 32 + 4 * fq); ss[m] = *(PG8_GAS const f32x4*)(ropeA + (size_t)r * 32 + 16 + 4 * fq); } }
#pragma unroll
                for (int m = 0; m < 4; ++m) { PG8_GAS unsigned char* rowp = base + (size_t)(ai * HALF + m * 16) * QW; const f32x4 c = cc[m], s = ss[m];
#pragma unroll
                    for (int bj = 0; bj < 2; ++bj) { const f32x4 v0 = acc[ai][bj][m][0], v1 = acc[ai][bj][m][1];
                        const f32x4 n0 = (v0 * c - v1 * s) * sc, n1 = (v1 * c + v0 * s) * sc;
                        st8q(rowp + bj * HALF, n0, n1); } } }
        } else if (pn >= 18 && pn < 27) {
            const float sc = pn < 26 ? QSCALE_B * F8S_Q : F8S_K;
            const bool rotl = ((wc & 1) == 0) && (fq < 2);
#pragma unroll
            for (int ai = 0; ai < 2; ++ai) {
                f32x4 cc[4], ss[4];
#pragma unroll
                for (int m = 0; m < 4; ++m) { const int r = row0 + ai * HALF + m * 16;
                    cc[m] = *(PG8_GAS const f32x4*)(ropeB + (size_t)r * 16 + 4 * (fq & 1)); ss[m] = *(PG8_GAS const f32x4*)(ropeB + (size_t)r * 16 + 8 + 4 * (fq & 1));
                    if (!rotl) { cc[m] = (f32x4){1.f, 1.f, 1.f, 1.f}; ss[m] = (f32x4){0.f, 0.f, 0.f, 0.f}; } }
#pragma unroll
                for (int m = 0; m < 4; ++m) { PG8_GAS unsigned char* rowp = base + (size_t)(ai * HALF + m * 16) * QW; const f32x4 c = cc[m], s = ss[m];
#pragma unroll
                    for (int bj = 0; bj < 2; ++bj) { const f32x4 v0 = acc[ai][bj][m][0], v1 = acc[ai][bj][m][1];
                        const f32x4 n0 = (v0 * c - v1 * s) * sc, n1 = (v1 * c + v0 * s) * sc;
                        st8q(rowp + bj * HALF, n0, n1); } } }
        } else {
#pragma unroll
            for (int ai = 0; ai < 2; ++ai)
#pragma unroll
                for (int m = 0; m < 4; ++m) { PG8_GAS unsigned char* rowp = base + (size_t)(ai * HALF + m * 16) * QW;
#pragma unroll
                    for (int bj = 0; bj < 2; ++bj) st8q(rowp + bj * HALF, acc[ai][bj][m][0] * F8S_V, acc[ai][bj][m][1] * F8S_V); }
        }
    }
};

struct EpiGate {
    static constexpr bool PERM = true, AFTER_DRAIN = false; static constexpr int MID_T = 2;
    PG8_GAS unsigned char* MG8; PG8_GAS const unsigned char* G8;
    typedef unsigned u32x2_ __attribute__((ext_vector_type(2)));
    __device__ __forceinline__ void mid(f32x4 (&acc)[2][2][4][2], const Unit& u, int wr, int wc, int fr, int fq) const {
        const int row0 = u.pm * BM + wr * 64 + fr, col0 = u.pn * BM + wc * 32 + 8 * fq;
        u32x2_ ga[2][4][2], gb[2][4][2];
#pragma unroll
        for (int ai = 0; ai < 2; ++ai)
#pragma unroll
            for (int m = 0; m < 4; ++m) { const size_t r = (size_t)(row0 + ai * HALF + m * 16) * (2 * DM);
#pragma unroll
                for (int bj = 0; bj < 2; ++bj) { const int c = col0 + bj * HALF; ga[ai][m][bj] = *(PG8_GAS const u32x2_*)(G8 + r + c); gb[ai][m][bj] = *(PG8_GAS const u32x2_*)(G8 + r + DM + c); } }
#pragma unroll
        for (int ai = 0; ai < 2; ++ai)
#pragma unroll
            for (int m = 0; m < 4; ++m)
#pragma unroll
                for (int bj = 0; bj < 2; ++bj) { f32x4 a0, a1, b0, b1; unpk8_fp8(ga[ai][m][bj].x, ga[ai][m][bj].y, a0, a1); unpk8_fp8(gb[ai][m][bj].x, gb[ai][m][bj].y, b0, b1);
#pragma unroll
                    for (int j = 0; j < 4; ++j) { acc[ai][bj][m][0][j] *= (1.0f + b0[j]) * __builtin_amdgcn_rcpf(1.0f + a0[j]); acc[ai][bj][m][1][j] *= (1.0f + b1[j]) * __builtin_amdgcn_rcpf(1.0f + a1[j]); } }
    }
    __device__ __forceinline__ void operator()(const f32x4 (&acc)[2][2][4][2], const Unit& u, int wr, int wc, int fr, int fq) const {
        const int row0 = u.pm * BM + wr * 64 + fr, col0 = u.pn * BM + wc * 32 + 8 * fq;
        u32x2_ gb[2][4][2];
#pragma unroll
        for (int ai = 0; ai < 2; ++ai)
#pragma unroll
            for (int m = 0; m < 4; ++m) { const size_t r = (size_t)(row0 + ai * HALF + m * 16) * (2 * DM);
#pragma unroll
                for (int bj = 0; bj < 2; ++bj) gb[ai][m][bj] = *(PG8_GAS const u32x2_*)(G8 + r + DM + col0 + bj * HALF); }
#pragma unroll
        for (int ai = 0; ai < 2; ++ai)
#pragma unroll
            for (int m = 0; m < 4; ++m) { const size_t r = (size_t)(row0 + ai * HALF + m * 16);
#pragma unroll
                for (int bj = 0; bj < 2; ++bj) { const int c = col0 + bj * HALF; f32x4 b0, b1; unpk8_fp8(gb[ai][m][bj].x, gb[ai][m][bj].y, b0, b1);
                    f32x4 v0, v1;
#pragma unroll
                    for (int j = 0; j < 4; ++j) { v0[j] = acc[ai][bj][m][0][j] * __builtin_amdgcn_rcpf((1.0f + b0[j]) * (1.0f / F8S_MG)); v1[j] = acc[ai][bj][m][1][j] * __builtin_amdgcn_rcpf((1.0f + b1[j]) * (1.0f / F8S_MG)); }
                    u32x2_ w; w.x = pk4_fp8(v0[0], v0[1], v0[2], v0[3]); w.y = pk4_fp8(v1[0], v1[1], v1[2], v1[3]);
                    *(PG8_GAS u32x2_*)(MG8 + r * DM + c) = w; } }
    }
};

typedef _Float16 f16x2_ __attribute__((ext_vector_type(2)));
__device__ __forceinline__ unsigned pk_f16(float lo, float hi) { f32x2 v = {lo, hi}; f16x2_ h = __builtin_convertvector(v, f16x2_); return __builtin_bit_cast(unsigned, h); }
__device__ __forceinline__ void unpk8_f16(const u32x4 w, f32x4& a, f32x4& b) {
    const unsigned wx = w.x, wy = w.y, wz = w.z, ww = w.w;
    const f16x2_ h0 = __builtin_bit_cast(f16x2_, wx), h1 = __builtin_bit_cast(f16x2_, wy), h2 = __builtin_bit_cast(f16x2_, wz), h3 = __builtin_bit_cast(f16x2_, ww);
    a = (f32x4){(float)h0[0], (float)h0[1], (float)h1[0], (float)h1[1]}; b = (f32x4){(float)h2[0], (float)h2[1], (float)h3[0], (float)h3[1]}; }
template <int OPK, bool XIN  > struct EpiResLn {
    static constexpr bool PERM = true, AFTER_DRAIN = false; static constexpr int MID_T = -1;
    PG8_GAS const float* xin; PG8_GAS unsigned short* H; PG8_GAS const float* g; PG8_GAS const float* b; PG8_GAS bf16_t* OB; PG8_GAS unsigned char* O8; PG8_GAS float* STP; PG8_LAS const unsigned char* lds; int lnres;
    __device__ __forceinline__ void operator()(const f32x4 (&acc)[2][2][4][2], const Unit& u, int wr, int wc, int fr, int fq) const {
        const int row0 = u.pm * BM + wr * 64 + fr, col0 = u.pn * BM + wc * 32 + 8 * fq;
        const PG8_LAS f32x2s* ST = (const PG8_LAS f32x2s*)(lds + ST_OFF);
        PG8_LAS float* GB = (PG8_LAS float*)(const_cast<PG8_LAS unsigned char*>(lds) + GB_OFF) + (wr * 4 + wc) * 128;
        if (lnres) { const int l5 = (fq * 16 + fr) & 31, hf = (fq * 16 + fr) >> 5, cc = u.pn * BM + hf * HALF + wc * 32 + l5; GB[hf * 32 + l5] = g[cc]; GB[64 + hf * 32 + l5] = b[cc]; }
        asm volatile("s_waitcnt lgkmcnt(0)" ::: "memory");
#define ERL_G(bj, n) (*(const PG8_LAS f32x4*)(GB + (bj) * 32 + 8 * fq + 4 * (n)))
#define ERL_B(bj, n) (*(const PG8_LAS f32x4*)(GB + 64 + (bj) * 32 + 8 * fq + 4 * (n)))
#define ERL_ROW(ai, m, X0, X1) do { const int row = row0 + (ai) * HALF + (m) * 16; const size_t off = (size_t)row * DM + col0; \
            f32x2s st = ST[(ai) * HALF + wr * 64 + (m) * 16 + fr]; if (!lnres) st = (f32x2s){0.f, 1.f}; \
            float sm = 0.f, sq = 0.f; \
            _Pragma("unroll") for (int bj = 0; bj < 2; ++bj) { f32x4 h[2]; \
                _Pragma("unroll") for (int n = 0; n < 2; ++n) { f32x4 x = n ? X1(bj) : X0(bj); if (lnres) x = (x - st.x) * st.y * ERL_G(bj, n) + ERL_B(bj, n); \
                    h[n] = x * DN_ALPHA + acc[ai][bj][m][n]; \
                    sm += (h[n][0] + h[n][1]) + (h[n][2] + h[n][3]); sq += (h[n][0] * h[n][0] + h[n][1] * h[n][1]) + (h[n][2] * h[n][2] + h[n][3] * h[n][3]); } \
                u32x4 hw; hw.x = pk_f16(h[0][0], h[0][1]); hw.y = pk_f16(h[0][2], h[0][3]); hw.z = pk_f16(h[1][0], h[1][1]); hw.w = pk_f16(h[1][2], h[1][3]); \
                *(PG8_GAS u32x4*)(H + off + bj * HALF) = hw; \
                if (OPK == 0) st8(OB + off + bj * HALF, h[0], h[1]); \
                else { typedef unsigned u32x2_ __attribute__((ext_vector_type(2))); u32x2_ w; w.x = pk4_fp8(h[0][0] * F8S_X, h[0][1] * F8S_X, h[0][2] * F8S_X, h[0][3] * F8S_X); w.y = pk4_fp8(h[1][0] * F8S_X, h[1][1] * F8S_X, h[1][2] * F8S_X, h[1][3] * F8S_X); \
                    *(PG8_GAS u32x2_*)(O8 + off + bj * HALF) = w; } } \
            { const int ln_ = fq * 16 + fr; sm += lx(sm, 16, ln_); sq += lx(sq, 16, ln_); sm += lx(sm, 32, ln_); sq += lx(sq, 32, ln_); } \
            if (fq == 0) *(PG8_GAS f32x2s*)(STP + ((size_t)row * 64 + u.pn * 4 + wc) * 2) = (f32x2s){sm, sq}; } while (0)
        if (!XIN || lnres) {
#pragma unroll
            for (int ai = 0; ai < 2; ++ai) {
                u32x4 xw[4][2];
#pragma unroll
                for (int m = 0; m < 4; ++m)
#pragma unroll
                    for (int bj = 0; bj < 2; ++bj) xw[m][bj] = *(PG8_GAS const u32x4*)(H + (size_t)(row0 + ai * HALF + m * 16) * DM + col0 + bj * HALF);
#pragma unroll
                for (int m = 0; m < 4; ++m) { f32x4 xa[2], xb[2];
#pragma unroll
                    for (int bj = 0; bj < 2; ++bj) unpk8_f16(xw[m][bj], xa[bj], xb[bj]);
#define ERL_XA(bj) xa[bj]
#define ERL_XB(bj) xb[bj]
                    ERL_ROW(ai, m, ERL_XA, ERL_XB); __builtin_amdgcn_sched_barrier(0); } }
        } else if constexpr (XIN) {
#pragma unroll
            for (int ai = 0; ai < 2; ++ai)
#pragma unroll
                for (int m = 0; m < 4; ++m) {
                    f32x4 xv[2][2];
#pragma unroll
                    for (int bj = 0; bj < 2; ++bj) { const size_t off = (size_t)(row0 + ai * HALF + m * 16) * DM + col0 + bj * HALF; xv[bj][0] = *(PG8_GAS const f32x4*)(xin + off); xv[bj][1] = *(PG8_GAS const f32x4*)(xin + off + 4); }
#define ERL_YA(bj) xv[bj][0]
#define ERL_YB(bj) xv[bj][1]
                    ERL_ROW(ai, m, ERL_YA, ERL_YB); __builtin_amdgcn_sched_barrier(0); }
        }
#undef ERL_ROW
#undef ERL_G
#undef ERL_B
#undef ERL_XA
#undef ERL_XB
#undef ERL_YA
#undef ERL_YB
    }
};

template <class Epi, class Sched, bool ALIGN_EPI = false, bool SP2 = false, int F8SA = 0, int F8SB = 0, bool ROWPERM = false>
__device__ __forceinline__ void gemm_phase(PG8_LAS unsigned char* lds, const Gemm g, const Sched& S, const Epi& E) {
    int tid_ = threadIdx.x; asm volatile("" : "+v"(tid_));
    const int tid = tid_, wid = __builtin_amdgcn_readfirstlane(tid >> 6), lane = tid & 63, wr = wid >> 2, wc = wid & 3, fr = lane & 15, fq = lane >> 4;
    int K_ = g.K; asm volatile("" : "+s"(K_));
    const int K = K_, nt = K / BK;
    unsigned voffA[2], voffB[2];
#pragma unroll
    for (int i = 0; i < 2; ++i) { int R, C; stage_rc(tid * 16 + i * 8192, R, C); const int Rb = Epi::PERM ? ((R & ~31) + perm32(R & 31)) : R;
        const int Ra = ROWPERM ? 8 * (16 * (R >> 6) + (R & 15)) + ((R >> 4) & 3) : R;
        voffA[i] = (unsigned)(Ra * K + C) * 2u; voffB[i] = (unsigned)(Rb * BK + C) * 2u; }
    const size_t kstep = (size_t)(BK * 2);
    const size_t hstep = (size_t)HALF * K * 2;
    const size_t hstepA = ROWPERM ? (size_t)4 * K * 2 : hstep;
    const size_t tstep = 2 * hstep;
    const size_t kstepB = (size_t)BM * BK * 2, hstepB = (size_t)HALF * BK * 2;
    const unsigned ldsw = (unsigned)wid * 1024u;
    const int aoff = lds_byte(wr * 64 + fr, fq * 8), boff = lds_byte(wc * 32 + fr, fq * 8);
#define PG8_SA(b, h) (((b) * 2 + (h)) * HTB)
#define PG8_SB(b, h) ((4 + (b) * 2 + (h)) * HTB)
#define PG8_STAGE(bufoff, gbase, voff) do { _Pragma("unroll") for (int _i = 0; _i < 2; ++_i) \
        __builtin_amdgcn_global_load_lds((const unsigned*)((const char*)(gbase) + (voff)[_i]), (PG8_LAS unsigned*)(lds + (bufoff) + ldsw + _i * 8192), 16, 0, 0); } while (0)
#define PG8_LDA(dst, b, h) do { _Pragma("unroll") for (int m = 0; m < 4; ++m) _Pragma("unroll") for (int k = 0; k < 2; ++k) dst[m][k] = *(const PG8_LAS bf16x8*)(lds + PG8_SA(b, h) + aoff + m * 2048 + k * 1024); } while (0)
#define PG8_LDB(dst, b, h) do { _Pragma("unroll") for (int n = 0; n < 2; ++n) _Pragma("unroll") for (int k = 0; k < 2; ++k) dst[n][k] = *(const PG8_LAS bf16x8*)(lds + PG8_SB(b, h) + boff + n * 2048 + k * 1024); } while (0)
#define PG8_MMA(ai, bj, At, Bt) do { __builtin_amdgcn_s_setprio(1); _Pragma("unroll") for (int m = 0; m < 4; ++m) _Pragma("unroll") for (int n = 0; n < 2; ++n) { \
        if constexpr (F8SA != 0) { typedef int i32x4_ __attribute__((ext_vector_type(4))); typedef int i32x8_ __attribute__((ext_vector_type(8))); \
            const i32x8_ b8 = __builtin_shufflevector(__builtin_bit_cast(i32x4_, Bt[n][0]), __builtin_bit_cast(i32x4_, Bt[n][1]), 0, 1, 2, 3, 4, 5, 6, 7), a8 = __builtin_shufflevector(__builtin_bit_cast(i32x4_, At[m][0]), __builtin_bit_cast(i32x4_, At[m][1]), 0, 1, 2, 3, 4, 5, 6, 7); \
            asm volatile("v_mfma_scale_f32_16x16x128_f8f6f4 %0, %1, %2, %0, %3, %4 op_sel_hi:[0,0,0]" : "+v"(acc[ai][bj][m][n]) : "v"(b8), "v"(a8), "v"(f8_sb), "v"(f8_sa)); } \
        else { _Pragma("unroll") for (int k = 0; k < 2; ++k) acc[ai][bj][m][n] = __builtin_amdgcn_mfma_f32_16x16x32_bf16(Bt[n][k], At[m][k], acc[ai][bj][m][n], 0, 0, 0); } } \
        __builtin_amdgcn_s_setprio(0); } while (0)
#define PG8_WAIT_V(n) asm volatile("s_waitcnt vmcnt(" #n ")" ::: "memory")
#define PG8_WAIT_L(n) asm volatile("s_waitcnt lgkmcnt(" #n ")" ::: "memory")
#define PG8_BAR __builtin_amdgcn_s_barrier()
#define PG8_SCHED __builtin_amdgcn_sched_barrier(0)
    int f8_sa = F8SA, f8_sb = F8SB; asm volatile("" : "+v"(f8_sa), "+v"(f8_sb));
    Unit cur, nxt; int ui = 0;
    if (!S.next(0, cur)) return;
    f32x4 acc[2][2][4][2];
#pragma unroll
    for (int a = 0; a < 2; ++a)
#pragma unroll
        for (int b = 0; b < 2; ++b)
#pragma unroll
            for (int m = 0; m < 4; ++m)
#pragma unroll
                for (int n = 0; n < 2; ++n) acc[a][b][m][n] = (f32x4){0.f, 0.f, 0.f, 0.f};
    bf16x8 At[4][2], B0[2][2], B1[2][2];
    const char* cA = (const char*)g.A + (size_t)cur.pm * tstep; const char* cB = (const char*)g.Bt + (size_t)cur.pn * tstep;
    S.a_ready(cur);
    if constexpr (SP2) {
        PG8_STAGE(PG8_SB(0, 0), cB, voffB); PG8_STAGE(PG8_SB(0, 1), cB + hstepB, voffB); PG8_STAGE(PG8_SA(0, 0), cA, voffA); PG8_STAGE(PG8_SA(0, 1), cA + hstepA, voffA);
        if (wr == 1) PG8_BAR;
        PG8_WAIT_V(2); PG8_BAR;
        PG8_STAGE(PG8_SB(1, 0), cB + kstepB, voffB); PG8_STAGE(PG8_SA(1, 0), cA + kstep, voffA); PG8_STAGE(PG8_SB(1, 1), cB + hstepB + kstepB, voffB);
        PG8_WAIT_V(6); PG8_BAR;
    } else {
        PG8_STAGE(PG8_SB(0, 0), cB, voffB); PG8_STAGE(PG8_SA(0, 0), cA, voffA); PG8_STAGE(PG8_SB(0, 1), cB + hstepB, voffB); PG8_STAGE(PG8_SA(0, 1), cA + hstepA, voffA);
        if (wr == 1) PG8_BAR;
        PG8_WAIT_V(4); PG8_BAR;
        PG8_STAGE(PG8_SB(1, 0), cB + kstepB, voffB); PG8_STAGE(PG8_SA(1, 0), cA + kstep, voffA); PG8_STAGE(PG8_SB(1, 1), cB + hstepB + kstepB, voffB);
        PG8_WAIT_V(6); PG8_BAR;
    }
    for (;;) {
        const bool has_next = S.next(ui + 1, nxt);
        const char* nA = has_next ? (const char*)g.A + (size_t)nxt.pm * tstep : cA; const char* nB = has_next ? (const char*)g.Bt + (size_t)nxt.pn * tstep : cB;
        for (int t = 0; t < nt; t += 2) {
            const bool last = (t == nt - 2);
            const char* a1 = cA + (size_t)(t + 1) * kstep;
            const char* a2 = last ? nA : cA + (size_t)(t + 2) * kstep; const char* b2 = last ? nB : cB + (size_t)(t + 2) * kstepB;
            const char* a3 = a2 + kstep; const char* b3 = b2 + kstepB;
            if (last && has_next) S.a_ready(nxt);
            if constexpr (SP2) {
            PG8_LDB(B0, 0, 0); PG8_LDB(B1, 0, 1); PG8_SCHED; PG8_LDA(At, 0, 0); PG8_STAGE(PG8_SA(1, 1), a1 + hstepA, voffA);
            PG8_WAIT_V(8); PG8_WAIT_L(0); PG8_BAR; PG8_MMA(0, 0, At, B0); PG8_MMA(0, 1, At, B1); PG8_BAR; PG8_SCHED;
            PG8_LDA(At, 0, 1); PG8_STAGE(PG8_SB(0, 0), b2, voffB); PG8_STAGE(PG8_SB(0, 1), b2 + hstepB, voffB); PG8_STAGE(PG8_SA(0, 0), a2, voffA);
            PG8_WAIT_V(8); PG8_WAIT_L(0); PG8_BAR; PG8_MMA(1, 0, At, B0); PG8_MMA(1, 1, At, B1); PG8_BAR; PG8_SCHED;
            PG8_LDB(B0, 1, 0); PG8_LDB(B1, 1, 1); PG8_SCHED; PG8_LDA(At, 1, 0); PG8_STAGE(PG8_SA(0, 1), a2 + hstepA, voffA);
            PG8_WAIT_V(8); PG8_WAIT_L(0); PG8_BAR; PG8_MMA(0, 0, At, B0); PG8_MMA(0, 1, At, B1); PG8_BAR; PG8_SCHED;
            PG8_LDA(At, 1, 1); PG8_STAGE(PG8_SB(1, 0), b3, voffB); PG8_STAGE(PG8_SB(1, 1), b3 + hstepB, voffB); PG8_STAGE(PG8_SA(1, 0), a3, voffA);
            PG8_WAIT_V(8); PG8_WAIT_L(0); PG8_BAR; PG8_MMA(1, 0, At, B0); PG8_MMA(1, 1, At, B1); PG8_BAR; PG8_SCHED;
            } else {
            PG8_LDB(B0, 0, 0); PG8_SCHED; PG8_LDA(At, 0, 0); PG8_STAGE(PG8_SA(1, 1), a1 + hstepA, voffA);
            PG8_WAIT_L(8); PG8_BAR; PG8_WAIT_L(0); PG8_MMA(0, 0, At, B0); PG8_BAR; PG8_SCHED;
            PG8_LDB(B1, 0, 1); PG8_STAGE(PG8_SB(0, 0), b2, voffB);
            PG8_BAR; PG8_WAIT_L(0); PG8_MMA(0, 1, At, B1); PG8_BAR;
            PG8_LDA(At, 0, 1); PG8_STAGE(PG8_SA(0, 0), a2, voffA);
            PG8_BAR; PG8_WAIT_L(0); PG8_MMA(1, 0, At, B0); PG8_BAR; PG8_SCHED;
            PG8_STAGE(PG8_SB(0, 1), b2 + hstepB, voffB);
            PG8_WAIT_V(6); PG8_BAR; PG8_MMA(1, 1, At, B1); PG8_BAR;
            PG8_LDB(B0, 1, 0); PG8_SCHED; PG8_LDA(At, 1, 0); PG8_STAGE(PG8_SA(0, 1), a2 + hstepA, voffA);
            PG8_WAIT_L(8); PG8_BAR; PG8_WAIT_L(0); PG8_MMA(0, 0, At, B0); PG8_BAR; PG8_SCHED;
            PG8_LDB(B1, 1, 1); PG8_STAGE(PG8_SB(1, 0), b3, voffB);
            PG8_BAR; PG8_WAIT_L(0); PG8_MMA(0, 1, At, B1); PG8_BAR;
            PG8_LDA(At, 1, 1); PG8_STAGE(PG8_SA(1, 0), a3, voffA);
            PG8_BAR; PG8_WAIT_L(0); PG8_MMA(1, 0, At, B0); PG8_BAR; PG8_SCHED;
            PG8_STAGE(PG8_SB(1, 1), b3 + hstepB, voffB);
            PG8_WAIT_V(6); PG8_BAR; PG8_MMA(1, 1, At, B1); PG8_BAR;
            }
            if constexpr (Epi::MID_T >= 0) { if (t == Epi::MID_T) {
                if constexpr (F8SA != 0) asm volatile("s_nop 15\n\ts_nop 15" ::: "memory");
                int fr_m = fr, fq_m = fq; asm volatile("" : "+v"(fr_m), "+v"(fq_m)); E.mid(acc, cur, wr, wc, fr_m, fq_m);
                asm volatile("s_nop 7" ::: "memory"); } }
        }
        if constexpr (F8SA != 0) asm volatile("s_nop 15\n\ts_nop 15" ::: "memory");
        if constexpr (ALIGN_EPI) { if (wr == 0) PG8_BAR; }
        if constexpr (!Epi::AFTER_DRAIN) { int fr_e = fr, fq_e = fq; asm volatile("" : "+v"(fr_e), "+v"(fq_e));   E(acc, cur, wr, wc, fr_e, fq_e); S.done(cur); }
        if (!has_next) break;
#pragma unroll
        for (int a = 0; a < 2; ++a)
#pragma unroll
            for (int b = 0; b < 2; ++b)
#pragma unroll
                for (int m = 0; m < 4; ++m)
#pragma unroll
                    for (int n = 0; n < 2; ++n) acc[a][b][m][n] = (f32x4){0.f, 0.f, 0.f, 0.f};
        cur = nxt; cA = nA; cB = nB; ++ui;
        if constexpr (ALIGN_EPI) { if (wr == 1) PG8_BAR; }
    }
    PG8_WAIT_V(0);
    if constexpr (!ALIGN_EPI) { if (wr == 0) PG8_BAR; }
    PG8_BAR;
    if constexpr (Epi::AFTER_DRAIN) { E.fused(acc, cur, wr, wc, fr, fq, lds, wid, lane); S.done(cur); }
#undef PG8_SA
#undef PG8_SB
#undef PG8_STAGE
#undef PG8_LDA
#undef PG8_LDB
#undef PG8_MMA
#undef PG8_WAIT_V
#undef PG8_WAIT_L
#undef PG8_BAR
#undef PG8_SCHED
}
}
__device__ __forceinline__ float sigmoidf_dev(float x) { return __builtin_amdgcn_rcpf(1.0f + __builtin_amdgcn_exp2f(-x * LOG2E)); }

constexpr int NWAVES = 8;
#ifndef MK_PER_PHASE
#define MK_PER_PHASE 0
#endif
constexpr int PH_PER_LAYER = 10;
constexpr int N_PHASES = 2 + DEPTH * PH_PER_LAYER;

constexpr size_t MiB = 1u << 20;
constexpr size_t WS_CTL = 0, CTL_ZERO_BYTES = 2 * MiB;
constexpr size_t WS_CVEC = 1 * MiB;
constexpr int CV_C1IN = 0, CV_C2IN = 4 * IN_COLS, CV_C1UP = 8 * IN_COLS, CV_C2UP = 8 * IN_COLS + 4 * UP_COLS;
static_assert((size_t)(8 * IN_COLS + 8 * UP_COLS) * 4 <= MiB, "fold vectors fit their MiB");
constexpr size_t WS_ROPEA = 2 * MiB;
constexpr size_t WS_ROPEB = 3 * MiB;
constexpr size_t WS_LSE = 4 * MiB;
constexpr size_t WS_STP1 = 5 * MiB, WS_STP2 = 9 * MiB;
constexpr size_t WS_SBL = 13 * MiB, WS_SBF = 17 * MiB;
constexpr size_t WS_W = 24 * MiB;
constexpr size_t LW_IN = 0, LW_PA = 120 * MiB, LW_PB = 124 * MiB, LW_OUT = 140 * MiB, LW_UP = 172 * MiB, LW_DN = 300 * MiB, LW_BYTES = 364 * MiB;
constexpr size_t WS_XB = WS_W + DEPTH * LW_BYTES;
constexpr size_t WS_XF = WS_XB + 64 * MiB;
constexpr size_t WS_HF = WS_XF + 128 * MiB;
constexpr size_t WS_PROJ = WS_HF + 128 * MiB;
constexpr size_t WS_OG = WS_PROJ + 240 * MiB;
constexpr size_t WS_YA = WS_OG + 48 * MiB;
constexpr size_t WS_YB = WS_YA + 8 * MiB;
constexpr size_t WS_MG = WS_YB + 32 * MiB;
constexpr size_t WS_U = WS_MG + 64 * MiB;
constexpr size_t WS_HA = WS_U + 256 * MiB;
constexpr size_t WS_G8 = WS_HA + 128 * MiB;
constexpr size_t WS_MT = WS_HA + 128 * MiB;
constexpr size_t WS_END = WS_MT + 64 * MiB;
static_assert((size_t)IN_COLS * DM * 2 == 120 * MiB && (size_t)M * IN_COLS * 2 == 240 * MiB && (size_t)3 * M * 512 * 4 == 48 * MiB, "ws map");
constexpr int CW_TMO = 0, CW_CODE = 1;
constexpr int IN_FULL_ROUNDS = (M / 256) * (IN_COLS / 256) / 256;
constexpr int IN_TAIL = (M / 256) * (IN_COLS / 256) - IN_FULL_ROUNDS * 256;
constexpr int CW_BAR = 4096;

constexpr int RING_OFF = 0, RING_BYTES = 131072;
constexpr int KSA = 272, KSB = 144;
constexpr int SCRATCH_BYTES = 2 * 256 * KSA;
constexpr int LDSCTL_OFF = SCRATCH_BYTES, MISC_OFF = LDSCTL_OFF + 320;
constexpr int LDS_BYTES = 147456 + 4096;
static_assert(MISC_OFF + 128 <= 147456 && pg8::CW_OFF == 147456 && 8 * 128 * 33 * 4 <= SCRATCH_BYTES && RING_BYTES <= SCRATCH_BYTES, "LDS map");

#define GAS __attribute__((address_space(1)))
#define LAS __attribute__((address_space(3)))
typedef unsigned short bf16;
typedef unsigned v4u __attribute__((ext_vector_type(4)));
typedef float f32x4 __attribute__((ext_vector_type(4)));
typedef short bf16x8 __attribute__((ext_vector_type(8)));
typedef GAS unsigned gu32;
typedef GAS unsigned long long gu64;
#define RLX_AGENT __ATOMIC_RELAXED, __HIP_MEMORY_SCOPE_AGENT
#define LDS_WAIT() asm volatile("s_waitcnt lgkmcnt(0)" ::: "memory")
#define VM_WAIT() asm volatile("s_waitcnt vmcnt(0)" ::: "memory")
__device__ __forceinline__ unsigned long long rt() { return __builtin_amdgcn_s_memrealtime(); }
__device__ __forceinline__ unsigned f2bf(float f) { unsigned u = __builtin_bit_cast(unsigned, f); return (u + 0x7fffu + ((u >> 16) & 1u)) >> 16; }
__device__ __forceinline__ unsigned pk2(float lo, float hi) { return f2bf(lo) | (f2bf(hi) << 16); }

#define XB_TMO      128
#define XB_XCNT(j)  (256  + 64 * (j))
#define XB_XSUB(j)  (1280 + 64 * (j))
#define XB_XGEN(j)  (2304 + 64 * (j))
#define XB_TOP      3328
#define XB_TOPGEN   3392
#define XCD_BAR_WORDS 3456
#define XB_SPIN_CAP (1u << 18)

__device__ __forceinline__ unsigned xb_ld(unsigned* p)              { return __hip_atomic_load((GAS unsigned*)p, __ATOMIC_RELAXED, __HIP_MEMORY_SCOPE_AGENT); }
__device__ __forceinline__ unsigned xb_add(unsigned* p, unsigned v) { return __hip_atomic_fetch_add((GAS unsigned*)p, v, __ATOMIC_RELAXED, __HIP_MEMORY_SCOPE_AGENT); }
__device__ __forceinline__ unsigned xb_xcc_id() { return (unsigned)__builtin_amdgcn_s_getreg((3 << 11) | 20) & 0xFu; }
#define XB_SPIN(cond, bar) do { unsigned _sp = 0; while (cond) { __builtin_amdgcn_s_sleep(1); \
    if ((++_sp & 255u) == 0u) { if (xb_ld(&(bar)[XB_TMO])) break; if (_sp > XB_SPIN_CAP) { (void)xb_add(&(bar)[XB_TMO], 1u); break; } } } } while (0)

struct XcdBarrier {
    unsigned* bar; unsigned x;
    volatile LAS unsigned* st;
};

__device__ __forceinline__ XcdBarrier xcd_barrier_post(unsigned* bar, volatile LAS unsigned* st) {
    XcdBarrier b; b.bar = bar; b.x = xb_xcc_id(); b.st = st;
    if (threadIdx.x == 0) (void)xb_add(&bar[XB_XCNT(b.x)], 1u);
    return b;
}
__device__ __forceinline__ void xcd_barrier_complete(unsigned* bar, unsigned x, unsigned& nloc, unsigned& nx) {
    const unsigned G = gridDim.x * gridDim.y * gridDim.z;
    unsigned sum, cnt, mine, sp = 0u;
    for (;;) {
        sum = 0u; cnt = 0u; mine = 0u;
#pragma unroll
        for (unsigned j = 0; j < 16; ++j) { const unsigned c = xb_ld(&bar[XB_XCNT(j)]); sum += c; cnt += (c > 0u) ? 1u : 0u; mine = (j == x) ? c : mine; }
        if (sum == G) break;
        __builtin_amdgcn_s_sleep(1);
        if ((++sp & 255u) == 0u) { if (xb_ld(&bar[XB_TMO])) break; if (sp > XB_SPIN_CAP) { (void)xb_add(&bar[XB_TMO], 1u); break; } }
    }
    nloc = mine > 0u ? mine : 1u; nx = cnt > 0u ? cnt : 1u;
}

__device__ __forceinline__ void xcd_barrier(const XcdBarrier& b) {
    asm volatile("s_waitcnt vmcnt(0)" ::: "memory");
    __syncthreads();
    if (threadIdx.x == 0) {
        unsigned* bar = b.bar; unsigned bx = b.x; asm volatile("" : "+s"(bar), "+s"(bx));
        __builtin_amdgcn_s_waitcnt(0);
        unsigned nloc = b.st[0], nx = b.st[1];
        if (nloc == 0u) { xcd_barrier_complete(bar, bx, nloc, nx); b.st[0] = nloc; b.st[1] = nx; }
        const unsigned old = xb_add(&bar[XB_XSUB(bx)], 1u);
        const unsigned gen = old / nloc;
        if (old + 1u == (gen + 1u) * nloc) {
            __builtin_amdgcn_fence(__ATOMIC_RELEASE, "agent");
            asm volatile("s_waitcnt vmcnt(0)" ::: "memory");
            const unsigned og = xb_add(&bar[XB_TOP], 1u);
            const unsigned tg = og / nx;
            if (og + 1u == (tg + 1u) * nx) xb_add(&bar[XB_TOPGEN], 1u);
            else XB_SPIN(xb_ld(&bar[XB_TOPGEN]) == tg, bar);
            __builtin_amdgcn_fence(__ATOMIC_ACQUIRE, "agent");
            xb_add(&bar[XB_XGEN(bx)], 1u);
            asm volatile("s_waitcnt vmcnt(0)" ::: "memory");
        } else {
            XB_SPIN(xb_ld(&bar[XB_XGEN(bx)]) == gen, bar);
            __builtin_amdgcn_fence(__ATOMIC_ACQUIRE, "agent");
            asm volatile("s_waitcnt vmcnt(0)" ::: "memory");
        }
    }
    __syncthreads();
}

typedef short v4i16_t __attribute__((ext_vector_type(4)));
using pg8::pk4_fp8;
typedef GAS const float gcf; typedef GAS float gf; typedef GAS bf16 gbf; typedef GAS const bf16 gcbf;
typedef float f32x2v __attribute__((ext_vector_type(2)));
typedef __bf16 bf16x2v __attribute__((ext_vector_type(2)));
__device__ __forceinline__ unsigned cvtpk(float lo, float hi) { f32x2v v = {lo, hi}; bf16x2v b = __builtin_convertvector(v, bf16x2v); return __builtin_bit_cast(unsigned, b); }
__device__ __forceinline__ float bflo(unsigned w) { return __uint_as_float(w << 16); }
__device__ __forceinline__ float bfhi(unsigned w) { return __uint_as_float(w & 0xffff0000u); }

struct Frame {
    LAS unsigned char* lds;
    volatile LAS unsigned* MISC;
    gu32* ctl;
    int tid, lane, wave;
    int vcu, G, bid;
};

__device__ __forceinline__ float wave_sum(float v) {
#pragma unroll
    for (int o = 1; o < 64; o <<= 1) v += __shfl_xor(v, o);
    return v;
}

__device__ __forceinline__ int win_dst_col(int c) {
    if (c < VA_OFF) { const int d = c & 127; if (d < 32) { const int nd = d < 16 ? 8 * (d >> 2) + (d & 3) : 8 * ((d - 16) >> 2) + 4 + (d & 3); return c - d + nd; } return c; }
    if (c >= QB_OFF && c < VB_OFF) { const int d = c & 63; if (d < 16) { const int nd = d < 8 ? 8 * (d >> 2) + (d & 3) : 8 * ((d - 8) >> 2) + 4 + (d & 3); return c - d + nd; } return c; }
    return c;
}
__device__ __forceinline__ void atomic_addf(gf* p, float v) { (void)__hip_atomic_fetch_add(p, v, __ATOMIC_RELAXED, __HIP_MEMORY_SCOPE_AGENT); }
__device__ __forceinline__ int up_dst_row(int c) { const int hf = c >= DFF ? 1 : 0, cc = c - hf * DFF; return 256 * (cc >> 7) + 128 * hf + (cc & 127); }
__device__ __forceinline__ size_t wpack_off(int n, int kb, int ldb) { return ((size_t)((n >> 8) * (ldb >> 7) + (kb >> 7)) * 256 + (n & 255)) * 128 + (kb & 127); }
template <bool FOLD, bool UPPERM>
__device__ __forceinline__ void p0_transpose_item(gcf* W, int K, int N, gbf* WT, gcf* g, gcf* b, gf* c1, gf* c2, LAS float* scr, int item, int lane) {
    const int nblk = N >> 6, kbg = item / nblk, nb = item - kbg * nblk, n0 = 64 * nb;
    f32x4 s1 = (f32x4){0.f, 0.f, 0.f, 0.f}, s2 = s1;
#pragma unroll 1
    for (int kk = 0; kk < 4; ++kk) { const int k0 = 64 * (4 * kbg + kk);
        const GAS f32x4* src = (const GAS f32x4*)(W + (size_t)(k0 + (lane >> 4)) * N + n0 + 4 * (lane & 15));
        f32x4 v[16];
#pragma unroll
        for (int i = 0; i < 16; ++i) v[i] = src[(size_t)i * N];
        if (FOLD) {
#pragma unroll
            for (int i = 0; i < 16; ++i) { const int k = k0 + 4 * i + (lane >> 4); const float gk = g[k], bk = b[k]; s2 = s2 + v[i] * bk; v[i] = v[i] * gk; s1 = s1 + v[i]; } }
#pragma unroll
        for (int i = 0; i < 16; ++i) { LAS float* d = scr + (4 * i + (lane >> 4)) * 65 + 4 * (lane & 15); d[0] = v[i][0]; d[1] = v[i][1]; d[2] = v[i][2]; d[3] = v[i][3]; }
        LDS_WAIT(); asm volatile("" ::: "memory");
        const int c = lane & 7;
#pragma unroll
        for (int j = 0; j < 8; ++j) { const int n = (lane >> 3) + 8 * j; const LAS float* q = scr + (8 * c) * 65 + n;
            v4u o; o.x = cvtpk(q[0 * 65], q[1 * 65]); o.y = cvtpk(q[2 * 65], q[3 * 65]); o.z = cvtpk(q[4 * 65], q[5 * 65]); o.w = cvtpk(q[6 * 65], q[7 * 65]);
            *(GAS v4u*)((GAS unsigned char*)WT + wpack_off(UPPERM ? up_dst_row(n0 + n) : n0 + n, 2 * (k0 + 8 * c), 2 * K)) = o; }
        LDS_WAIT(); asm volatile("" ::: "memory");
    }
    if (FOLD) {
#pragma unroll
        for (int j = 0; j < 4; ++j) { s1[j] += __shfl_xor(s1[j], 16); s1[j] += __shfl_xor(s1[j], 32); s2[j] += __shfl_xor(s2[j], 16); s2[j] += __shfl_xor(s2[j], 32); }
        float t1 = 0.f, t2 = 0.f;
#pragma unroll
        for (int j = 0; j < 4; ++j) { const float a1 = __shfl(s1[j], lane >> 2), a2 = __shfl(s2[j], lane >> 2); if ((lane & 3) == j) { t1 = a1; t2 = a2; } }
        const int dc = UPPERM ? up_dst_row(n0 + lane) : n0 + lane; atomic_addf(c1 + dc, t1); atomic_addf(c2 + dc, t2); }
}
template <bool PERM_IN, bool FOLD>
__device__ __forceinline__ void p0_transpose_item8(gcf* W, int K, int N, GAS unsigned char* WT, int ldw  , int kofs  , float scale, gcf* g, gcf* b, gf* c1, gf* c2, LAS float* scr, int item, int lane) {
    const int nblk = N >> 5, kbg = item / nblk, nb = item - kbg * nblk, n0 = 32 * nb;
    f32x4 s1 = (f32x4){0.f, 0.f, 0.f, 0.f}, s2 = s1;
#pragma unroll 1
    for (int kk = 0; kk < 4; ++kk) { const int k0 = 128 * (4 * kbg + kk);
        const GAS f32x4* src = (const GAS f32x4*)(W + (size_t)(k0 + (lane >> 3)) * N + n0 + 4 * (lane & 7));
        f32x4 v[16];
#pragma unroll
        for (int i = 0; i < 16; ++i) v[i] = src[(size_t)i * 2 * N];
        if (FOLD) {
#pragma unroll
            for (int i = 0; i < 16; ++i) { const int k = k0 + 8 * i + (lane >> 3); const float gk = g[k], bk = b[k]; s2 = s2 + v[i] * bk; v[i] = v[i] * gk; s1 = s1 + v[i]; } }
#pragma unroll
        for (int i = 0; i < 16; ++i) { LAS float* d = scr + (8 * i + (lane >> 3)) * 33 + 4 * (lane & 7); d[0] = v[i][0]; d[1] = v[i][1]; d[2] = v[i][2]; d[3] = v[i][3]; }
        LDS_WAIT(); asm volatile("" ::: "memory");
        const int c = lane & 7;
#pragma unroll
        for (int j = 0; j < 4; ++j) { const int n = (lane >> 3) + 8 * j; const LAS float* q = scr + (16 * c) * 33 + n;
            v4u o; o.x = pk4_fp8(q[0 * 33] * scale, q[1 * 33] * scale, q[2 * 33] * scale, q[3 * 33] * scale); o.y = pk4_fp8(q[4 * 33] * scale, q[5 * 33] * scale, q[6 * 33] * scale, q[7 * 33] * scale);
            o.z = pk4_fp8(q[8 * 33] * scale, q[9 * 33] * scale, q[10 * 33] * scale, q[11 * 33] * scale); o.w = pk4_fp8(q[12 * 33] * scale, q[13 * 33] * scale, q[14 * 33] * scale, q[15 * 33] * scale);
            const int row = PERM_IN ? win_dst_col(n0 + n) : n0 + n;
            *(GAS v4u*)(WT + wpack_off(row, kofs + k0 + 16 * c, ldw)) = o; }
        LDS_WAIT(); asm volatile("" ::: "memory");
    }
    if (FOLD) {
#pragma unroll
        for (int j = 0; j < 4; ++j) { s1[j] += __shfl_xor(s1[j], 8); s1[j] += __shfl_xor(s1[j], 16); s1[j] += __shfl_xor(s1[j], 32); s2[j] += __shfl_xor(s2[j], 8); s2[j] += __shfl_xor(s2[j], 16); s2[j] += __shfl_xor(s2[j], 32); }
        float t1 = 0.f, t2 = 0.f;
#pragma unroll
        for (int j = 0; j < 4; ++j) { const float a1 = __shfl(s1[j], (lane >> 2) & 7), a2 = __shfl(s2[j], (lane >> 2) & 7); if ((lane & 3) == j) { t1 = a1; t2 = a2; } }
        if (lane < 32) { const int cc = n0 + lane, dc = PERM_IN ? win_dst_col(cc) : cc; atomic_addf(c1 + dc, t1); atomic_addf(c2 + dc, t2); } }
}
__device__ __forceinline__ void sincos_d(double a, float& c, float& s) {
    const double q = __builtin_rint(a * 0.63661977236758134308);
    const double r = (a - q * 1.5707963267948966192) - q * 6.123233995736766036e-17;
    const double r2 = r * r;
    const double sn = r * (1.0 + r2 * (-1.0 / 6 + r2 * (1.0 / 120 + r2 * (-1.0 / 5040 + r2 * (1.0 / 362880 + r2 * (-1.0 / 39916800 + r2 * (1.0 / 6227020800.0)))))));
    const double cs = 1.0 + r2 * (-0.5 + r2 * (1.0 / 24 + r2 * (-1.0 / 720 + r2 * (1.0 / 40320 + r2 * (-1.0 / 3628800 + r2 * (1.0 / 479001600 + r2 * (-1.0 / 87178291200.0)))))));
    const int qi = (int)q & 3;
    const double sv = (qi == 0) ? sn : (qi == 1) ? cs : (qi == 2) ? -sn : -cs;
    const double cv = (qi == 0) ? cs : (qi == 1) ? -sn : (qi == 2) ? -cs : sn;
    c = (float)cv; s = (float)sv;
}
enum { PT_X, PT_POS, PT_WIN, PT_WPA, PT_WPB, PT_WOUT, PT_SINKS, PT_LN1G, PT_LN1B, PT_WUP, PT_CW, PT_CB, PT_WDN, PT_LN2G, PT_LN2B, PT_OUT, PT_WS, PT_N };
struct Ptrs { const void* p[PT_N]; };
__device__ __forceinline__ GAS unsigned char* ldptr(const Frame& F, int i) {
    unsigned off = LDSCTL_OFF + 8 * i; asm volatile("" : "+v"(off));
    const unsigned long long v = *(volatile LAS unsigned long long*)(F.lds + off);
    const unsigned lo = __builtin_amdgcn_readfirstlane((unsigned)v), hi = __builtin_amdgcn_readfirstlane((unsigned)(v >> 32));
    return (GAS unsigned char*)(((unsigned long long)hi << 32) | lo);
}
struct PPtrs { gcf *x, *w_in, *w_pa, *w_pb, *w_out, *w_up, *w_dn, *ln1g, *ln1b, *ln2g, *ln2b; GAS const int* pos; GAS unsigned char* ws; };
__device__ __forceinline__ void p0_prologue(Frame& F) {
    PPtrs P; P.x = (gcf*)ldptr(F, PT_X); P.w_in = (gcf*)ldptr(F, PT_WIN); P.w_pa = (gcf*)ldptr(F, PT_WPA); P.w_pb = (gcf*)ldptr(F, PT_WPB); P.w_out = (gcf*)ldptr(F, PT_WOUT);
    P.w_up = (gcf*)ldptr(F, PT_WUP); P.w_dn = (gcf*)ldptr(F, PT_WDN); P.ln1g = (gcf*)ldptr(F, PT_LN1G); P.ln1b = (gcf*)ldptr(F, PT_LN1B); P.ln2g = (gcf*)ldptr(F, PT_LN2G); P.ln2b = (gcf*)ldptr(F, PT_LN2B); P.pos = (GAS const int*)ldptr(F, PT_POS); P.ws = ldptr(F, PT_WS);
    LAS float* scr = (LAS float*)(F.lds + F.wave * (128 * 33 * 4));
    const int gw = F.vcu * NWAVES + F.wave, NGW = F.G * NWAVES;
    constexpr int I_IN = (DM / 512) * (IN_COLS / 32), I_PA = (A_OUT / 512) * (DM / 32), I_PB = (B_QW / 512) * (DM / 32), I_OUT = (DM / 512) * (DM / 32), I_UP = (DM / 256) * (UP_COLS / 64), I_DN = (DFF / 256) * (DM / 64);
    constexpr int I_LAYER = I_IN + I_PA + I_PB + I_OUT + I_UP + I_DN;
    gf* cv = (gf*)(P.ws + WS_CVEC);
    for (int it = gw; it < DEPTH * I_LAYER; it += NGW) {
        const int l = it / I_LAYER; int r = it - l * I_LAYER;
        GAS unsigned char* wl = P.ws + WS_W + (size_t)l * LW_BYTES;
        if (r < I_IN) { if (l == 0) p0_transpose_item8<true, false>(P.w_in, DM, IN_COLS, wl + LW_IN, DM, 0, F8S_WIN, nullptr, nullptr, nullptr, nullptr, scr, r, F.lane);
                        else p0_transpose_item8<true, true>(P.w_in + (size_t)l * DM * IN_COLS, DM, IN_COLS, wl + LW_IN, DM, 0, F8S_WIN, P.ln2g + (l - 1) * DM, P.ln2b + (l - 1) * DM, cv + CV_C1IN + l * IN_COLS, cv + CV_C2IN + l * IN_COLS, scr, r, F.lane);
                        continue; } r -= I_IN;
        if (r < I_PA) { p0_transpose_item8<false, false>(P.w_pa + (size_t)l * A_OUT * DM, A_OUT, DM, wl + LW_PA, YW, 0, F8S_WPA, nullptr, nullptr, nullptr, nullptr, scr, r, F.lane); continue; } r -= I_PA;
        if (r < I_PB) { p0_transpose_item8<false, false>(P.w_pb + (size_t)l * B_QW * DM, B_QW, DM, wl + LW_PA, YW, A_OUT, F8S_WPB, nullptr, nullptr, nullptr, nullptr, scr, r, F.lane); continue; } r -= I_PB;
        if (r < I_OUT) { p0_transpose_item8<false, false>(P.w_out + (size_t)l * DM * DM, DM, DM, wl + LW_OUT, DM, 0, F8S_WOUT, nullptr, nullptr, nullptr, nullptr, scr, r, F.lane); continue; } r -= I_OUT;
        if (r < I_UP) { p0_transpose_item<true, true>(P.w_up + (size_t)l * DM * UP_COLS, DM, UP_COLS, (gbf*)(wl + LW_UP), P.ln1g + l * DM, P.ln1b + l * DM, cv + CV_C1UP + l * UP_COLS, cv + CV_C2UP + l * UP_COLS, scr, r, F.lane); continue; } r -= I_UP;
        p0_transpose_item<false, false>(P.w_dn + (size_t)l * DFF * DM, DFF, DM, (gbf*)(wl + LW_DN), nullptr, nullptr, nullptr, nullptr, scr, r, F.lane);
    }
    { const int gt = F.vcu * (NWAVES * 64) + F.tid, NT = F.G * NWAVES * 64; GAS unsigned char* X8 = P.ws + WS_XB;
      for (int i = gt; i < M * DM / 16; i += NT) { const GAS f32x4* q = (const GAS f32x4*)(P.x + (size_t)i * 16); const f32x4 a = q[0] * F8S_X, b = q[1] * F8S_X, c = q[2] * F8S_X, d = q[3] * F8S_X;
          v4u o; o.x = pk4_fp8(a[0], a[1], a[2], a[3]); o.y = pk4_fp8(b[0], b[1], b[2], b[3]); o.z = pk4_fp8(c[0], c[1], c[2], c[3]); o.w = pk4_fp8(d[0], d[1], d[2], d[3]); *(GAS v4u*)(X8 + (size_t)i * 16) = o; }
      gf* ra = (gf*)(P.ws + WS_ROPEA); gf* rb = (gf*)(P.ws + WS_ROPEB);
      constexpr double INVF[16] = {1.0, 0.44036660267178046, 0.19392274474868576, 0.08539710028576561, 0.03760603093086393, 0.016560440080994446, 0.007292664737217109, 0.003211445994752591,
                                   0.001414213562373095, 0.000622772421914596, 0.0002742481756762073, 0.00012076973741146504, 5.318295896944988e-05, 2.341999896140934e-05, 1.031338537721246e-05, 4.5416704806078695e-06};
      for (int m = gt; m < M; m += NT) { const double pos = (double)P.pos[m];
#pragma unroll
          for (int j = 0; j < 16; ++j) { float c, s; sincos_d(pos * INVF[j], c, s); ra[(size_t)m * 32 + j] = c; ra[(size_t)m * 32 + 16 + j] = s;
              if ((j & 1) == 0) { rb[(size_t)m * 16 + (j >> 1)] = c; rb[(size_t)m * 16 + 8 + (j >> 1)] = s; } } }
    }
}

__device__ __forceinline__ void ln_final_phase(Frame& F, GAS const unsigned short* H, gcf* g, gcf* b, gf* out) {
    const int gw = F.vcu * NWAVES + F.wave, NGW = F.G * NWAVES;
    for (int m = gw; m < M; m += NGW) {
        const GAS v4u* hr = (const GAS v4u*)(H + (size_t)m * DM) + F.lane;
        f32x4 v[8][2]; float s = 0.f;
#pragma unroll
        for (int j = 0; j < 8; ++j) { pg8::unpk8_f16(__builtin_bit_cast(pg8::u32x4, hr[64 * j]), v[j][0], v[j][1]); s += ((v[j][0][0] + v[j][0][1]) + (v[j][0][2] + v[j][0][3])) + ((v[j][1][0] + v[j][1][1]) + (v[j][1][2] + v[j][1][3])); }
        const float mean = wave_sum(s) * (1.f / DM); float s2 = 0.f;
#pragma unroll
        for (int j = 0; j < 8; ++j)
#pragma unroll
            for (int h = 0; h < 2; ++h) { v[j][h] = v[j][h] - mean; s2 += (v[j][h][0] * v[j][h][0] + v[j][h][1] * v[j][h][1]) + (v[j][h][2] * v[j][h][2] + v[j][h][3] * v[j][h][3]); }
        const float rstd = 1.f / sqrtf(wave_sum(s2) * (1.f / DM) + LN_EPS);
#pragma unroll
        for (int j = 0; j < 8; ++j)
#pragma unroll
            for (int h = 0; h < 2; ++h) { const int c = 8 * (F.lane + 64 * j) + 4 * h; *(GAS f32x4*)(out + (size_t)m * DM + c) = v[j][h] * rstd * *(const GAS f32x4*)(g + c) + *(const GAS f32x4*)(b + c); }
    }
}

__device__ __forceinline__ void stats_to_lds(Frame& F, gcf* STP, int pm) {
    const int row = F.tid >> 1, half = F.tid & 1;
    const GAS f32x4* p = (const GAS f32x4*)(STP + ((size_t)(pm * 256 + row) * 64 + 32 * half) * 2);
    float sm = 0.f, sq = 0.f;
#pragma unroll
    for (int i = 0; i < 16; ++i) { const f32x4 v = p[i]; sm += v[0] + v[2]; sq += v[1] + v[3]; }
    sm += pg8::lx(sm, 1, F.lane); sq += pg8::lx(sq, 1, F.lane);
    const float mu = sm * (1.f / DM), var = sq * (1.f / DM) - mu * mu;
    if (half == 0) *(LAS f32x2v*)(F.lds + pg8::ST_OFF + row * 8) = (f32x2v){mu, 1.f / sqrtf(var + LN_EPS)};
    __syncthreads();
}

__device__ __forceinline__ void conv_fixup(Frame& F, int pm, gcf* SBL, gcf* SBF, gcf* cw, gcf* cb, gbf* HA) {
    const bool first = (pm & (SEQ / 256 - 1)) == 0;
    const int pl = first ? pm : pm - 1;
#pragma unroll
    for (int i = 0; i < 4; ++i) { const int c = 4 * (F.tid + 512 * i);
        f32x4 o[2][2];
#pragma unroll
        for (int gvh = 0; gvh < 2; ++gvh) { const int cc = c + gvh * DFF;
            f32x4 um2 = *(const GAS f32x4*)(SBL + (size_t)pl * 2 * UP_COLS + cc), um1 = *(const GAS f32x4*)(SBL + (size_t)pl * 2 * UP_COLS + UP_COLS + cc);
            if (first) { um2 = (f32x4){0.f, 0.f, 0.f, 0.f}; um1 = um2; }
            const f32x4 u0 = *(const GAS f32x4*)(SBF + (size_t)pm * 2 * UP_COLS + cc), u1 = *(const GAS f32x4*)(SBF + (size_t)pm * 2 * UP_COLS + UP_COLS + cc);
            const f32x4 w0 = *(const GAS f32x4*)(cw + cc), w1 = *(const GAS f32x4*)(cw + UP_COLS + cc), w2 = *(const GAS f32x4*)(cw + 2 * UP_COLS + cc), bb = *(const GAS f32x4*)(cb + cc);
            o[0][gvh] = w0 * um2 + w1 * um1 + w2 * u0 + bb; o[1][gvh] = w0 * um1 + w1 * u0 + w2 * u1 + bb; }
#pragma unroll
        for (int t = 0; t < 2; ++t) { const f32x4 g = o[t][0], v = o[t][1];
            *(GAS unsigned long long*)(HA + (size_t)(pm * 256 + t) * DFF + c) = (unsigned long long)cvtpk(pg8::silu_mul(g[0], v[0]), pg8::silu_mul(g[1], v[1])) | ((unsigned long long)cvtpk(pg8::silu_mul(g[2], v[2]), pg8::silu_mul(g[3], v[3])) << 32); } }
    asm volatile("s_waitcnt vmcnt(0)" ::: "memory"); __syncthreads();
}

__device__ __forceinline__ void conv_phase(Frame& F, gcbf* U, gcf* cw, gcf* cb, gbf* HA) {
    const int gt = F.vcu * (NWAVES * 64) + F.tid, NT = F.G * NWAVES * 64;
    for (int item = gt; item < (DFF / 8) * (M / 64); item += NT) {
        const int c0 = 8 * (item & (DFF / 8 - 1)), t0 = 64 * (item >> 10);
        f32x4 wg[3][2], wv[3][2], bg[2], bv[2];
#pragma unroll
        for (int h = 0; h < 2; ++h) {
#pragma unroll
            for (int i = 0; i < 3; ++i) { wg[i][h] = *(const GAS f32x4*)(cw + (size_t)i * UP_COLS + c0 + 4 * h); wv[i][h] = *(const GAS f32x4*)(cw + (size_t)i * UP_COLS + DFF + c0 + 4 * h); }
            bg[h] = *(const GAS f32x4*)(cb + c0 + 4 * h); bv[h] = *(const GAS f32x4*)(cb + DFF + c0 + 4 * h); }
        f32x4 g1[2], g2[2], v1[2], v2[2];
        const bool first = (t0 & (SEQ - 1)) == 0;
        { const int ta = first ? t0 : t0 - 1, tb = first ? t0 : t0 - 2;
          const v4u a = *(const GAS v4u*)(U + (size_t)ta * UP_COLS + c0), av = *(const GAS v4u*)(U + (size_t)ta * UP_COLS + DFF + c0);
          const v4u b = *(const GAS v4u*)(U + (size_t)tb * UP_COLS + c0), bw = *(const GAS v4u*)(U + (size_t)tb * UP_COLS + DFF + c0);
          const float z = first ? 0.f : 1.f;
          g1[0] = (f32x4){bflo(a.x), bfhi(a.x), bflo(a.y), bfhi(a.y)} * z; g1[1] = (f32x4){bflo(a.z), bfhi(a.z), bflo(a.w), bfhi(a.w)} * z;
          v1[0] = (f32x4){bflo(av.x), bfhi(av.x), bflo(av.y), bfhi(av.y)} * z; v1[1] = (f32x4){bflo(av.z), bfhi(av.z), bflo(av.w), bfhi(av.w)} * z;
          g2[0] = (f32x4){bflo(b.x), bfhi(b.x), bflo(b.y), bfhi(b.y)} * z; g2[1] = (f32x4){bflo(b.z), bfhi(b.z), bflo(b.w), bfhi(b.w)} * z;
          v2[0] = (f32x4){bflo(bw.x), bfhi(bw.x), bflo(bw.y), bfhi(bw.y)} * z; v2[1] = (f32x4){bflo(bw.z), bfhi(bw.z), bflo(bw.w), bfhi(bw.w)} * z; }
#pragma unroll 4
        for (int t = t0; t < t0 + 64; ++t) {
            const v4u a = *(const GAS v4u*)(U + (size_t)t * UP_COLS + c0), av = *(const GAS v4u*)(U + (size_t)t * UP_COLS + DFF + c0);
            f32x4 gc[2], vc[2], hh[2];
            gc[0] = (f32x4){bflo(a.x), bfhi(a.x), bflo(a.y), bfhi(a.y)}; gc[1] = (f32x4){bflo(a.z), bfhi(a.z), bflo(a.w), bfhi(a.w)};
            vc[0] = (f32x4){bflo(av.x), bfhi(av.x), bflo(av.y), bfhi(av.y)}; vc[1] = (f32x4){bflo(av.z), bfhi(av.z), bflo(av.w), bfhi(av.w)};
#pragma unroll
            for (int h = 0; h < 2; ++h) {
                const f32x4 ug = wg[0][h] * g2[h] + wg[1][h] * g1[h] + wg[2][h] * gc[h] + bg[h];
                const f32x4 uv = wv[0][h] * v2[h] + wv[1][h] * v1[h] + wv[2][h] * vc[h] + bv[h];
#pragma unroll
                for (int j = 0; j < 4; ++j) hh[h][j] = ug[j] * sigmoidf_dev(ug[j]) * uv[j];
                g2[h] = g1[h]; g1[h] = gc[h]; v2[h] = v1[h]; v1[h] = vc[h]; }
            v4u o; o.x = cvtpk(hh[0][0], hh[0][1]); o.y = cvtpk(hh[0][2], hh[0][3]); o.z = cvtpk(hh[1][0], hh[1][1]); o.w = cvtpk(hh[1][2], hh[1][3]);
            *(GAS v4u*)(HA + (size_t)t * DFF + c0) = o;
        }
    }
}

__device__ __forceinline__ v4i16_t vtr(const LAS unsigned char* p) { return __builtin_amdgcn_ds_read_tr16_b64_v4i16((LAS v4i16_t*)p); }
template <int HD, int KS, int MAXD>
__device__ __forceinline__ void attn_wave(const LAS unsigned char* Kl, const LAS unsigned char* Vl, const bf16x8 (&qf)[HD / 32], int w, int lane, bool first_blk, float sink2, bool has_sink,
                                          f32x4 (&o)[HD / 16], float& mx_out, float& l_out) {
    int lane_o = lane; asm volatile("" : "+v"(lane_o));
    const int fr = lane_o & 15, fq = lane_o >> 4, sb = 32 * (w >> 1);
    f32x4 S[10];
    constexpr int KK = HD / 32;
    const LAS unsigned char* kp0 = Kl + (sb + 8 * (fr >> 2) + (fr & 3)) * KS + 16 * fq;
    bf16x8 ka[2][2 * KK];
#define AT_LDK(ks_, bb_) _Pragma("unroll") for (int t = 0; t < 2; ++t) _Pragma("unroll") for (int kk = 0; kk < KK; ++kk) ka[bb_][t * KK + kk] = *(const LAS bf16x8*)(kp0 + (32 * (ks_) + 4 * t) * KS + 64 * kk)
    AT_LDK(0, 0);
#pragma unroll
    for (int ks = 0; ks < 5; ++ks) {
        if (ks + 1 < 5) { AT_LDK(ks + 1, (ks + 1) & 1); }
        __builtin_amdgcn_sched_barrier(0);
        S[2 * ks] = (f32x4){0.f, 0.f, 0.f, 0.f}; S[2 * ks + 1] = (f32x4){0.f, 0.f, 0.f, 0.f};
#pragma unroll
        for (int kk = 0; kk < KK; ++kk)
#pragma unroll
            for (int t = 0; t < 2; ++t) S[2 * ks + t] = __builtin_amdgcn_mfma_f32_16x16x32_bf16(ka[ks & 1][t * KK + kk], qf[kk], S[2 * ks + t], 0, 0, 0);
        __builtin_amdgcn_sched_barrier(0);
    }
#undef AT_LDK
    const int Lq = fr - 8 * fq, c0 = 128 + 16 * w - sb; float mx = -INFINITY;
    const int thr0 = first_blk ? -1000 : MAXD - c0, thr4 = 128 - c0;
#pragma unroll
    for (int ks = 0; ks < 5; ++ks)
#pragma unroll
        for (int t = 0; t < 2; ++t)
#pragma unroll
            for (int r = 0; r < 4; ++r) { float s = S[2 * ks + t][r];
                if (ks == 0) s = (Lq <= thr0 + 4 * t + r) ? s : -INFINITY;
                else if (ks == 4) s = (Lq >= thr4 + 4 * t + r) ? s : -INFINITY;
                else s = (first_blk && sb + 32 * ks < 128) ? -INFINITY : s;
                S[2 * ks + t][r] = s; mx = fmaxf(mx, s); }
    mx = fmaxf(mx, pg8::lx(mx, 16, lane_o)); mx = fmaxf(mx, pg8::lx(mx, 32, lane_o));
    if (has_sink) mx = fmaxf(mx, sink2);
    float l = 0.f;
#pragma unroll
    for (int T = 0; T < 10; ++T)
#pragma unroll
        for (int r = 0; r < 4; ++r) { const float p = __builtin_amdgcn_exp2f(S[T][r] - mx); S[T][r] = p; l += p; }
    l += pg8::lx(l, 16, lane_o); l += pg8::lx(l, 32, lane_o);
    if (has_sink) l += __builtin_amdgcn_exp2f(sink2 - mx);
    bf16x8 pf[5];
#pragma unroll
    for (int ks = 0; ks < 5; ++ks) { v4u pw; pw.x = cvtpk(S[2 * ks][0], S[2 * ks][1]); pw.y = cvtpk(S[2 * ks][2], S[2 * ks][3]); pw.z = cvtpk(S[2 * ks + 1][0], S[2 * ks + 1][1]); pw.w = cvtpk(S[2 * ks + 1][2], S[2 * ks + 1][3]);
        pf[ks] = __builtin_bit_cast(bf16x8, pw); }
    const LAS unsigned char* vp = Vl + (sb + 8 * fq + ((lane_o & 15) >> 2)) * KS + 8 * (lane_o & 3);
    constexpr int ND = HD / 16;
    v4i16_t va[2][2 * ND];
#define AT_LDV(ks_, bb_) _Pragma("unroll") for (int dt = 0; dt < ND; ++dt) { va[bb_][2 * dt] = vtr(vp + (32 * (ks_)) * KS + 32 * dt); va[bb_][2 * dt + 1] = vtr(vp + (32 * (ks_) + 4) * KS + 32 * dt); }
    AT_LDV(0, 0);
#pragma unroll
    for (int dt = 0; dt < ND; ++dt) o[dt] = (f32x4){0.f, 0.f, 0.f, 0.f};
#pragma unroll
    for (int ks = 0; ks < 5; ++ks) {
        if (ks + 1 < 5) { AT_LDV(ks + 1, (ks + 1) & 1); }
        __builtin_amdgcn_sched_barrier(0);
#pragma unroll
        for (int dt = 0; dt < ND; ++dt) { const v4i16_t lo = va[ks & 1][2 * dt], hi = va[ks & 1][2 * dt + 1];
            const bf16x8 vf = (bf16x8){lo[0], lo[1], lo[2], lo[3], hi[0], hi[1], hi[2], hi[3]};
            o[dt] = __builtin_amdgcn_mfma_f32_16x16x32_bf16(vf, pf[ks], o[dt], 0, 0, 0); }
        __builtin_amdgcn_sched_barrier(0);
    }
#undef AT_LDV
    mx_out = mx; l_out = l;
}

__device__ __forceinline__ void attnA_phase(Frame& F, gcbf* PROJ, gbf* OG, gf* LSE) {
    LAS unsigned char* Kl = F.lds; LAS unsigned char* Vl = F.lds + 256 * KSA;
    const int lane = F.lane, w = F.wave, fr = lane & 15, fq = lane >> 4;
    for (int u = F.bid; u < 768; u += F.G) {
        const int b = u / 384, h = (u >> 5) % 12, cq = u & 31, grp = h >> 2, slot = h & 3;
        const int lr = 2 * grp;
        const int c = cq >> (5 - lr), qb = cq & ((32 >> lr) - 1);
        gcbf* kbase = PROJ + KA_OFF + h * 128; gcbf* vbase = PROJ + VA_OFF + h * 128;
        v4u kv[8], vv[8];
#pragma unroll
        for (int i = 0; i < 8; ++i) { const int rho = 32 * i + (F.tid >> 4), ch = F.tid & 15, p = 128 * (qb - 1) + rho, pc = p < 0 ? 0 : p;
            const size_t m = (size_t)b * SEQ + ((size_t)pc << lr) + c;
            kv[i] = *(const GAS v4u*)(kbase + m * IN_COLS + 8 * ch); vv[i] = *(const GAS v4u*)(vbase + m * IN_COLS + 8 * ch); }
        const int pq = 128 * qb + 16 * w + fr; const size_t mq = (size_t)b * SEQ + ((size_t)pq << lr) + c;
        bf16x8 qf[4];
#pragma unroll
        for (int kk = 0; kk < 4; ++kk) qf[kk] = *(const GAS bf16x8*)(PROJ + mq * IN_COLS + h * 128 + 32 * kk + 8 * fq);
#pragma unroll
        for (int i = 0; i < 8; ++i) { const int rho = 32 * i + (F.tid >> 4), ch = F.tid & 15; const bool z = (128 * (qb - 1) + rho) < 0;
            if (z) { kv[i] = (v4u){0u, 0u, 0u, 0u}; vv[i] = (v4u){0u, 0u, 0u, 0u}; }
            *(LAS v4u*)(Kl + rho * KSA + 16 * ch) = kv[i]; *(LAS v4u*)(Vl + rho * KSA + 16 * ch) = vv[i]; }
        __syncthreads();
        f32x4 o[8]; float mx, l;
        attn_wave<128, KSA, 128>(Kl, Vl, qf, w, lane, qb == 0, 0.f, false, o, mx, l);
        const float inv = 1.0f / l;
        gbf* op = OG + ((size_t)grp * M + mq) * 512 + slot * 128 + 4 * fq;
#pragma unroll
        for (int dt = 0; dt < 8; ++dt) { const f32x4 y = o[dt] * inv; *(GAS unsigned long long*)(op + 16 * dt) = (unsigned long long)cvtpk(y[0], y[1]) | ((unsigned long long)cvtpk(y[2], y[3]) << 32); }
        if (fq == 0) LSE[((size_t)grp * M + mq) * 4 + slot] = mx + __builtin_amdgcn_logf(l);
        __syncthreads();
    }
}
__device__ __forceinline__ void attnB_phase(Frame& F, gcbf* PROJ, gcf* sinks, GAS unsigned char* YB8) {
    LAS unsigned char* Kl = F.lds; LAS unsigned char* Vl = F.lds + 256 * KSB;
    const int lane = F.lane, w = F.wave, fr = lane & 15, fq = lane >> 4;
    for (int u = F.bid; u < 256; u += F.G) {
        const int b = u >> 7, kvh = (u >> 5) & 3, qb = u & 31;
        gcbf* kbase = PROJ + KB_OFF + kvh * 64; gcbf* vbase = PROJ + VB_OFF + kvh * 64;
        v4u kv[4], vv[4];
#pragma unroll
        for (int i = 0; i < 4; ++i) { const int idx = 512 * i + F.tid, rho = idx >> 3, ch = idx & 7, t = 128 * (qb - 1) + rho, tc = t < 0 ? 0 : t;
            const size_t m = (size_t)b * SEQ + tc;
            kv[i] = *(const GAS v4u*)(kbase + m * IN_COLS + 8 * ch); vv[i] = *(const GAS v4u*)(vbase + m * IN_COLS + 8 * ch); }
#pragma unroll
        for (int i = 0; i < 4; ++i) { const int idx = 512 * i + F.tid, rho = idx >> 3, ch = idx & 7; const bool z = (128 * (qb - 1) + rho) < 0;
            if (z) { kv[i] = (v4u){0u, 0u, 0u, 0u}; vv[i] = (v4u){0u, 0u, 0u, 0u}; }
            *(LAS v4u*)(Kl + rho * KSB + 16 * ch) = kv[i]; *(LAS v4u*)(Vl + rho * KSB + 16 * ch) = vv[i]; }
        __syncthreads();
        const size_t mq = (size_t)b * SEQ + 128 * qb + 16 * w + fr;
#pragma unroll 1
        for (int g = 0; g < 8; ++g) { const int hq = kvh * 8 + g;
            bf16x8 qf[2];
#pragma unroll
            for (int kk = 0; kk < 2; ++kk) qf[kk] = *(const GAS bf16x8*)(PROJ + mq * IN_COLS + QB_OFF + hq * 64 + 32 * kk + 8 * fq);
            f32x4 o[4]; float mx, l;
            const float sink2 = *(const __attribute__((address_space(4))) float*)(unsigned long long)(sinks + hq) * LOG2E;
            attn_wave<64, KSB, 127>(Kl, Vl, qf, w, lane, qb == 0, sink2, true, o, mx, l);
            const float inv = 1.0f / l;
            const float inv8 = inv * F8S_Y;
            GAS unsigned char* op = YB8 + mq * YW + A_OUT + hq * 64 + 4 * fq;
#pragma unroll
            for (int dt = 0; dt < 4; ++dt) { const f32x4 y = o[dt] * inv8; *(GAS unsigned*)(op + 16 * dt) = pk4_fp8(y[0], y[1], y[2], y[3]); } }
        __syncthreads();
    }
}
struct AUnitD { int b, h, grp, slot, lr, c, qb; };
__device__ __forceinline__ AUnitD attn_decodeA(int u) { AUnitD d; d.b = u / 384; d.h = (u >> 5) % 12; const int cq = u & 31; d.grp = d.h >> 2; d.slot = d.h & 3; d.lr = 2 * d.grp; d.c = cq >> (5 - d.lr); d.qb = cq & ((32 >> d.lr) - 1); return d; }
__device__ __forceinline__ v4u cvt8_bf16(unsigned w0, unsigned w1, float sc) {
    v4u r; r.x = __builtin_bit_cast(unsigned, __builtin_amdgcn_cvt_scalef32_pk_bf16_fp8(w0, sc, false)); r.y = __builtin_bit_cast(unsigned, __builtin_amdgcn_cvt_scalef32_pk_bf16_fp8(w0, sc, true));
    r.z = __builtin_bit_cast(unsigned, __builtin_amdgcn_cvt_scalef32_pk_bf16_fp8(w1, sc, false)); r.w = __builtin_bit_cast(unsigned, __builtin_amdgcn_cvt_scalef32_pk_bf16_fp8(w1, sc, true)); return r; }
__device__ __forceinline__ void attn_phase(Frame& F, const GAS unsigned char* Q8, gbf* OG, gf* LSE, gcf* sinks, GAS unsigned char* Y8) {
    typedef unsigned u32x2_ __attribute__((ext_vector_type(2)));
    const int lane = F.lane, w = F.wave, fr = lane & 15, fq = lane >> 4;
    v4u kv[4], vv[4]; u32x2_ qn[4];
#define AT_LOAD_A(d) do { const GAS unsigned char* kbase = Q8 + KA_OFF + (d).h * 128; const GAS unsigned char* vbase = Q8 + VA_OFF + (d).h * 128; \
        _Pragma("unroll") for (int i = 0; i < 4; ++i) { const int idx = 512 * i + F.tid, rho = idx >> 3, ch = idx & 7, p = 128 * ((d).qb - 1) + rho, pc = p < 0 ? 0 : p; \
            const size_t m = (size_t)(d).b * SEQ + ((size_t)pc << (d).lr) + (d).c; kv[i] = *(const GAS v4u*)(kbase + m * QW + 16 * ch); vv[i] = *(const GAS v4u*)(vbase + m * QW + 16 * ch); } \
        const size_t mq_ = (size_t)(d).b * SEQ + ((size_t)(128 * (d).qb + 16 * w + fr) << (d).lr) + (d).c; \
        _Pragma("unroll") for (int kk = 0; kk < 4; ++kk) qn[kk] = *(const GAS u32x2_*)(Q8 + mq_ * QW + (d).h * 128 + 32 * kk + 8 * fq); } while (0)
#define AT_LOAD_B(ub) do { const int b_ = (ub) >> 7, kvh_ = ((ub) >> 5) & 3, qb_ = (ub) & 31; const GAS unsigned char* kbase = Q8 + KB_OFF + kvh_ * 64; const GAS unsigned char* vbase = Q8 + VB_OFF + kvh_ * 64; \
        _Pragma("unroll") for (int i = 0; i < 2; ++i) { const int idx = 512 * i + F.tid, rho = idx >> 2, ch = idx & 3, t = 128 * (qb_ - 1) + rho, tc = t < 0 ? 0 : t; const size_t m = (size_t)b_ * SEQ + tc; \
            kv[i] = *(const GAS v4u*)(kbase + m * QW + 16 * ch); vv[i] = *(const GAS v4u*)(vbase + m * QW + 16 * ch); } \
        const size_t mq_ = (size_t)b_ * SEQ + 128 * qb_ + 16 * w + fr; \
        _Pragma("unroll") for (int kk = 0; kk < 2; ++kk) qn[kk] = *(const GAS u32x2_*)(Q8 + mq_ * QW + QB_OFF + (kvh_ * 8) * 64 + 32 * kk + 8 * fq); } while (0)
#define AT_CVTQ(dst, kk_) do { const unsigned a_ = qn[kk_].x, b_ = qn[kk_].y; dst = __builtin_bit_cast(bf16x8, cvt8_bf16(a_, b_, 1.0f / F8S_Q)); } while (0)
    const int nbw = F.G - IN_TAIL, bw = F.bid - IN_TAIL, per = (256 + nbw - 1) / nbw; const int ub0 = bw * per; const int nB = bw < 0 ? 0 : (ub0 >= 256 ? 0 : (ub0 + per > 256 ? 256 - ub0 : per));
    int u = F.bid; bool haveB = false;
    if (u < 768) {
        AUnitD cu = attn_decodeA(u); AT_LOAD_A(cu);
        for (;;) {
            LAS unsigned char* Kl = F.lds; LAS unsigned char* Vl = F.lds + 256 * KSA;
#pragma unroll
            for (int i = 0; i < 4; ++i) { const int idx = 512 * i + F.tid, rho = idx >> 3, ch = idx & 7; const bool z = (128 * (cu.qb - 1) + rho) < 0;
                if (z) { kv[i] = (v4u){0u, 0u, 0u, 0u}; vv[i] = (v4u){0u, 0u, 0u, 0u}; }
                const unsigned k0 = kv[i].x, k1 = kv[i].y, k2 = kv[i].z, k3 = kv[i].w, v0 = vv[i].x, v1 = vv[i].y, v2 = vv[i].z, v3 = vv[i].w;
                *(LAS v4u*)(Kl + rho * KSA + 32 * ch) = cvt8_bf16(k0, k1, 1.0f / F8S_K); *(LAS v4u*)(Kl + rho * KSA + 32 * ch + 16) = cvt8_bf16(k2, k3, 1.0f / F8S_K);
                *(LAS v4u*)(Vl + rho * KSA + 32 * ch) = cvt8_bf16(v0, v1, 1.0f / F8S_V); *(LAS v4u*)(Vl + rho * KSA + 32 * ch + 16) = cvt8_bf16(v2, v3, 1.0f / F8S_V); }
            bf16x8 qf[4];
#pragma unroll
            for (int kk = 0; kk < 4; ++kk) AT_CVTQ(qf[kk], kk);
            __syncthreads();
            const int un = u + F.G; const bool moreA = un < 768; AUnitD nu = cu;
            if (moreA) { nu = attn_decodeA(un); AT_LOAD_A(nu); } else if (nB > 0) { AT_LOAD_B(ub0); haveB = true; }
            f32x4 o[8]; float mx, l;
            attn_wave<128, KSA, 128>(Kl, Vl, qf, w, lane, cu.qb == 0, 0.f, false, o, mx, l);
            const float inv = 1.0f / l;
            const size_t mq = (size_t)cu.b * SEQ + ((size_t)(128 * cu.qb + 16 * w + fr) << cu.lr) + cu.c;
            gbf* op = OG + ((size_t)cu.grp * M + mq) * 512 + cu.slot * 128 + 4 * fq;
#pragma unroll
            for (int dt = 0; dt < 8; ++dt) { const f32x4 y = o[dt] * inv; *(GAS unsigned long long*)(op + 16 * dt) = (unsigned long long)cvtpk(y[0], y[1]) | ((unsigned long long)cvtpk(y[2], y[3]) << 32); }
            if (fq == 0) LSE[((size_t)cu.grp * M + mq) * 4 + cu.slot] = mx + __builtin_amdgcn_logf(l);
            __syncthreads();
            if (!moreA) break;
            u = un; cu = nu;
        }
    }
    for (int ub = ub0; ub < ub0 + nB; ++ub) {
        if (!haveB) AT_LOAD_B(ub);
        haveB = false;
        const int b = ub >> 7, kvh = (ub >> 5) & 3, qb = ub & 31;
        LAS unsigned char* Kl = F.lds; LAS unsigned char* Vl = F.lds + 256 * KSB;
#pragma unroll
        for (int i = 0; i < 2; ++i) { const int idx = 512 * i + F.tid, rho = idx >> 2, ch = idx & 3; const bool z = (128 * (qb - 1) + rho) < 0;
            if (z) { kv[i] = (v4u){0u, 0u, 0u, 0u}; vv[i] = (v4u){0u, 0u, 0u, 0u}; }
            const unsigned k0 = kv[i].x, k1 = kv[i].y, k2 = kv[i].z, k3 = kv[i].w, v0 = vv[i].x, v1 = vv[i].y, v2 = vv[i].z, v3 = vv[i].w;
            *(LAS v4u*)(Kl + rho * KSB + 32 * ch) = cvt8_bf16(k0, k1, 1.0f / F8S_K); *(LAS v4u*)(Kl + rho * KSB + 32 * ch + 16) = cvt8_bf16(k2, k3, 1.0f / F8S_K);
            *(LAS v4u*)(Vl + rho * KSB + 32 * ch) = cvt8_bf16(v0, v1, 1.0f / F8S_V); *(LAS v4u*)(Vl + rho * KSB + 32 * ch + 16) = cvt8_bf16(v2, v3, 1.0f / F8S_V); }
        __syncthreads();
        const size_t mq = (size_t)b * SEQ + 128 * qb + 16 * w + fr;
#pragma unroll 1
        for (int g = 0; g < 8; ++g) { const int hq = kvh * 8 + g;
            bf16x8 qf[2]; AT_CVTQ(qf[0], 0); AT_CVTQ(qf[1], 1);
            if (g < 7) {
#pragma unroll
                for (int kk = 0; kk < 2; ++kk) qn[kk] = *(const GAS u32x2_*)(Q8 + mq * QW + QB_OFF + (hq + 1) * 64 + 32 * kk + 8 * fq); }
            f32x4 o[4]; float mx, l;
            const float sink2 = *(const __attribute__((address_space(4))) float*)(unsigned long long)(sinks + hq) * LOG2E;
            attn_wave<64, KSB, 127>(Kl, Vl, qf, w, lane, qb == 0, sink2, true, o, mx, l);
            const float inv8 = (1.0f / l) * F8S_Y;
            GAS unsigned char* op = Y8 + mq * YW + A_OUT + hq * 64 + 4 * fq;
#pragma unroll
            for (int dt = 0; dt < 4; ++dt) { const f32x4 y = o[dt] * inv8; *(GAS unsigned*)(op + 16 * dt) = pk4_fp8(y[0], y[1], y[2], y[3]); } }
        __syncthreads();
    }
#undef AT_LOAD_A
#undef AT_LOAD_B
#undef AT_CVTQ
}

__device__ __forceinline__ void combine_phase(Frame& F, gcbf* OG, gcf* LSE, GAS unsigned char* YA8) {
    const int gt = F.vcu * (NWAVES * 64) + F.tid, NT = F.G * NWAVES * 64;
    for (int item = gt; item < M * 128; item += NT) {
        const int m = item >> 7, j = (item >> 5) & 3, d4 = item & 31;
        const float l0 = LSE[((size_t)0 * M + m) * 4 + j], l1 = LSE[((size_t)1 * M + m) * 4 + j], l2 = LSE[((size_t)2 * M + m) * 4 + j];
        const float mx = fmaxf(l0, fmaxf(l1, l2));
        const float e0 = __builtin_amdgcn_exp2f(l0 - mx), e1 = __builtin_amdgcn_exp2f(l1 - mx), e2 = __builtin_amdgcn_exp2f(l2 - mx), inv = 1.0f / (e0 + e1 + e2);
        const size_t off = (size_t)m * 512 + j * 128 + 4 * d4;
        const unsigned long long wa = *(const GAS unsigned long long*)(OG + off), wb = *(const GAS unsigned long long*)(OG + (size_t)M * 512 + off), wc = *(const GAS unsigned long long*)(OG + (size_t)2 * M * 512 + off);
        const f32x4 a = (f32x4){bflo((unsigned)wa), bfhi((unsigned)wa), bflo((unsigned)(wa >> 32)), bfhi((unsigned)(wa >> 32))}, bq = (f32x4){bflo((unsigned)wb), bfhi((unsigned)wb), bflo((unsigned)(wb >> 32)), bfhi((unsigned)(wb >> 32))},
                    cq = (f32x4){bflo((unsigned)wc), bfhi((unsigned)wc), bflo((unsigned)(wc >> 32)), bfhi((unsigned)(wc >> 32))};
        const f32x4 y = (a * e0 + bq * e1 + cq * e2) * (inv * F8S_Y);
        *(GAS unsigned*)(YA8 + (size_t)m * YW + j * 128 + 4 * d4) = pk4_fp8(y[0], y[1], y[2], y[3]);
    }
}

struct Args { Ptrs p; int ph_lo, ph_hi; };
__global__ void __launch_bounds__(NWAVES * 64, 2) fwd_kernel(Args args) {
    extern __shared__ __attribute__((aligned(16))) unsigned char lds[];
    Frame F;
    F.lds = (LAS unsigned char*)lds;
    F.MISC = (volatile LAS unsigned*)(F.lds + MISC_OFF);
    F.tid = threadIdx.x; F.lane = F.tid & 63; F.wave = __builtin_amdgcn_readfirstlane(F.tid >> 6);
    F.bid = blockIdx.x; F.G = gridDim.x; { const int bx = blockIdx.x; F.vcu = (F.G % 8 == 0) ? (bx % 8) * (F.G / 8) + bx / 8 : bx; }
    for (int u = F.tid; u < (LDS_BYTES - LDSCTL_OFF) / 4; u += NWAVES * 64) ((LAS unsigned*)(F.lds + LDSCTL_OFF))[u] = 0u;
    __syncthreads();
    if (F.tid == 0) {
#pragma unroll
        for (int i = 0; i < PT_N; ++i) ((LAS unsigned long long*)(F.lds + LDSCTL_OFF))[i] = (unsigned long long)args.p.p[i]; }
    __syncthreads();
    F.ctl = (gu32*)(ldptr(F, PT_WS) + WS_CTL);
    if (!MK_PER_PHASE) (void)xcd_barrier_post((unsigned*)(F.ctl + CW_BAR), F.MISC + 8);
#define GRID_BAR() do { if (MK_PER_PHASE) { if (F.tid == 0) __hip_atomic_store((gu32*)(ldptr(F, PT_WS) + WS_CTL) + CW_TMO, 0xBADBA0u, RLX_AGENT); } else { XcdBarrier bar_; bar_.bar = (unsigned*)((gu32*)(ldptr(F, PT_WS) + WS_CTL) + CW_BAR); bar_.x = xb_xcc_id(); bar_.st = (volatile LAS unsigned*)(F.lds + MISC_OFF) + 8; xcd_barrier(bar_); } } while (0)
#if MK_PER_PHASE
    const int lo = args.ph_lo, hi = args.ph_hi;
#else
    constexpr int lo = 0, hi = N_PHASES;
#endif
#define IN(k) (lo <= (k) && (k) < hi)
#define SEAM(k) do { if (IN((k) + 1)) GRID_BAR(); } while (0)
#define WSP(T, off) ((GAS T*)(ldptr(F, PT_WS) + (off)))
#define INP(T, i) ((GAS const T*)ldptr(F, (i)))
#define PHASE_IDS() int bid = blockIdx.x; asm volatile("" : "+s"(bid)); bid = __builtin_amdgcn_readfirstlane(bid); Frame Fp = F; asm volatile("" : "+v"(Fp.tid)); Fp.lane = Fp.tid & 63; Fp.wave = __builtin_amdgcn_readfirstlane(Fp.tid >> 6); asm volatile("" : "+s"(Fp.vcu)); Fp.vcu = __builtin_amdgcn_readfirstlane(Fp.vcu); Fp.bid = bid
#ifndef DBL_MASK
#define DBL_MASK 0
#endif
#define REPS(bit) ((((DBL_MASK) >> (bit)) & 1) + 1)
#define PHASE_BEGIN(k, bit) if (IN(k)) { _Pragma("unroll 1") for (int rep_ = 0; rep_ < REPS(bit); ++rep_) { PHASE_IDS();
#define PHASE_END(k, bit, seam) if (rep_ + 1 < REPS(bit)) GRID_BAR(); } if (seam) SEAM(k); }

    PHASE_BEGIN(0, 0) p0_prologue(Fp); PHASE_END(0, 0, true)

    for (int l = 0; l < DEPTH; ++l) {
        const int g0 = 1 + l * PH_PER_LAYER;
        const size_t wl = WS_W + (size_t)l * LW_BYTES;

        PHASE_BEGIN(g0 + 0, 1)
            pg8::Gemm g{(const bf16*)WSP(bf16, WS_XB), (const bf16*)WSP(bf16, wl + LW_IN), M, IN_COLS, DM / 2};   pg8::StaticOrder S; S.init(M, IN_COLS, F.G, bid); S.nr = IN_FULL_ROUNDS;
            if (l > 0) { pg8::Unit u0; S.next(0, u0); stats_to_lds(Fp, WSP(float, WS_STP2), u0.pm); }
            pg8::EpiIn E{WSP(unsigned char, WS_PROJ), WSP(float, WS_ROPEA), WSP(float, WS_ROPEB), WSP(float, WS_CVEC) + CV_C1IN + l * IN_COLS, WSP(float, WS_CVEC) + CV_C2IN + l * IN_COLS, F.lds, l > 0 ? 1 : 0, WSP(unsigned char, WS_G8)};
            pg8::gemm_phase<pg8::EpiIn, pg8::StaticOrder, true, true, F8_X, F8_WIN>(F.lds + RING_OFF, g, S, E);
        PHASE_END(g0 + 0, 1, true)
        PHASE_BEGIN(g0 + 1, 2)
            { pg8::Gemm g{(const bf16*)WSP(bf16, WS_XB), (const bf16*)WSP(bf16, wl + LW_IN), M, IN_COLS, DM / 2}; pg8::StaticOrder S; S.init(M, IN_COLS, F.G, bid); S.i0 = IN_FULL_ROUNDS;
              pg8::Unit u0;
              if (S.next(0, u0)) {
                  if (l > 0) stats_to_lds(Fp, WSP(float, WS_STP2), u0.pm);
                  pg8::EpiIn E{WSP(unsigned char, WS_PROJ), WSP(float, WS_ROPEA), WSP(float, WS_ROPEB), WSP(float, WS_CVEC) + CV_C1IN + l * IN_COLS, WSP(float, WS_CVEC) + CV_C2IN + l * IN_COLS, F.lds, l > 0 ? 1 : 0, WSP(unsigned char, WS_G8)};
                  pg8::gemm_phase<pg8::EpiIn, pg8::StaticOrder, true, true, F8_X, F8_WIN>(F.lds + RING_OFF, g, S, E);
                  __syncthreads(); } }
            attn_phase(Fp, WSP(unsigned char, WS_PROJ), WSP(bf16, WS_OG), WSP(float, WS_LSE), INP(float, PT_SINKS) + l * 32, WSP(unsigned char, WS_YA));
        PHASE_END(g0 + 1, 2, true)
        PHASE_BEGIN(g0 + 2, 3) combine_phase(Fp, WSP(bf16, WS_OG), WSP(float, WS_LSE), WSP(unsigned char, WS_YA)); PHASE_END(g0 + 2, 3, true)
        PHASE_BEGIN(g0 + 3, 4)
            pg8::Gemm g{(const bf16*)WSP(bf16, WS_YA), (const bf16*)WSP(bf16, wl + LW_PA), M, DM, YW / 2}; pg8::StaticOrder S; S.init(M, DM, F.G, bid);
            pg8::EpiGate E{WSP(unsigned char, WS_MG), WSP(unsigned char, WS_G8)};
            pg8::gemm_phase<pg8::EpiGate, pg8::StaticOrder, true, true, F8_Y, F8_WPA>(F.lds + RING_OFF, g, S, E);
        PHASE_END(g0 + 3, 4, true)
        PHASE_BEGIN(g0 + 4, 5)
            pg8::Gemm g{(const bf16*)WSP(bf16, WS_MG), (const bf16*)WSP(bf16, wl + LW_OUT), M, DM, DM / 2}; pg8::StaticOrder S; S.init(M, DM, F.G, bid);
            if (l > 0) { pg8::Unit u0; S.next(0, u0); stats_to_lds(Fp, WSP(float, WS_STP2), u0.pm); }
            pg8::EpiResLn<0, true> E{INP(float, PT_X), WSP(unsigned short, WS_HF), INP(float, PT_LN2G) + (l > 0 ? l - 1 : 0) * DM, INP(float, PT_LN2B) + (l > 0 ? l - 1 : 0) * DM, WSP(bf16, WS_XB), WSP(unsigned char, WS_XB), WSP(float, WS_STP1), F.lds, l > 0 ? 1 : 0};
            pg8::gemm_phase<pg8::EpiResLn<0, true>, pg8::StaticOrder, true, true, F8_MG, F8_WOUT>(F.lds + RING_OFF, g, S, E);
        PHASE_END(g0 + 4, 5, true)
        PHASE_BEGIN(g0 + 6, 7)
            pg8::Gemm g{(const bf16*)WSP(bf16, WS_XB), (const bf16*)WSP(bf16, wl + LW_UP), M, UP_COLS, DM}; pg8::StaticOrder S; S.init(M, UP_COLS, F.G, bid);
            { pg8::Unit u0; S.next(0, u0); stats_to_lds(Fp, WSP(float, WS_STP1), u0.pm); }
            pg8::EpiConv E{WSP(bf16, WS_HA), WSP(float, WS_CVEC) + CV_C1UP + l * UP_COLS, WSP(float, WS_CVEC) + CV_C2UP + l * UP_COLS, INP(float, PT_CW) + (size_t)l * 3 * UP_COLS, INP(float, PT_CB) + (size_t)l * UP_COLS, WSP(float, WS_SBL), WSP(float, WS_SBF), F.lds};
            pg8::gemm_phase<pg8::EpiConv, pg8::StaticOrder, true, true, 0, 0, true>(F.lds + RING_OFF, g, S, E);
        PHASE_END(g0 + 6, 7, true)
        PHASE_BEGIN(g0 + 8, 9)
            pg8::Gemm g{(const bf16*)WSP(bf16, WS_HA), (const bf16*)WSP(bf16, wl + LW_DN), M, DM, DFF}; pg8::StaticOrder S; S.init(M, DM, F.G, bid);
            { pg8::Unit u0; S.next(0, u0); conv_fixup(Fp, u0.pm, WSP(float, WS_SBL), WSP(float, WS_SBF), INP(float, PT_CW) + (size_t)l * 3 * UP_COLS, INP(float, PT_CB) + (size_t)l * UP_COLS, WSP(bf16, WS_HA)); stats_to_lds(Fp, WSP(float, WS_STP1), u0.pm); }
            pg8::EpiResLn<1, false> E{INP(float, PT_X), WSP(unsigned short, WS_HF), INP(float, PT_LN1G) + l * DM, INP(float, PT_LN1B) + l * DM, WSP(bf16, WS_XB), WSP(unsigned char, WS_XB), WSP(float, WS_STP2), F.lds, 1};
            pg8::gemm_phase<pg8::EpiResLn<1, false>, pg8::StaticOrder, true, true>(F.lds + RING_OFF, g, S, E);
        PHASE_END(g0 + 8, 9, true)
    }
    PHASE_BEGIN(N_PHASES - 1, 10) ln_final_phase(Fp, WSP(unsigned short, WS_HF), INP(float, PT_LN2G) + (DEPTH - 1) * DM, INP(float, PT_LN2B) + (DEPTH - 1) * DM, (GAS float*)ldptr(F, PT_OUT)); PHASE_END(N_PHASES - 1, 10, false)
#undef IN
#undef SEAM
#undef GRID_BAR
#undef WSP
#undef INP
#undef PHASE_IDS
#undef PHASE_BEGIN
#undef PHASE_END
}

extern "C" void kernel_launch(void* const* d_in, const int* in_sizes, int n_in, void* d_out, int out_size, void* d_ws, size_t ws_size, hipStream_t stream) {
    static int grid = 0;
    if (grid == 0) {
        if (n_in != 15 || in_sizes[0] != M * DM || out_size != M * DM || ws_size < WS_END) { fprintf(stderr, "kernel_launch: shape/workspace mismatch (n_in %d, in0 %d, out %d, ws %zu, need %zu); nothing launched\n", n_in, n_in > 0 ? in_sizes[0] : -1, out_size, ws_size, (size_t)WS_END); grid = -1; return; }
        int dev = 0, cus = 0, per_cu = 0;
        if (hipGetDevice(&dev) != hipSuccess || hipDeviceGetAttribute(&cus, hipDeviceAttributeMultiprocessorCount, dev) != hipSuccess) { fprintf(stderr, "kernel_launch: hipGetDevice / hipDeviceGetAttribute failed; nothing launched\n"); grid = -1; return; }
        if (hipFuncSetAttribute((const void*)fwd_kernel, hipFuncAttributeMaxDynamicSharedMemorySize, LDS_BYTES) != hipSuccess) { fprintf(stderr, "kernel_launch: hipFuncSetAttribute failed; nothing launched\n"); grid = -1; return; }
        if (hipOccupancyMaxActiveBlocksPerMultiprocessor(&per_cu, (const void*)fwd_kernel, NWAVES * 64, LDS_BYTES) != hipSuccess || per_cu < 1)
            fprintf(stderr, "kernel_launch: note: the occupancy query reports %d workgroups per CU\n", per_cu);
        (void)hipGetLastError();
        grid = 256;
        if (cus != 256) fprintf(stderr, "kernel_launch: note: %d CUs reported; this kernel is built for the 256-CU MI355X (grid stays 256)\n", cus);
    }
    if (grid < 0) return;
    if (hipMemsetAsync((char*)d_ws + WS_CTL, 0, CTL_ZERO_BYTES, stream) != hipSuccess) { fprintf(stderr, "kernel_launch: hipMemsetAsync of the control words failed; nothing launched\n"); return; }
    Args a{};
    a.p.p[PT_X] = d_in[0]; a.p.p[PT_POS] = d_in[1]; a.p.p[PT_WIN] = d_in[2]; a.p.p[PT_WPA] = d_in[3]; a.p.p[PT_WPB] = d_in[4]; a.p.p[PT_WOUT] = d_in[5]; a.p.p[PT_SINKS] = d_in[6];
    a.p.p[PT_LN1G] = d_in[7]; a.p.p[PT_LN1B] = d_in[8]; a.p.p[PT_WUP] = d_in[9]; a.p.p[PT_CW] = d_in[10]; a.p.p[PT_CB] = d_in[11]; a.p.p[PT_WDN] = d_in[12]; a.p.p[PT_LN2G] = d_in[13]; a.p.p[PT_LN2B] = d_in[14];
    a.p.p[PT_OUT] = d_out; a.p.p[PT_WS] = d_ws;
#if MK_PER_PHASE
    for (int ph = 0; ph < N_PHASES; ++ph) { a.ph_lo = ph; a.ph_hi = ph + 1; hipLaunchKernelGGL(fwd_kernel, dim3(grid), dim3(NWAVES * 64), LDS_BYTES, stream, a); }
#else
    a.ph_lo = 0; a.ph_hi = N_PHASES;
    hipLaunchKernelGGL(fwd_kernel, dim3(grid), dim3(NWAVES * 64), LDS_BYTES, stream, a);
#endif
    const hipError_t le = hipPeekAtLastError();
    if (le != hipSuccess) fprintf(stderr, "kernel_launch: launch failed: %s (grid %d x %d threads, %d B LDS)\n", hipGetErrorName(le), grid, NWAVES * 64, LDS_BYTES);
}
```
